# Optimizing an MI355X kernel written in HIP

```python
import jax
import jax.numpy as jnp
from jax import lax
import numpy as np

D_MODEL = 1024
BATCH = 16
SEQ = 2048
DEPTH = 4

CHUNK = 64
D_MIX = D_MODEL
W_GROUP = D_MIX // 4
A_HEADS = 4
A_HD = W_GROUP // A_HEADS
CONV_W = 4
B_HEADS = 4
B_HD = W_GROUP // B_HEADS
SG_BLOCK = 128
C_GROUPS = 4
C_GD = W_GROUP // C_GROUPS
POOL_WINDOWS = (2, 4, 8, 16)
D_HEADS = 4
D_HD = W_GROUP // D_HEADS
SB_QBLOCK = 128
D_FF = 4 * D_MODEL
N_MOD = 6
EPS = 1e-6

COL_SIZES = (3 * W_GROUP, A_HEADS, A_HEADS, W_GROUP,
             W_GROUP, W_GROUP,
             W_GROUP,
             3 * W_GROUP)
P_IN = sum(COL_SIZES)

kernel_name = "hybrid_parallel_mixer_trunk"


def rms_norm(x, g):
    xf = x.astype(jnp.float32)
    y = xf * lax.rsqrt(jnp.mean(xf * xf, axis=-1, keepdims=True) + EPS)
    return (y * g.astype(jnp.float32)).astype(x.dtype)


def layer_norm(x, g):
    xf = x.astype(jnp.float32)
    mu = jnp.mean(xf, axis=-1, keepdims=True)
    xc = xf - mu
    y = xc * lax.rsqrt(jnp.mean(xc * xc, axis=-1, keepdims=True) + EPS)
    return (y * g.astype(jnp.float32)).astype(x.dtype)


def l2norm(x):
    return x * lax.rsqrt(jnp.sum(x * x, axis=-1, keepdims=True) + EPS)


def split_cols(p, sizes):
    outs, o = [], 0
    for s in sizes:
        outs.append(p[..., o:o + s])
        o += s
    return outs


def causal_depthwise_conv(x, w):
    return lax.conv_general_dilated(x, w[:, None, :].astype(x.dtype), window_strides=(1,),
                                    padding=((CONV_W - 1, 0),),
                                    dimension_numbers=("NWC", "WIO", "NWC"),
                                    feature_group_count=x.shape[-1])


def chunk_gated_delta_rule(q, k, v, g, beta):
    Bn, S, H, Dk = q.shape
    n = S // CHUNK

    def blocks(t):
        t = t.reshape((Bn, n, CHUNK, H) + t.shape[3:])
        return jnp.moveaxis(t, 3, 1)

    q = blocks(q) * (Dk ** -0.5)
    k = blocks(k)
    v = blocks(v)
    beta = blocks(beta)
    g = jnp.cumsum(blocks(g), axis=-1)
    pos = jnp.arange(CHUNK)
    incl = pos[:, None] >= pos[None, :]
    strict = pos[:, None] > pos[None, :]
    decay = jnp.exp(jnp.where(incl, g[..., :, None] - g[..., None, :], -jnp.inf))
    k_beta = k * beta[..., None]
    nmat = -jnp.where(strict, jnp.einsum('bhnid,bhnjd->bhnij', k_beta, k) * decay, 0.0)
    tmat = jnp.eye(CHUNK, dtype=q.dtype) + nmat
    pw = nmat
    for _ in range(CHUNK.bit_length() - 2):
        pw = pw @ pw
        tmat = tmat + tmat @ pw
    u = tmat @ (v * beta[..., None])
    w = tmat @ (k_beta * jnp.exp(g)[..., None])
    qk = jnp.einsum('bhnid,bhnjd->bhnij', q, k) * decay
    q_dec = q * jnp.exp(g)[..., None]
    g_last = g[..., -1]
    k_dec = k * jnp.exp(g_last[..., None] - g)[..., None]

    def step(state, inp):
        qd, kd, uc, wc, qkc, gl = inp
        v_new = uc - wc @ state
        o = qd @ state + qkc @ v_new
        state = state * jnp.exp(gl)[..., None, None] + jnp.swapaxes(kd, -1, -2) @ v_new
        return state, o

    xs = tuple(jnp.moveaxis(t, 2, 0) for t in (q_dec, k_dec, u, w, qk, g_last))
    state0 = jnp.zeros((Bn, H, Dk, v.shape[-1]), q.dtype)
    _, o = lax.scan(step, state0, xs)
    o = jnp.moveaxis(o, 0, 2)
    return jnp.moveaxis(o, 1, 3).reshape(Bn, S, H, -1)


def gated_deltanet(qkv, a, b, gate, conv_w, a_log, dt_bias, g_out):
    Bn, S, _ = qkv.shape
    y = jax.nn.silu(causal_depthwise_conv(qkv, conv_w)).astype(jnp.float32)
    q, k, v = [t.reshape(Bn, S, A_HEADS, A_HD) for t in jnp.split(y, 3, axis=-1)]
    q, k = l2norm(q), l2norm(k)
    beta = jax.nn.sigmoid(b.astype(jnp.float32))
    g = -jnp.exp(a_log.astype(jnp.float32)) * jax.nn.softplus(a.astype(jnp.float32) + dt_bias.astype(jnp.float32))
    o = chunk_gated_delta_rule(q, k, v, g, beta)
    o = rms_norm(o, g_out.reshape(A_HEADS, A_HD))
    o = o * jax.nn.silu(gate.astype(jnp.float32)).reshape(Bn, S, A_HEADS, A_HD)
    return o.reshape(Bn, S, W_GROUP).astype(qkv.dtype)


def spatial_gating(u, v, g_ln, w_s, b_s):
    Bn, S, _ = u.shape
    v = layer_norm(v.reshape(Bn, S, B_HEADS, B_HD), g_ln.reshape(B_HEADS, B_HD))
    v = v.reshape(Bn, S // SG_BLOCK, SG_BLOCK, B_HEADS, B_HD)
    cpos = jnp.arange(SG_BLOCK) // CHUNK
    mask = cpos[:, None] >= cpos[None, :]
    w_m = jnp.where(mask, w_s, jnp.zeros_like(w_s))
    s = jnp.einsum('hts,bnshd->bnthd', w_m, v) + jnp.transpose(b_s)[None, None, :, :, None]
    return u * s.reshape(Bn, S, W_GROUP)


def multiscale_pool(xc, w_p, s_p):
    Bn, S, _ = xc.shape
    xf = xc.astype(jnp.float32).reshape(Bn, S, C_GROUPS, C_GD)
    cs = jnp.pad(jnp.cumsum(xf, axis=1), ((0, 0), (1, 0), (0, 0), (0, 0)))
    t = jnp.arange(S)
    win = jnp.array(POOL_WINDOWS, dtype=jnp.int32)
    lo = jnp.maximum(t[:, None] + 1 - win[None, :], 0)
    g_idx = jnp.arange(C_GROUPS)[None, :]
    total = cs[:, 1:] - cs[:, lo, g_idx]
    count = (t[:, None] + 1 - lo).astype(jnp.float32)
    pooled = total / count[None, :, :, None] - xf
    y = jnp.einsum('bsgc,gcd->bsgd', pooled, w_p.astype(jnp.float32))
    y = y * s_p.astype(jnp.float32).reshape(C_GROUPS, C_GD)
    return y.reshape(Bn, S, W_GROUP).astype(xc.dtype)


def stick_breaking(q, k, v):
    Bn, S, H, hd = q.shape
    scale = hd ** -0.5
    outs = []
    for i in range(S // SB_QBLOCK):
        q0, q1 = i * SB_QBLOCK, (i + 1) * SB_QBLOCK
        z = jnp.einsum('bqhd,bkhd->bhqk', q[:, q0:q1], k[:, :q1]).astype(jnp.float32) * scale
        past = jnp.arange(q1)[None, :] < jnp.arange(q0, q1)[:, None]
        log_fail = jnp.where(past, jax.nn.log_sigmoid(-z), 0.0)
        after = lax.cumsum(log_fail, axis=3, reverse=True) - log_fail
        a = jnp.where(past, jnp.exp(jax.nn.log_sigmoid(z) + after), 0.0)
        outs.append(jnp.einsum('bhqk,bkhd->bqhd', a.astype(v.dtype), v[:, :q1]))
    return jnp.concatenate(outs, axis=1)


def setup_inputs(seed: int = 0) -> dict:
    key = jax.random.key(seed)
    ks = jax.random.split(key, 24)
    f32 = jnp.float32
    nrm = lambda k, shape, s: jax.random.normal(k, shape, f32) * s
    dt = jnp.exp(jax.random.uniform(ks[8], (DEPTH, A_HEADS), f32) * (jnp.log(0.1) - jnp.log(0.001)) + jnp.log(0.001))
    return {
        "x": nrm(ks[0], (BATCH, SEQ, D_MODEL), 1.0),
        "c": nrm(ks[1], (BATCH, D_MODEL), 1.0),
        "w_mod": nrm(ks[2], (DEPTH, D_MODEL, N_MOD * D_MODEL), 0.5 * D_MODEL ** -0.5),
        "b_mod": nrm(ks[3], (DEPTH, N_MOD * D_MODEL), 0.01),
        "g_norm1": 1.0 + nrm(ks[4], (DEPTH, D_MODEL), 0.02),
        "g_norm2": 1.0 + nrm(ks[5], (DEPTH, D_MODEL), 0.02),
        "w_in": nrm(ks[6], (DEPTH, D_MODEL, P_IN), D_MODEL ** -0.5),
        "conv_a": nrm(ks[7], (DEPTH, CONV_W, 3 * W_GROUP), CONV_W ** -0.5),
        "a_log": jnp.log(jax.random.uniform(ks[9], (DEPTH, A_HEADS), f32, 1.0, 16.0)),
        "dt_bias": dt + jnp.log(-jnp.expm1(-dt)),
        "g_out_a": 1.0 + nrm(ks[10], (DEPTH, W_GROUP), 0.02),
        "g_ln_b": 1.0 + nrm(ks[11], (DEPTH, W_GROUP), 0.02),
        "w_sg": nrm(ks[12], (DEPTH, B_HEADS, SG_BLOCK, SG_BLOCK), 0.5 * SG_BLOCK ** -0.5),
        "b_sg": 1.0 + nrm(ks[13], (DEPTH, B_HEADS, SG_BLOCK), 0.01),
        "w_pool": nrm(ks[14], (DEPTH, C_GROUPS, C_GD, C_GD), C_GD ** -0.5),
        "s_pool": 1.0 + nrm(ks[15], (DEPTH, W_GROUP), 0.1),
        "g_out_d": 1.0 + nrm(ks[16], (DEPTH, W_GROUP), 0.02),
        "w_out": nrm(ks[17], (DEPTH, D_MIX, D_MODEL), D_MIX ** -0.5),
        "w_ff1": nrm(ks[18], (DEPTH, D_MODEL, D_FF), D_MODEL ** -0.5),
        "w_ff2": nrm(ks[19], (DEPTH, D_FF, D_MODEL), D_FF ** -0.5),
        "g_final": 1.0 + nrm(ks[20], (D_MODEL,), 0.02),
    }


def reference(x, c, w_mod, b_mod, g_norm1, g_norm2, w_in, conv_a, a_log, dt_bias, g_out_a, g_ln_b,
              w_sg, b_sg, w_pool, s_pool, g_out_d, w_out, w_ff1, w_ff2, g_final):
    Bn, S, _ = x.shape
    cond = jax.nn.silu(c)
    for l in range(DEPTH):
        mod = cond @ w_mod[l] + b_mod[l]
        shift1, scale1, gate1, shift2, scale2, gate2 = jnp.split(mod[:, None, :], N_MOD, axis=-1)
        h = rms_norm(x, g_norm1[l]) * (1.0 + scale1) + shift1
        p = h @ w_in[l]
        qkv_a, a_a, b_a, gate_a, u_b, v_b, x_c, qkv_d = split_cols(p, COL_SIZES)
        y_a = gated_deltanet(qkv_a, a_a, b_a, gate_a, conv_a[l], a_log[l], dt_bias[l], g_out_a[l])
        y_b = spatial_gating(u_b, v_b, g_ln_b[l], w_sg[l], b_sg[l])
        y_c = multiscale_pool(x_c, w_pool[l], s_pool[l])
        q_d, k_d, v_d = [t.reshape(Bn, S, D_HEADS, D_HD) for t in jnp.split(qkv_d, 3, axis=-1)]
        y_d = rms_norm(stick_breaking(q_d, k_d, v_d), g_out_d[l].reshape(D_HEADS, D_HD)).reshape(Bn, S, W_GROUP)
        y = jnp.concatenate([y_a, y_b, y_c, y_d], axis=-1) @ w_out[l]
        x = x + gate1 * y
        h = rms_norm(x, g_norm2[l]) * (1.0 + scale2) + shift2
        x = x + gate2 * (jnp.square(jax.nn.relu(h @ w_ff1[l])) @ w_ff2[l])
    return rms_norm(x, g_final)
```

```cpp
#include <hip/hip_runtime.h>
#include <cstdio>
#include <cstdint>
#define MK_PER_PHASE 0
namespace pg8 {
#define PG8_LAS __attribute__((address_space(3)))
typedef unsigned short bf16_t;
typedef short bf16x8 __attribute__((ext_vector_type(8)));
typedef float f32x4 __attribute__((ext_vector_type(4)));
typedef unsigned u32x4 __attribute__((ext_vector_type(4)));
constexpr int BM = 256, BK = 64, HALF = 128, HTB = HALF * BK * 2  , STAGE_BYTES = 8 * HTB, NXCD = 8, WGM = 8;

__host__ __device__ __forceinline__ int lds_byte(int r, int c) { const int st = (r >> 4) * 2 + (c >> 5), rr = r & 15, cc = c & 31, ob = rr * 64 + cc * 2; return st * 1024 + (ob ^ (((ob >> 9) & 1) << 5)); }
__host__ __device__ __forceinline__ void stage_rc(int b, int& R, int& C) { const int st = b / 1024, sb = b % 1024, swz = sb ^ (((sb >> 9) & 1) << 5); R = (st >> 1) * 16 + swz / 64; C = (st & 1) * 32 + (swz % 64) / 2; }
__host__ __device__ __forceinline__ int perm32(int rho) { const int n = rho >> 4, i = rho & 15; return 8 * (i >> 2) + 4 * n + (i & 3); }

struct Unit { int pm, pn, slot; };
struct Gemm { const bf16_t* A; const bf16_t* Bt; int M, N, K, lda, ldb; };
typedef int i32x4 __attribute__((ext_vector_type(4)));

struct StaticOrder {
    int nM, nN, nwg, G, c;
    __host__ __device__ __forceinline__ void init(int M, int N, int G_, int c_) { nM = M / BM; nN = N / BM; nwg = nM * nN; G = G_; c = c_; }
    __host__ __device__ __forceinline__ bool next(int i, Unit& u) const {
        const int L = i * G + c; if (L >= nwg) return false;
        int wgid = L; { const int q = nwg / NXCD, r = nwg % NXCD, xcd = wgid % NXCD, off = wgid / NXCD; wgid = (xcd < r ? xcd * (q + 1) : r * (q + 1) + (xcd - r) * q) + off; }
        const int nig = WGM * nN, gid = wgid / nig, fm = gid * WGM, gsz = (nM - fm) < WGM ? (nM - fm) : WGM;
        u.pm = fm + ((wgid % nig) % gsz); u.pn = (wgid % nig) / gsz; u.slot = i; return true;
    }
    __device__ __forceinline__ void a_ready(const Unit&) const {}
    __device__ __forceinline__ void done(const Unit&) const {}
};
__device__ __forceinline__ unsigned cvt_pk_bf16(float lo, float hi) { unsigned r; asm volatile("v_cvt_pk_bf16_f32 %0, %1, %2" : "=v"(r) : "v"(lo), "v"(hi)); return r; }
typedef float f32x2 __attribute__((ext_vector_type(2))); typedef unsigned u32x2_t __attribute__((ext_vector_type(2)));
constexpr float QCLIP8 = 8.0f;
constexpr float HCLIP8 = 40.0f;
__device__ __forceinline__ float row_rstd(const float* ssq, int row) {
    const f32x4* p = (const f32x4*)(ssq + (size_t)row * 16);
    const f32x4 a = p[0], b = p[1], c = p[2], d = p[3];
    const float s = ((a[0] + a[1]) + (a[2] + a[3])) + ((b[0] + b[1]) + (b[2] + b[3])) + ((c[0] + c[1]) + (c[2] + c[3])) + ((d[0] + d[1]) + (d[2] + d[3]));
    return __builtin_amdgcn_rsqf(s * (1.0f / 1024.0f) + 1e-6f);
}
template <int ACT, bool I8_ = false, bool OUT8 = false> struct EpiNormed {
    static constexpr bool PERM = true, AFTER_DRAIN = false, I8 = I8_, P16 = OUT8;
    bf16_t* O; int ldc; const PG8_LAS float* rtab; const PG8_LAS float* stab; const PG8_LAS float* gtab; const PG8_LAS float* qtab; int nost = 0;
    __device__ __forceinline__ void operator()(const f32x4 (&acc)[2][2][4][2], const Unit& u, int wr, int wc, int fr, int fq) const {
        const int lc0 = P16 ? wc * 64 + 16 * fq : wc * 32 + 8 * fq;
        constexpr int BJS = P16 ? 8 : HALF;
        const int row0 = u.pm * BM + wr * 64 + fr, col0 = u.pn * BM + lc0;
        f32x4 bv[2][2];
#pragma unroll
        for (int bj = 0; bj < 2; ++bj)
#pragma unroll
            for (int n = 0; n < 2; ++n) { bv[bj][n] = *(const PG8_LAS f32x4*)(stab + u.slot * BM + lc0 + bj * BJS + 4 * n); if (OUT8) bv[bj][n] = bv[bj][n] * __builtin_sqrtf(255.0f / HCLIP8); }
        const bool gsel = (ACT == 0) && gtab != nullptr && u.pn == 3;
        f32x4 gv[2][2];
#pragma unroll
        for (int bj = 0; bj < 2; ++bj)
#pragma unroll
            for (int n = 0; n < 2; ++n) gv[bj][n] = I8 ? *(const PG8_LAS f32x4*)(qtab + u.slot * BM + lc0 + bj * BJS + 4 * n) : (f32x4){1.f, 1.f, 1.f, 1.f};
#pragma unroll
        for (int ai = 0; ai < 2; ++ai)
#pragma unroll
            for (int m = 0; m < 4; ++m) { const int row = row0 + ai * HALF + m * 16; float rs = rtab[u.slot * BM + wr * 64 + fr + ai * HALF + m * 16]; if (OUT8) rs *= __builtin_sqrtf(255.0f / HCLIP8);
                bf16_t* rowp = O + (size_t)row * ldc + col0; u32x2_t wlo = {0u, 0u};
#pragma unroll
                for (int bj = 0; bj < 2; ++bj) { f32x4 a0 = acc[ai][bj][m][0], a1 = acc[ai][bj][m][1];
                    if (I8) { a0 = __builtin_convertvector(__builtin_bit_cast(i32x4, a0), f32x4); a1 = __builtin_convertvector(__builtin_bit_cast(i32x4, a1), f32x4); }
                    f32x4 v0, v1;
                    {
                        const f32x2 rs2 = {rs, rs};
                        f32x2 p0 = {a0[0], a0[1]}, p1 = {a0[2], a0[3]}, p2 = {a1[0], a1[1]}, p3 = {a1[2], a1[3]};
                        if (I8) { p0 = p0 * (f32x2){gv[bj][0][0], gv[bj][0][1]}; p1 = p1 * (f32x2){gv[bj][0][2], gv[bj][0][3]}; p2 = p2 * (f32x2){gv[bj][1][0], gv[bj][1][1]}; p3 = p3 * (f32x2){gv[bj][1][2], gv[bj][1][3]}; }
                        p0 = __builtin_elementwise_fma(p0, rs2, (f32x2){bv[bj][0][0], bv[bj][0][1]}); p1 = __builtin_elementwise_fma(p1, rs2, (f32x2){bv[bj][0][2], bv[bj][0][3]});
                        p2 = __builtin_elementwise_fma(p2, rs2, (f32x2){bv[bj][1][0], bv[bj][1][1]}); p3 = __builtin_elementwise_fma(p3, rs2, (f32x2){bv[bj][1][2], bv[bj][1][3]});
                        v0 = (f32x4){p0[0], p0[1], p1[0], p1[1]}; v1 = (f32x4){p2[0], p2[1], p3[0], p3[1]}; }
                    if (gsel) { const f32x4 gg0 = *(const PG8_LAS f32x4*)(gtab + lc0 + bj * BJS), gg1 = *(const PG8_LAS f32x4*)(gtab + lc0 + bj * BJS + 4);
#pragma unroll
                        for (int j = 0; j < 4; ++j) { v0[j] = v0[j] * __builtin_amdgcn_rcpf(1.0f + __expf(-v0[j])) * gg0[j]; v1[j] = v1[j] * __builtin_amdgcn_rcpf(1.0f + __expf(-v1[j])) * gg1[j]; } }
                    if (ACT == 1 && !OUT8) {
#pragma unroll
                        for (int j = 0; j < 4; ++j) { const float a = fmaxf(v0[j], 0.f), b = fmaxf(v1[j], 0.f); v0[j] = a * a; v1[j] = b * b; } }
                    if (OUT8) {
                        unsigned w0 = 0u, w1 = 0u;
#pragma unroll
                        for (int j = 0; j < 4; ++j) { w0 = __builtin_amdgcn_cvt_pk_u8_f32(v0[j] * __builtin_fabsf(v0[j]), j, w0); w1 = __builtin_amdgcn_cvt_pk_u8_f32(v1[j] * __builtin_fabsf(v1[j]), j, w1); }
                        if (bj == 0) { wlo.x = w0 ^ 0x80808080u; wlo.y = w1 ^ 0x80808080u; }
                        else { u32x4 w; w.x = wlo.x; w.y = wlo.y; w.z = w0 ^ 0x80808080u; w.w = w1 ^ 0x80808080u;
#ifdef PROBE_REP
                            if (nost) { asm volatile("" :: "v"(w.x), "v"(w.y), "v"(w.z), "v"(w.w)); } else
#endif
                            *(u32x4*)((unsigned char*)O + (size_t)row * ldc + col0) = w; } }
                    else { u32x4 w; w.x = cvt_pk_bf16(v0[0], v0[1]); w.y = cvt_pk_bf16(v0[2], v0[3]); w.z = cvt_pk_bf16(v1[0], v1[1]); w.w = cvt_pk_bf16(v1[2], v1[3]);
                        *(u32x4*)(rowp + bj * BJS) = w; } } }
    }
};
template <bool XI32, bool XO32, bool XQ8 = false, bool I8_ = false> struct EpiResid {
    static constexpr bool PERM = true, AFTER_DRAIN = false, I8 = I8_, P16 = false;
    const void* xi; void* xo; bf16_t* xg; float* ssq; const PG8_LAS float* tis; const PG8_LAS float* tgs; const PG8_LAS float* tG; const PG8_LAS int* thc;
    __device__ __forceinline__ void operator()(const f32x4 (&acc)[2][2][4][2], const Unit& u, int wr, int wc, int fr, int fq) const {
        const int row0 = u.pm * BM + wr * 64 + fr, col0 = u.pn * BM + wc * 32 + 8 * fq, lc0 = u.slot * BM + wc * 32 + 8 * fq;
        f32x2 sq[2][4]; float isq[2][4];
#pragma unroll
        for (int ai = 0; ai < 2; ++ai)
#pragma unroll
            for (int m = 0; m < 4; ++m) { sq[ai][m] = (f32x2){0.f, 0.f}; isq[ai][m] = XQ8 ? tis[u.slot * BM + wr * 64 + fr + ai * HALF + m * 16] : 0.f; }
#pragma unroll
        for (int bj = 0; bj < 2; ++bj) {
            const int col = col0 + bj * HALF, lc = lc0 + bj * HALF;
            const f32x4 g0 = *(const PG8_LAS f32x4*)(tgs + lc), g1 = *(const PG8_LAS f32x4*)(tgs + lc + 4);
            f32x4 G0 = (f32x4){0.f, 0.f, 0.f, 0.f}, G1 = G0, hc0 = G0, hc1 = G0;
            if (I8) { hc0 = *(const PG8_LAS f32x4*)((const PG8_LAS float*)thc + lc); hc1 = *(const PG8_LAS f32x4*)((const PG8_LAS float*)thc + lc + 4); }
            if (xg) { G0 = *(const PG8_LAS f32x4*)(tG + lc); G1 = *(const PG8_LAS f32x4*)(tG + lc + 4); }
#pragma unroll
            for (int ai = 0; ai < 2; ++ai)
#pragma unroll
                for (int m = 0; m < 4; ++m) { const int row = row0 + ai * HALF + m * 16; const size_t off = (size_t)row * 1024 + col;
                    f32x4 x0, x1;
                    if (XI32) { x0 = *(const f32x4*)((const float*)xi + off); x1 = *(const f32x4*)((const float*)xi + off + 4); }
                    else { const u32x4 xv = *(const u32x4*)((const bf16_t*)xi + off);
                        x0 = (f32x4){__uint_as_float(xv.x << 16), __uint_as_float(xv.x & 0xffff0000u), __uint_as_float(xv.y << 16), __uint_as_float(xv.y & 0xffff0000u)};
                        x1 = (f32x4){__uint_as_float(xv.z << 16), __uint_as_float(xv.z & 0xffff0000u), __uint_as_float(xv.w << 16), __uint_as_float(xv.w & 0xffff0000u)}; }
                    f32x4 a0 = acc[ai][bj][m][0], a1 = acc[ai][bj][m][1];
                    if (I8) { a0 = __builtin_convertvector(__builtin_bit_cast(i32x4, a0), f32x4); a1 = __builtin_convertvector(__builtin_bit_cast(i32x4, a1), f32x4); x0 = x0 + hc0; x1 = x1 + hc1; }
                    const f32x4 y0 = x0 + g0 * a0, y1 = x1 + g1 * a1;
                    if (XO32) { *(f32x4*)((float*)xo + off) = y0; *(f32x4*)((float*)xo + off + 4) = y1; }
                    else { u32x4 w; w.x = cvt_pk_bf16(y0[0], y0[1]); w.y = cvt_pk_bf16(y0[2], y0[3]); w.z = cvt_pk_bf16(y1[0], y1[1]); w.w = cvt_pk_bf16(y1[2], y1[3]); *(u32x4*)((bf16_t*)xo + off) = w; }
                    { const f32x2 ya = {y0[0], y0[1]}, yb = {y0[2], y0[3]}, yc = {y1[0], y1[1]}, yd = {y1[2], y1[3]}; sq[ai][m] = __builtin_elementwise_fma(ya, ya, sq[ai][m]); sq[ai][m] = __builtin_elementwise_fma(yb, yb, sq[ai][m]); sq[ai][m] = __builtin_elementwise_fma(yc, yc, sq[ai][m]); sq[ai][m] = __builtin_elementwise_fma(yd, yd, sq[ai][m]); }
                    if (xg) { f32x4 z0 = y0 * G0, z1 = y1 * G1;
                        if (XQ8) { const f32x2 is2 = {isq[ai][m], isq[ai][m]}, c128 = {128.0f, 128.0f};
                            { const f32x2 q0 = __builtin_elementwise_fma((f32x2){z0[0], z0[1]}, is2, c128), q1 = __builtin_elementwise_fma((f32x2){z0[2], z0[3]}, is2, c128), q2 = __builtin_elementwise_fma((f32x2){z1[0], z1[1]}, is2, c128), q3 = __builtin_elementwise_fma((f32x2){z1[2], z1[3]}, is2, c128);
                              z0 = (f32x4){q0[0], q0[1], q1[0], q1[1]}; z1 = (f32x4){q2[0], q2[1], q3[0], q3[1]}; }
                            unsigned w0 = 0u, w1 = 0u;
#pragma unroll
                            for (int j = 0; j < 4; ++j) { w0 = __builtin_amdgcn_cvt_pk_u8_f32(z0[j], j, w0); w1 = __builtin_amdgcn_cvt_pk_u8_f32(z1[j], j, w1); }
                            u32x2_t w; w.x = w0 ^ 0x80808080u; w.y = w1 ^ 0x80808080u;
                            *(u32x2_t*)((unsigned char*)xg + off) = w; }
                        else { u32x4 w; w.x = cvt_pk_bf16(z0[0], z0[1]); w.y = cvt_pk_bf16(z0[2], z0[3]); w.z = cvt_pk_bf16(z1[0], z1[1]); w.w = cvt_pk_bf16(z1[2], z1[3]);
                            *(u32x4*)(xg + off) = w; } } }
        }
        float s8[2][4];
#pragma unroll
        for (int ai = 0; ai < 2; ++ai)
#pragma unroll
            for (int m = 0; m < 4; ++m) { float s = sq[ai][m][0] + sq[ai][m][1]; s += __shfl_xor(s, 16); s += __shfl_xor(s, 32); s8[ai][m] = s; }
#pragma unroll
        for (int ai = 0; ai < 2; ++ai) { const float v = fq == 0 ? s8[ai][0] : fq == 1 ? s8[ai][1] : fq == 2 ? s8[ai][2] : s8[ai][3];
            ssq[(size_t)(row0 + ai * HALF + fq * 16) * 16 + u.pn * 4 + wc] = v; }
    }
};
struct EpiNull {
    static constexpr bool PERM = true, AFTER_DRAIN = false, I8 = false, P16 = false;
    float* sink;
    __device__ __forceinline__ void operator()(const f32x4 (&acc)[2][2][4][2], const Unit& u, int wr, int wc, int fr, int fq) const {
        float s = 0.f;
#pragma unroll
        for (int ai = 0; ai < 2; ++ai)
#pragma unroll
            for (int bj = 0; bj < 2; ++bj)
#pragma unroll
                for (int m = 0; m < 4; ++m)
#pragma unroll
                    for (int n = 0; n < 2; ++n) s += acc[ai][bj][m][n][0] + acc[ai][bj][m][n][1] + acc[ai][bj][m][n][2] + acc[ai][bj][m][n][3];
        if (s == 123.456f) sink[0] = s;
    }
};
struct NoPre { __device__ __forceinline__ void operator()() const {} };
template <class Epi, class Sched, bool ALIGN_EPI = false, bool SP2 = false, class Pre = NoPre>
__device__ __forceinline__ void gemm_phase(PG8_LAS unsigned char* lds, const Gemm g, const Sched& S, const Epi& E, const Pre& pre = Pre()) {
    int tid_ = threadIdx.x; asm volatile("" : "+v"(tid_));
    const int tid = tid_, wid = __builtin_amdgcn_readfirstlane(tid >> 6), lane = tid & 63, wr = wid >> 2, wc = wid & 3, fr = lane & 15, fq = lane >> 4;
    const int K = g.K, nt = K / BK;
    unsigned voffA[2], voffB[2];
#pragma unroll
    for (int i = 0; i < 2; ++i) { int R, C; stage_rc(tid * 16 + i * 8192, R, C); const int Rb = Epi::P16 ? ((R >> 5) * 64 + 16 * ((R >> 2) & 3) + 4 * ((R >> 4) & 1) + (R & 3)) : Epi::PERM ? ((R & ~31) + perm32(R & 31)) : R;
        voffA[i] = (unsigned)(R * g.lda + C) * 2u; voffB[i] = (unsigned)(Rb * g.ldb + C) * 2u; }
    const size_t kstep = (size_t)(BK * 2);
    const size_t hstepA = (size_t)HALF * g.lda * 2, tstepA = 2 * hstepA;
    const size_t tstepB = (size_t)2 * HALF * g.ldb * 2, hstepB = Epi::P16 ? (size_t)8 * g.ldb * 2 : (size_t)HALF * g.ldb * 2;
    const unsigned ldsw = (unsigned)wid * 1024u;
    const int aoff = lds_byte(wr * 64 + fr, fq * 8), boff = lds_byte(wc * 32 + fr, fq * 8);
#define PG8_SA(b, h) (((b) * 2 + (h)) * HTB)
#define PG8_SB(b, h) ((4 + (b) * 2 + (h)) * HTB)
#define PG8_STAGE(bufoff, gbase, voff) do { _Pragma("unroll") for (int _i = 0; _i < 2; ++_i) \
        __builtin_amdgcn_global_load_lds((const unsigned*)((const char*)(gbase) + (voff)[_i]), (PG8_LAS unsigned*)(lds + (bufoff) + ldsw + _i * 8192), 16, 0, 0); } while (0)
#define PG8_LDA(dst, b, h) do { _Pragma("unroll") for (int m = 0; m < 4; ++m) _Pragma("unroll") for (int k = 0; k < 2; ++k) dst[m][k] = *(const PG8_LAS bf16x8*)(lds + PG8_SA(b, h) + aoff + m * 2048 + k * 1024); } while (0)
#define PG8_LDB(dst, b, h) do { _Pragma("unroll") for (int n = 0; n < 2; ++n) _Pragma("unroll") for (int k = 0; k < 2; ++k) dst[n][k] = *(const PG8_LAS bf16x8*)(lds + PG8_SB(b, h) + boff + n * 2048 + k * 1024); } while (0)
#define PG8_MMA(ai, bj, At, Bt) do { __builtin_amdgcn_s_setprio(1); _Pragma("unroll") for (int m = 0; m < 4; ++m) _Pragma("unroll") for (int n = 0; n < 2; ++n) _Pragma("unroll") for (int k = 0; k < 2; ++k) \
        { if constexpr (Epi::I8) acc[ai][bj][m][n] = __builtin_bit_cast(f32x4, __builtin_amdgcn_mfma_i32_16x16x64_i8(__builtin_bit_cast(i32x4, Bt[n][k]), __builtin_bit_cast(i32x4, At[m][k]), __builtin_bit_cast(i32x4, acc[ai][bj][m][n]), 0, 0, 0)); \
          else acc[ai][bj][m][n] = __builtin_amdgcn_mfma_f32_16x16x32_bf16(Bt[n][k], At[m][k], acc[ai][bj][m][n], 0, 0, 0); } __builtin_amdgcn_s_setprio(0); } while (0)
#define PG8_WAIT_V(n) asm volatile("s_waitcnt vmcnt(" #n ")" ::: "memory")
#define PG8_WAIT_L(n) asm volatile("s_waitcnt lgkmcnt(" #n ")" ::: "memory")
#define PG8_BAR __builtin_amdgcn_s_barrier()
#define PG8_SCHED __builtin_amdgcn_sched_barrier(0)
    Unit cur, nxt; int ui = 0;
    if (!S.next(0, cur)) return;
    f32x4 acc[2][2][4][2];
#pragma unroll
    for (int a = 0; a < 2; ++a)
#pragma unroll
        for (int b = 0; b < 2; ++b)
#pragma unroll
            for (int m = 0; m < 4; ++m)
#pragma unroll
                for (int n = 0; n < 2; ++n) acc[a][b][m][n] = (f32x4){0.f, 0.f, 0.f, 0.f};
    bf16x8 At[4][2], B0[2][2], B1[2][2];
    const char* cA = (const char*)g.A + (size_t)cur.pm * tstepA; const char* cB = (const char*)g.Bt + (size_t)cur.pn * tstepB;
    S.a_ready(cur);
    if constexpr (SP2) {
        PG8_STAGE(PG8_SB(0, 0), cB, voffB); PG8_STAGE(PG8_SB(0, 1), cB + hstepB, voffB); PG8_STAGE(PG8_SA(0, 0), cA, voffA); PG8_STAGE(PG8_SA(0, 1), cA + hstepA, voffA);
        pre();
        if (wr == 1) PG8_BAR;
        PG8_WAIT_V(2); PG8_BAR;
        PG8_STAGE(PG8_SB(1, 0), cB + kstep, voffB); PG8_STAGE(PG8_SA(1, 0), cA + kstep, voffA); PG8_STAGE(PG8_SB(1, 1), cB + hstepB + kstep, voffB);
        PG8_WAIT_V(6); PG8_BAR;
    } else {
        PG8_STAGE(PG8_SB(0, 0), cB, voffB); PG8_STAGE(PG8_SA(0, 0), cA, voffA); PG8_STAGE(PG8_SB(0, 1), cB + hstepB, voffB); PG8_STAGE(PG8_SA(0, 1), cA + hstepA, voffA);
        if (wr == 1) PG8_BAR;
        PG8_WAIT_V(4); PG8_BAR;
        PG8_STAGE(PG8_SB(1, 0), cB + kstep, voffB); PG8_STAGE(PG8_SA(1, 0), cA + kstep, voffA); PG8_STAGE(PG8_SB(1, 1), cB + hstepB + kstep, voffB);
        PG8_WAIT_V(6); PG8_BAR;
    }
    for (;;) {
        const bool has_next = S.next(ui + 1, nxt);
        const char* nA = has_next ? (const char*)g.A + (size_t)nxt.pm * tstepA : cA; const char* nB = has_next ? (const char*)g.Bt + (size_t)nxt.pn * tstepB : cB;
        for (int t = 0; t < nt; t += 2) {
            const bool last = (t == nt - 2);
            const char* a1 = cA + (size_t)(t + 1) * kstep;
            const char* a2 = last ? nA : cA + (size_t)(t + 2) * kstep; const char* b2 = last ? nB : cB + (size_t)(t + 2) * kstep;
            const char* a3 = a2 + kstep; const char* b3 = b2 + kstep;
            if (last && has_next) S.a_ready(nxt);
            if constexpr (SP2) {
            PG8_LDB(B0, 0, 0); PG8_LDB(B1, 0, 1); PG8_SCHED; PG8_LDA(At, 0, 0); PG8_STAGE(PG8_SA(1, 1), a1 + hstepA, voffA);
            PG8_WAIT_V(8); PG8_WAIT_L(0); PG8_BAR; PG8_MMA(0, 0, At, B0); PG8_MMA(0, 1, At, B1); PG8_BAR; PG8_SCHED;
            PG8_LDA(At, 0, 1); PG8_STAGE(PG8_SB(0, 0), b2, voffB); PG8_STAGE(PG8_SB(0, 1), b2 + hstepB, voffB); PG8_STAGE(PG8_SA(0, 0), a2, voffA);
            PG8_WAIT_V(8); PG8_WAIT_L(0); PG8_BAR; PG8_MMA(1, 0, At, B0); PG8_MMA(1, 1, At, B1); PG8_BAR; PG8_SCHED;
            PG8_LDB(B0, 1, 0); PG8_LDB(B1, 1, 1); PG8_SCHED; PG8_LDA(At, 1, 0); PG8_STAGE(PG8_SA(0, 1), a2 + hstepA, voffA);
            PG8_WAIT_V(8); PG8_WAIT_L(0); PG8_BAR; PG8_MMA(0, 0, At, B0); PG8_MMA(0, 1, At, B1); PG8_BAR; PG8_SCHED;
            PG8_LDA(At, 1, 1); PG8_STAGE(PG8_SB(1, 0), b3, voffB); PG8_STAGE(PG8_SB(1, 1), b3 + hstepB, voffB); PG8_STAGE(PG8_SA(1, 0), a3, voffA);
            PG8_WAIT_V(8); PG8_WAIT_L(0); PG8_BAR; PG8_MMA(1, 0, At, B0); PG8_MMA(1, 1, At, B1); PG8_BAR; PG8_SCHED;
            } else {
            PG8_LDB(B0, 0, 0); PG8_SCHED; PG8_LDA(At, 0, 0); PG8_STAGE(PG8_SA(1, 1), a1 + hstepA, voffA);
            PG8_WAIT_L(8); PG8_BAR; PG8_WAIT_L(0); PG8_MMA(0, 0, At, B0); PG8_BAR; PG8_SCHED;
            PG8_LDB(B1, 0, 1); PG8_STAGE(PG8_SB(0, 0), b2, voffB);
            PG8_BAR; PG8_WAIT_L(0); PG8_MMA(0, 1, At, B1); PG8_BAR;
            PG8_LDA(At, 0, 1); PG8_STAGE(PG8_SA(0, 0), a2, voffA);
            PG8_BAR; PG8_WAIT_L(0); PG8_MMA(1, 0, At, B0); PG8_BAR; PG8_SCHED;
            PG8_STAGE(PG8_SB(0, 1), b2 + hstepB, voffB);
            PG8_WAIT_V(6); PG8_BAR; PG8_MMA(1, 1, At, B1); PG8_BAR;
            PG8_LDB(B0, 1, 0); PG8_SCHED; PG8_LDA(At, 1, 0); PG8_STAGE(PG8_SA(0, 1), a2 + hstepA, voffA);
            PG8_WAIT_L(8); PG8_BAR; PG8_WAIT_L(0); PG8_MMA(0, 0, At, B0); PG8_BAR; PG8_SCHED;
            PG8_LDB(B1, 1, 1); PG8_STAGE(PG8_SB(1, 0), b3, voffB);
            PG8_BAR; PG8_WAIT_L(0); PG8_MMA(0, 1, At, B1); PG8_BAR;
            PG8_LDA(At, 1, 1); PG8_STAGE(PG8_SA(1, 0), a3, voffA);
            PG8_BAR; PG8_WAIT_L(0); PG8_MMA(1, 0, At, B0); PG8_BAR; PG8_SCHED;
            PG8_STAGE(PG8_SB(1, 1), b3 + hstepB, voffB);
            PG8_WAIT_V(6); PG8_BAR; PG8_MMA(1, 1, At, B1); PG8_BAR;
            }
        }
        if constexpr (ALIGN_EPI) { if (wr == 0) PG8_BAR; }
        if constexpr (!Epi::AFTER_DRAIN) { E(acc, cur, wr, wc, fr, fq); S.done(cur); }
        if (!has_next) break;
#pragma unroll
        for (int a = 0; a < 2; ++a)
#pragma unroll
            for (int b = 0; b < 2; ++b)
#pragma unroll
                for (int m = 0; m < 4; ++m)
#pragma unroll
                    for (int n = 0; n < 2; ++n) acc[a][b][m][n] = (f32x4){0.f, 0.f, 0.f, 0.f};
        cur = nxt; cA = nA; cB = nB; ++ui;
        if constexpr (ALIGN_EPI) { if (wr == 1) PG8_BAR; }
    }
    PG8_WAIT_V(0);
    if constexpr (!ALIGN_EPI) { if (wr == 0) PG8_BAR; }
    PG8_BAR;
    if constexpr (Epi::AFTER_DRAIN) { E.fused(acc, cur, wr, wc, fr, fq, lds, wid, lane); S.done(cur); }
#undef PG8_SA
#undef PG8_SB
#undef PG8_STAGE
#undef PG8_LDA
#undef PG8_LDB
#undef PG8_MMA
#undef PG8_WAIT_V
#undef PG8_WAIT_L
#undef PG8_BAR
#undef PG8_SCHED
}
}
constexpr int NB = 16, SEQ = 2048, D = 1024, DEPTH = 4, M = NB * SEQ, PIN = 2568, NP = 2560, FF = 4096, NMOD = 6144;
constexpr int NWAVES = 8, NTHR = 512;
constexpr float EPS = 1e-6f;
constexpr int PC_QA = 0, PC_KA = 256, PC_VA = 512, PC_GATE = 768, PC_UB = 1024, PC_VB = 1280, PC_XC = 1536, PC_QD = 1792, PC_KD = 2048, PC_VD = 2304;
constexpr int YC_A = 0, YC_B = 256, YC_C = 512, YC_D = 768;
enum { I_X = 0, I_C, I_WMOD, I_BMOD, I_GN1, I_GN2, I_WIN, I_CONV, I_ALOG, I_DTB, I_GOA, I_GLNB, I_WSG, I_BSG, I_WPOOL, I_SPOOL, I_GOD, I_WOUT, I_WFF1, I_WFF2, I_GFIN, N_IN };

constexpr size_t MiB = 1u << 20;
constexpr size_t WS_CTL = 0, CTL_ZERO_BYTES = 1 * MiB;
constexpr size_t WS_MOD = 1 * MiB;
constexpr size_t WS_SW1 = 3 * MiB;
constexpr size_t WS_SWAB = 3 * MiB + 768 * 1024;
constexpr size_t WS_SW2 = 4 * MiB;
constexpr size_t WS_WAB = 5 * MiB;
constexpr size_t WS_WSG = 5 * MiB + 256 * 1024;
constexpr size_t WS_WPT = 5 * MiB + 768 * 1024;
constexpr size_t WS_QSA = 7 * MiB + 256 * 1024;
constexpr size_t WS_QSA1 = 7 * MiB + 512 * 1024;
constexpr size_t WS_QSB1 = 7 * MiB + 768 * 1024;
constexpr size_t WS_QSB2 = 7 * MiB + 896 * 1024;
constexpr size_t WS_QCS2 = 7 * MiB + 928 * 1024;
constexpr size_t WS_QSBO = 7 * MiB + 960 * 1024;
constexpr size_t WS_ZERO = 512 * 1024;
constexpr size_t WS_QSB = 7 * MiB;
constexpr size_t WS_ABLOG = 6 * MiB;
constexpr size_t WS_SSQ1 = 8 * MiB, WS_SSQ2 = 10 * MiB;
constexpr size_t WS_BETA = 12 * MiB, WS_GLOG = 13 * MiB;
constexpr size_t WS_WIN = 16 * MiB;
constexpr size_t WS_WOUT = 36 * MiB;
constexpr size_t WS_WFF1 = 44 * MiB;
constexpr size_t WS_WFF2 = 76 * MiB;
constexpr size_t WS_XQ = 144 * MiB;
constexpr size_t WS_XG = 112 * MiB;
constexpr size_t WS_HID = 176 * MiB;
constexpr size_t WS_P = 176 * MiB;
constexpr size_t WS_Y = 336 * MiB;
constexpr size_t WS_CHA = 112 * MiB, WS_CHB = 400 * MiB;
constexpr size_t WS_XB = 448 * MiB;
constexpr size_t WS_END = 512 * MiB;
constexpr int CW_BAR = 4096;
constexpr int CW_XRANK = 24576;
constexpr int CW_DNCNT = 16384;

constexpr int RING_BYTES = 131072, LDS_BYTES = 163840, MISC_OFF = LDS_BYTES - 256;

#define LAS __attribute__((address_space(3)))
typedef unsigned short bf16;
typedef float f32x4 __attribute__((ext_vector_type(4)));
typedef unsigned u32x4 __attribute__((ext_vector_type(4)));
typedef unsigned u32x2 __attribute__((ext_vector_type(2)));
__device__ __forceinline__ float bf2f(unsigned v) { return __uint_as_float(v << 16); }
__device__ __forceinline__ unsigned f2bf(float f) { unsigned u = __float_as_uint(f); return (u + 0x7fffu + ((u >> 16) & 1u)) >> 16; }
__device__ __forceinline__ unsigned pk2(float lo, float hi) { return f2bf(lo) | (f2bf(hi) << 16); }
__device__ __forceinline__ float wave_sum(float v) {
#pragma unroll
    for (int o = 1; o < 64; o <<= 1) v += __shfl_xor(v, o);
    return v;
}
__device__ __forceinline__ float rdlane(float v, int l) { return __builtin_bit_cast(float, __builtin_amdgcn_readlane(__builtin_bit_cast(int, v), l)); }
__device__ __forceinline__ float silu_f(float x) { return x * __builtin_amdgcn_rcpf(1.0f + __expf(-x)); }
__device__ __forceinline__ float sigmoid_f(float x) { return __builtin_amdgcn_rcpf(1.0f + __expf(-x)); }
__device__ __forceinline__ float softplus_f(float x) { return fmaxf(x, 0.f) + __logf(1.0f + __expf(-fabsf(x))); }
#define GAS __attribute__((address_space(1)))
template <class T> __device__ __forceinline__ T* as_global(T* p) { return p; }
constexpr float YCLIP8 = 8.0f;
__device__ __forceinline__ unsigned q8x4(float a, float b, float c, float d) {
    constexpr float k = 127.0f / YCLIP8; unsigned w = 0u;
    w = __builtin_amdgcn_cvt_pk_u8_f32(__builtin_fmaf(a, k, 128.0f), 0, w); w = __builtin_amdgcn_cvt_pk_u8_f32(__builtin_fmaf(b, k, 128.0f), 1, w);
    w = __builtin_amdgcn_cvt_pk_u8_f32(__builtin_fmaf(c, k, 128.0f), 2, w); w = __builtin_amdgcn_cvt_pk_u8_f32(__builtin_fmaf(d, k, 128.0f), 3, w);
    return w ^ 0x80808080u; }
template <class T> __device__ __forceinline__ T* uni_ptr(T* p) { const unsigned long long v = (unsigned long long)p; const unsigned lo = __builtin_amdgcn_readfirstlane((unsigned)v), hi = __builtin_amdgcn_readfirstlane((unsigned)(v >> 32)); return as_global((T*)(((unsigned long long)hi << 32) | lo)); }
#define XB_TMO      128
#define XB_XCNT(j)  (256  + 64 * (j))
#define XB_XSUB(j)  (1280 + 64 * (j))
#define XB_XGEN(j)  (2304 + 64 * (j))
#define XB_TOP      3328
#define XB_TOPGEN   3392
#define XCD_BAR_WORDS 3456
#define XB_SPIN_CAP (1u << 18)

__device__ __forceinline__ unsigned xb_ld(unsigned* p)              { return __hip_atomic_load(p, __ATOMIC_RELAXED, __HIP_MEMORY_SCOPE_AGENT); }
__device__ __forceinline__ unsigned xb_add(unsigned* p, unsigned v) { return __hip_atomic_fetch_add(p, v, __ATOMIC_RELAXED, __HIP_MEMORY_SCOPE_AGENT); }
__device__ __forceinline__ unsigned xb_xcc_id() { return (unsigned)__builtin_amdgcn_s_getreg((3 << 11) | 20) & 0xFu; }
#define XB_SPIN(cond, bar) do { unsigned _sp = 0; while (cond) { __builtin_amdgcn_s_sleep(1); \
    if ((++_sp & 255u) == 0u) { if (xb_ld(&(bar)[XB_TMO])) break; if (_sp > XB_SPIN_CAP) { atomicAdd(&(bar)[XB_TMO], 1u); break; } } } } while (0)

struct XcdBarrier {
    unsigned* bar; unsigned x;
    volatile LAS unsigned* st;
};

__device__ __forceinline__ XcdBarrier xcd_barrier_post(unsigned* bar, volatile LAS unsigned* st) {
    XcdBarrier b; b.bar = bar; b.x = xb_xcc_id(); b.st = st;
    if (threadIdx.x == 0) (void)xb_add(&bar[XB_XCNT(b.x)], 1u);
    return b;
}
__device__ __forceinline__ void xcd_barrier_complete(unsigned* bar, unsigned x, unsigned& nloc, unsigned& nx) {
    const unsigned G = gridDim.x * gridDim.y * gridDim.z;
    unsigned sum, cnt, mine, sp = 0u;
    for (;;) {
        sum = 0u; cnt = 0u; mine = 0u;
#pragma unroll
        for (unsigned j = 0; j < 16; ++j) { const unsigned c = xb_ld(&bar[XB_XCNT(j)]); sum += c; cnt += (c > 0u) ? 1u : 0u; mine = (j == x) ? c : mine; }
        if (sum == G) break;
        __builtin_amdgcn_s_sleep(1);
        if ((++sp & 255u) == 0u) { if (xb_ld(&bar[XB_TMO])) break; if (sp > XB_SPIN_CAP) { atomicAdd(&bar[XB_TMO], 1u); break; } }
    }
    nloc = mine > 0u ? mine : 1u; nx = cnt > 0u ? cnt : 1u;
}

__device__ __forceinline__ void xcd_barrier(const XcdBarrier& b) {
    asm volatile("s_waitcnt vmcnt(0)" ::: "memory");
    __syncthreads();
    if (threadIdx.x == 0) {
        unsigned* bar = b.bar;
        __builtin_amdgcn_s_waitcnt(0);
        unsigned nloc = b.st[0], nx = b.st[1];
        if (nloc == 0u) { xcd_barrier_complete(bar, b.x, nloc, nx); b.st[0] = nloc; b.st[1] = nx; }
        const unsigned old = xb_add(&bar[XB_XSUB(b.x)], 1u);
        const unsigned gen = old / nloc;
        if (old + 1u == (gen + 1u) * nloc) {
            __builtin_amdgcn_fence(__ATOMIC_RELEASE, "agent");
            asm volatile("s_waitcnt vmcnt(0)" ::: "memory");
            const unsigned og = xb_add(&bar[XB_TOP], 1u);
            const unsigned tg = og / nx;
            if (og + 1u == (tg + 1u) * nx) xb_add(&bar[XB_TOPGEN], 1u);
            else XB_SPIN(xb_ld(&bar[XB_TOPGEN]) == tg, bar);
            __builtin_amdgcn_fence(__ATOMIC_ACQUIRE, "agent");
            xb_add(&bar[XB_XGEN(b.x)], 1u);
            asm volatile("s_waitcnt vmcnt(0)" ::: "memory");
        } else {
            XB_SPIN(xb_ld(&bar[XB_XGEN(b.x)]) == gen, bar);
            __builtin_amdgcn_fence(__ATOMIC_ACQUIRE, "agent");
            asm volatile("s_waitcnt vmcnt(0)" ::: "memory");
        }
    }
    __syncthreads();
}
struct Frame {
    LAS unsigned char* lds;
    int tid, lane, wave, G, bid;
    unsigned char* ws;
    const float* const* in;
    float* out;
};
#define WSP(T, off) (as_global((T*)(F.ws + (off))))
#define GIN(i) (as_global(F.in[i]))

template <class Writer>
__device__ __forceinline__ void gemm16_unit(Frame& F, const float* W, int ldw, int N, int n0, LAS float* lhsT, LAS float* red, const Writer& wr) {
    const int n = n0 + F.lane; const bool ok = n < N;
    float acc[16];
#pragma unroll
    for (int b = 0; b < 16; ++b) acc[b] = 0.f;
    const int kbeg = F.wave * 128;
    const float* wp = W + (size_t)kbeg * ldw + (ok ? n : 0);
    for (int k0 = 0; k0 < 128; k0 += 32) {
        float wv[32];
#pragma unroll
        for (int j = 0; j < 32; ++j) wv[j] = ok ? wp[(size_t)(k0 + j) * ldw] : 0.f;
#pragma unroll
        for (int j = 0; j < 32; ++j) { const float w = wv[j];
            const LAS f32x4* lp = (const LAS f32x4*)(lhsT + (kbeg + k0 + j) * 16);
            const f32x4 l0 = lp[0], l1 = lp[1], l2 = lp[2], l3 = lp[3];
            acc[0] += l0[0] * w; acc[1] += l0[1] * w; acc[2] += l0[2] * w; acc[3] += l0[3] * w;
            acc[4] += l1[0] * w; acc[5] += l1[1] * w; acc[6] += l1[2] * w; acc[7] += l1[3] * w;
            acc[8] += l2[0] * w; acc[9] += l2[1] * w; acc[10] += l2[2] * w; acc[11] += l2[3] * w;
            acc[12] += l3[0] * w; acc[13] += l3[1] * w; acc[14] += l3[2] * w; acc[15] += l3[3] * w;
            if ((j & 7) == 7) asm volatile("" ::: "memory"); }
    }
#pragma unroll
    for (int b = 0; b < 16; ++b) red[(F.wave * 16 + b) * 64 + F.lane] = acc[b];
    __syncthreads();
    for (int o_ = F.tid; o_ < 1024; o_ += NTHR) { int o = o_; asm volatile("" : "+v"(o)); const int b = o >> 6, nn = o & 63; float s = 0.f;
#pragma unroll
        for (int w = 0; w < 8; ++w) s += red[(w * 16 + b) * 64 + nn];
        if (n0 + nn < N) wr(b, n0 + nn, s); }
    __syncthreads();
}

__device__ __forceinline__ void transpose_item(const float* W, int ldw, int csrc, int k0, bf16* WT, int Kd, int rdst, LAS float* scr, int lane) {
    float tv[32];
#pragma unroll
    for (int i = 0; i < 32; ++i) tv[i] = W[(size_t)(k0 + 2 * i + (lane >> 5)) * ldw + csrc + (lane & 31)];
#pragma unroll
    for (int i = 0; i < 32; ++i) scr[(2 * i + (lane >> 5)) * 33 + (lane & 31)] = tv[i];
    asm volatile("s_waitcnt lgkmcnt(0)" ::: "memory");
    const int c = lane & 7;
#pragma unroll
    for (int j = 0; j < 4; ++j) { const int n = (lane >> 3) + 8 * j; const LAS float* s = scr + (8 * c) * 33 + n;
        u32x4 o; o.x = pk2(s[0 * 33], s[1 * 33]); o.y = pk2(s[2 * 33], s[3 * 33]); o.z = pk2(s[4 * 33], s[5 * 33]); o.w = pk2(s[6 * 33], s[7 * 33]);
        *(u32x4*)(WT + (size_t)(rdst + n) * Kd + k0 + 8 * c) = o; }
    asm volatile("s_waitcnt lgkmcnt(0)" ::: "memory");
}

__device__ __forceinline__ void p0a(Frame& F) {
    LAS float* lhsT = (LAS float*)F.lds; LAS float* red = (LAS float*)(F.lds + 65536);
    const float* c = GIN(I_C);
    float* mod = WSP(float, WS_MOD);
    bool filled = false;
    for (int u = F.bid; u < DEPTH * 96; u += F.G) {
        if (!filled) { for (int i = F.tid; i < 16384; i += NTHR) { const int b = i >> 10, k = i & 1023; lhsT[k * 16 + b] = silu_f(c[i]); } __syncthreads(); filled = true; }
        const int l = u / 96, n0 = (u % 96) * 64;
        const float* bm = GIN(I_BMOD) + (size_t)l * NMOD; float* mo = mod + (size_t)l * 16 * NMOD;
        gemm16_unit(F, GIN(I_WMOD) + (size_t)l * D * NMOD, NMOD, NMOD, n0, lhsT, red, [=](int b, int n, float s) { mo[(size_t)b * NMOD + n] = s + bm[n]; });
    }
    __syncthreads();
    LAS float* scr = (LAS float*)(F.lds + F.wave * 8448);
    const int gw = F.bid * NWAVES + F.wave, NGW = F.G * NWAVES;
    constexpr int IT_IN = 16 * 80, IT_OUT = 16 * 32, IT_F1 = 16 * 128, IT_F2 = 64 * 32, IT_L = IT_IN + IT_OUT + IT_F1 + IT_F2;
    for (int it = gw; it < DEPTH * IT_L; it += NGW) {
        const int l = it / IT_L; int r = it % IT_L;
        if (r < IT_IN) { const int kb = r / 80, nb = r % 80, n0 = nb * 32; transpose_item(GIN(I_WIN) + (size_t)l * D * PIN, PIN, n0 < 768 ? n0 : n0 + 8, kb * 64, WSP(bf16, WS_WIN) + (size_t)l * NP * D, D, n0, scr, F.lane); continue; }
        r -= IT_IN;
        if (r < IT_OUT) { const int kb = r / 32, nb = r % 32; transpose_item(GIN(I_WOUT) + (size_t)l * D * D, D, nb * 32, kb * 64, WSP(bf16, WS_WOUT) + (size_t)l * D * D, D, nb * 32, scr, F.lane); continue; }
        r -= IT_OUT;
        if (r < IT_F1) { const int kb = r / 128, nb = r % 128; transpose_item(GIN(I_WFF1) + (size_t)l * D * FF, FF, nb * 32, kb * 64, WSP(bf16, WS_WFF1) + (size_t)l * FF * D, D, nb * 32, scr, F.lane); continue; }
        r -= IT_F1;
        { const int kb = r / 32, nb = r % 32; transpose_item(GIN(I_WFF2) + (size_t)l * FF * D, D, nb * 32, kb * 64, WSP(bf16, WS_WFF2) + (size_t)l * D * FF, FF, nb * 32, scr, F.lane); }
    }
    { bf16* wsgb = WSP(bf16, WS_WSG); const float* wsg = GIN(I_WSG);
      for (int i = F.bid * NTHR + F.tid; i < DEPTH * 4 * 128 * 128; i += F.G * NTHR) wsgb[i] = (bf16)f2bf(wsg[i]);
      bf16* wpt = WSP(bf16, WS_WPT); const float* wp = GIN(I_WPOOL);
      for (int i = F.bid * NTHR + F.tid; i < DEPTH * 4 * 64 * 64; i += F.G * NTHR) { const int lg = i >> 12, d = (i >> 6) & 63, c = i & 63; wpt[i] = (bf16)f2bf(wp[(lg * 64 + c) * 64 + d]); } }
    bf16* wab = WSP(bf16, WS_WAB);
    for (int i = F.bid * NTHR + F.tid; i < DEPTH * 16 * D; i += F.G * NTHR) { const int l = i / (16 * D), j = (i / D) & 15, k = i % D;
        wab[i] = j < 8 ? (bf16)f2bf(GIN(I_WIN)[((size_t)l * D + k) * PIN + 768 + j]) : (bf16)0; }
}

__device__ __forceinline__ void p0b(Frame& F) {
    LAS float* lhsT = (LAS float*)F.lds; LAS float* red = (LAS float*)(F.lds + 65536);
    const float* mod = WSP(float, WS_MOD);
    for (int u = F.bid; u < DEPTH * 105; u += F.G) {
        const int l = u / 105, r = u % 105; const bool first = r < 41;
        const float* ml = mod + (size_t)l * 16 * NMOD + (first ? 0 : 3 * D);
        for (int i = F.tid; i < 16384; i += NTHR) { const int b = i >> 10, k = i & 1023; lhsT[k * 16 + b] = ml[(size_t)b * NMOD + k]; }
        __syncthreads();
        if (first) { float* sw1 = WSP(float, WS_SW1) + (size_t)l * 16 * NP; float* swab = WSP(float, WS_SWAB) + (size_t)l * 16 * 8;
            gemm16_unit(F, GIN(I_WIN) + (size_t)l * D * PIN, PIN, PIN, r * 64, lhsT, red, [=](int b, int n, float s) {
                if (n < 768) sw1[b * NP + n] = s; else if (n < 776) swab[b * 8 + (n - 768)] = s; else sw1[b * NP + n - 8] = s; }); }
        else { float* sw2 = WSP(float, WS_SW2) + (size_t)l * 16 * FF;
            gemm16_unit(F, GIN(I_WFF1) + (size_t)l * D * FF, FF, FF, (r - 41) * 64, lhsT, red, [=](int b, int n, float s) { sw2[b * FF + n] = s; }); }
    }
    { const int gw_ = F.bid * NWAVES + F.wave, NGW_ = F.G * NWAVES;
      constexpr int NR1 = DEPTH * FF, NR2 = DEPTH * NP, NR3 = DEPTH * 16, NR4 = DEPTH * D;
      for (int it = gw_; it < NR1 + NR2 + NR3 + NR4; it += NGW_) {
          bf16* wq; float* sc; int n;
          if (it >= NR1 + NR2 + NR3) { n = it - NR1 - NR2 - NR3; wq = WSP(bf16, WS_WOUT); sc = WSP(float, WS_QSBO); } else
          if (it < NR1) { n = it; wq = WSP(bf16, WS_WFF1); sc = WSP(float, WS_QSB); } else if (it < NR1 + NR2) { n = it - NR1; wq = WSP(bf16, WS_WIN); sc = WSP(float, WS_QSB1); } else { n = it - NR1 - NR2; wq = WSP(bf16, WS_WAB); sc = WSP(float, WS_QSB1) + 16384; }
          bf16* rowp = wq + (size_t)n * D + 16 * F.lane; u32x4 a = *(u32x4*)rowp, b = *(u32x4*)(rowp + 8);
          float v[16]; v[0] = bf2f(a.x & 0xffffu); v[1] = bf2f(a.x >> 16); v[2] = bf2f(a.y & 0xffffu); v[3] = bf2f(a.y >> 16); v[4] = bf2f(a.z & 0xffffu); v[5] = bf2f(a.z >> 16); v[6] = bf2f(a.w & 0xffffu); v[7] = bf2f(a.w >> 16);
          v[8] = bf2f(b.x & 0xffffu); v[9] = bf2f(b.x >> 16); v[10] = bf2f(b.y & 0xffffu); v[11] = bf2f(b.y >> 16); v[12] = bf2f(b.z & 0xffffu); v[13] = bf2f(b.z >> 16); v[14] = bf2f(b.w & 0xffffu); v[15] = bf2f(b.w >> 16);
          float mx = 0.f;
#pragma unroll
          for (int j = 0; j < 16; ++j) mx = fmaxf(mx, fabsf(v[j]));
#pragma unroll
          for (int o = 1; o < 64; o <<= 1) mx = fmaxf(mx, __shfl_xor(mx, o));
          const float sc_ = mx > 0.f ? mx * (1.0f / 127.0f) : 1.0f, is_ = 1.0f / sc_;
#pragma unroll
          for (int j = 0; j < 16; ++j) v[j] = __builtin_rintf(v[j] * is_);
          u32x4 oq;
          oq.x = ((unsigned)((int)v[0] & 255)) | ((unsigned)((int)v[1] & 255) << 8) | ((unsigned)((int)v[2] & 255) << 16) | ((unsigned)((int)v[3] & 255) << 24);
          oq.y = ((unsigned)((int)v[4] & 255)) | ((unsigned)((int)v[5] & 255) << 8) | ((unsigned)((int)v[6] & 255) << 16) | ((unsigned)((int)v[7] & 255) << 24);
          oq.z = ((unsigned)((int)v[8] & 255)) | ((unsigned)((int)v[9] & 255) << 8) | ((unsigned)((int)v[10] & 255) << 16) | ((unsigned)((int)v[11] & 255) << 24);
          oq.w = ((unsigned)((int)v[12] & 255)) | ((unsigned)((int)v[13] & 255) << 8) | ((unsigned)((int)v[14] & 255) << 16) | ((unsigned)((int)v[15] & 255) << 24);
          asm volatile("s_waitcnt vmcnt(0)" ::: "memory");
          *(u32x4*)((unsigned char*)(wq + (size_t)n * D) + 16 * F.lane) = oq; if (F.lane == 0) sc[n] = it >= NR1 + NR2 + NR3 ? sc_ * (YCLIP8 / 127.0f) : sc_; } }
    { const int gw_ = F.bid * NWAVES + F.wave, NGW_ = F.G * NWAVES; bf16* wq = WSP(bf16, WS_WFF2); float* sc2 = WSP(float, WS_QSB2); int* cs2 = WSP(int, WS_QCS2);
      for (int n = gw_; n < DEPTH * D; n += NGW_) { const u32x4* rp = (const u32x4*)(wq + (size_t)n * FF + 64 * F.lane); u32x4 in[8]; float mx = 0.f;
#pragma unroll
          for (int j = 0; j < 8; ++j) { in[j] = rp[j]; mx = fmaxf(mx, fmaxf(fmaxf(fmaxf(fabsf(bf2f(in[j].x & 0xffffu)), fabsf(bf2f(in[j].x >> 16))), fmaxf(fabsf(bf2f(in[j].y & 0xffffu)), fabsf(bf2f(in[j].y >> 16)))), fmaxf(fmaxf(fabsf(bf2f(in[j].z & 0xffffu)), fabsf(bf2f(in[j].z >> 16))), fmaxf(fabsf(bf2f(in[j].w & 0xffffu)), fabsf(bf2f(in[j].w >> 16)))))); }
#pragma unroll
          for (int o = 1; o < 64; o <<= 1) mx = fmaxf(mx, __shfl_xor(mx, o));
          const float sc_ = mx > 0.f ? mx * (1.0f / 127.0f) : 1.0f, is_ = 1.0f / sc_; int sum = 0; u32x4 oq[4];
#pragma unroll
          for (int j = 0; j < 8; ++j) { const int q0 = (int)__builtin_rintf(bf2f(in[j].x & 0xffffu) * is_), q1 = (int)__builtin_rintf(bf2f(in[j].x >> 16) * is_), q2 = (int)__builtin_rintf(bf2f(in[j].y & 0xffffu) * is_), q3 = (int)__builtin_rintf(bf2f(in[j].y >> 16) * is_);
              const int q4 = (int)__builtin_rintf(bf2f(in[j].z & 0xffffu) * is_), q5 = (int)__builtin_rintf(bf2f(in[j].z >> 16) * is_), q6 = (int)__builtin_rintf(bf2f(in[j].w & 0xffffu) * is_), q7 = (int)__builtin_rintf(bf2f(in[j].w >> 16) * is_);
              sum += ((q0 + q1) + (q2 + q3)) + ((q4 + q5) + (q6 + q7));
              const unsigned lo = (unsigned)(q0 & 255) | ((unsigned)(q1 & 255) << 8) | ((unsigned)(q2 & 255) << 16) | ((unsigned)(q3 & 255) << 24), hi = (unsigned)(q4 & 255) | ((unsigned)(q5 & 255) << 8) | ((unsigned)(q6 & 255) << 16) | ((unsigned)(q7 & 255) << 24);
              if (j & 1) { oq[j >> 1].z = lo; oq[j >> 1].w = hi; } else { oq[j >> 1].x = lo; oq[j >> 1].y = hi; } }
#pragma unroll
          for (int o = 1; o < 64; o <<= 1) sum += __shfl_xor(sum, o);
          asm volatile("s_waitcnt vmcnt(0)" ::: "memory");
          u32x4* op = (u32x4*)((unsigned char*)(wq + (size_t)n * FF) + 64 * F.lane);
#pragma unroll
          for (int j = 0; j < 4; ++j) op[j] = oq[j];
          if (F.lane == 0) { sc2[n] = sc_ * (pg8::HCLIP8 / 255.0f); cs2[n] = sum; } } }
    const int gw = F.bid * NWAVES + F.wave, NGW = F.G * NWAVES;
    const float* x = GIN(I_X); const float* gn = GIN(I_GN1); bf16* xg = WSP(bf16, WS_XG); float* ssq = WSP(float, WS_SSQ1);
    unsigned char* xq = WSP(unsigned char, WS_XG); float* qsa1 = WSP(float, WS_QSA1); bf16* xb0 = WSP(bf16, WS_XB);
    for (int r = gw; r < M; r += 2 * NGW) {
        const int r2 = r + NGW < M ? r + NGW : r;
        const f32x4* xa = (const f32x4*)(x + (size_t)r * D) + F.lane; const f32x4* xb = (const f32x4*)(x + (size_t)r2 * D) + F.lane; f32x4 va[4], vb[4];
#pragma unroll
        for (int j = 0; j < 4; ++j) { va[j] = xa[64 * j]; vb[j] = xb[64 * j]; }
        float sa = 0.f, sb = 0.f;
#pragma unroll
        for (int j = 0; j < 4; ++j) { sa += (va[j][0] * va[j][0] + va[j][1] * va[j][1]) + (va[j][2] * va[j][2] + va[j][3] * va[j][3]); sb += (vb[j][0] * vb[j][0] + vb[j][1] * vb[j][1]) + (vb[j][2] * vb[j][2] + vb[j][3] * vb[j][3]); }
        sa = wave_sum(sa); sb = wave_sum(sb);
        const float rra = __builtin_amdgcn_rsqf(sa * (1.0f / 1024.0f) + 1e-6f), rrb = __builtin_amdgcn_rsqf(sb * (1.0f / 1024.0f) + 1e-6f), isa = 127.0f * rra * (1.0f / pg8::QCLIP8), isb = 127.0f * rrb * (1.0f / pg8::QCLIP8);
        const float* sca = mod + (size_t)(r >> 11) * NMOD + D; const float* scb = mod + (size_t)(r2 >> 11) * NMOD + D;
#pragma unroll
        for (int j = 0; j < 4; ++j) { const int cc = 256 * j + 4 * F.lane; const f32x4 g = *(const f32x4*)(gn + cc), qa = *(const f32x4*)(sca + cc), qb = *(const f32x4*)(scb + cc);
            const f32x4 za = va[j] * (g * (qa + 1.0f)) * isa, zb = vb[j] * (g * (qb + 1.0f)) * isb; unsigned wa = 0u, wb = 0u;
#pragma unroll
            for (int i = 0; i < 4; ++i) { wa |= ((unsigned)((int)fminf(fmaxf(__builtin_rintf(za[i]), -127.f), 127.f) & 255)) << (8 * i); wb |= ((unsigned)((int)fminf(fmaxf(__builtin_rintf(zb[i]), -127.f), 127.f) & 255)) << (8 * i); }
            *(unsigned*)(xq + (size_t)r * D + cc) = wa; *(unsigned*)(xq + (size_t)r2 * D + cc) = wb;
            *(u32x2*)(xb0 + (size_t)r * D + cc) = (u32x2){pk2(va[j][0], va[j][1]), pk2(va[j][2], va[j][3])}; *(u32x2*)(xb0 + (size_t)r2 * D + cc) = (u32x2){pk2(vb[j][0], vb[j][1]), pk2(vb[j][2], vb[j][3])}; }
        if (F.lane < 16) { ssq[(size_t)r * 16 + F.lane] = F.lane == 0 ? sa : 0.f; ssq[(size_t)r2 * 16 + F.lane] = F.lane == 0 ? sb : 0.f; }
        if (F.lane == 0) { qsa1[r] = pg8::QCLIP8 / (127.0f * rra); qsa1[r2] = pg8::QCLIP8 / (127.0f * rrb); }
    }
}

__device__ __forceinline__ void ab_logits(Frame& F, int l) {
    typedef int i32x4_ __attribute__((ext_vector_type(4)));
    const int gw = F.bid * NWAVES + F.wave, NGW = F.G * NWAVES, n = F.lane & 15, kq = F.lane >> 4;
    const unsigned char* xq = WSP(unsigned char, WS_XG); const unsigned char* wab = (const unsigned char*)(WSP(bf16, WS_WAB) + (size_t)l * 16 * D); const float* ssq = WSP(float, WS_SSQ1);
    const float* swab = WSP(float, WS_SWAB) + (size_t)l * 16 * 8; float* ab = WSP(float, WS_ABLOG); const float* qsa1 = WSP(float, WS_QSA1); const float* qsbab = WSP(float, WS_QSB1) + 16384 + l * 16;
    for (int tile = gw; tile < M / 16; tile += NGW) { const int r0 = tile * 16;
        const unsigned char* ap = xq + (size_t)(r0 + n) * D + 16 * kq; const unsigned char* bp = wab + (size_t)n * (2 * D) + 16 * kq;
        i32x4_ acc0 = (i32x4_){0, 0, 0, 0}, acc1 = acc0;
        float rq[4];
#pragma unroll
        for (int i = 0; i < 4; ++i) { const int row = r0 + 4 * kq + i; rq[i] = pg8::row_rstd(ssq, row) * qsa1[row]; }
        i32x4_ af[16], bw[16];
#pragma unroll
        for (int ks = 0; ks < 16; ++ks) { af[ks] = *(const i32x4_*)(ap + 64 * ks); bw[ks] = *(const i32x4_*)(bp + 64 * ks); }
        asm volatile("" ::: "memory");
#pragma unroll
        for (int ks = 0; ks < 16; ks += 2) {
            acc0 = __builtin_amdgcn_mfma_i32_16x16x64_i8(af[ks], bw[ks], acc0, 0, 0, 0);
            acc1 = __builtin_amdgcn_mfma_i32_16x16x64_i8(af[ks + 1], bw[ks + 1], acc1, 0, 0, 0); }
        const i32x4_ acc = acc0 + acc1;
        if (n < 8) { const int b = r0 >> 11; const float sb_ = swab[b * 8 + n], wsc = qsbab[n];
#pragma unroll
            for (int i = 0; i < 4; ++i) { const int row = r0 + 4 * kq + i; ab[(size_t)row * 8 + n] = rq[i] * wsc * (float)acc[i] + sb_; } }
    }
}

__device__ __forceinline__ void sg_simple(Frame& F, int l, int unit) {
    const int b = unit >> 4, nblk = unit & 15; const size_t r0 = (size_t)b * SEQ + nblk * 128;
    const bf16* P = WSP(bf16, WS_P); bf16* Y = WSP(bf16, WS_Y); LAS float* vn = (LAS float*)F.lds;
    for (int pr = F.wave; pr < 512; pr += NWAVES) { const int tok = pr >> 2, h = pr & 3;
        const float v = bf2f(P[(r0 + tok) * NP + PC_VB + h * 64 + F.lane]);
        const float mu = wave_sum(v) * (1.0f / 64.0f), xc = v - mu, var = wave_sum(xc * xc) * (1.0f / 64.0f);
        vn[tok * 256 + h * 64 + F.lane] = xc * __builtin_amdgcn_rsqf(var + EPS) * GIN(I_GLNB)[l * 256 + h * 64 + F.lane]; }
    __syncthreads();
    const int c = F.tid & 255, h = __builtin_amdgcn_readfirstlane(c >> 6), half = __builtin_amdgcn_readfirstlane(F.tid >> 8);
    const float* wsg = GIN(I_WSG) + ((size_t)l * 4 + h) * 128 * 128; const float* bsg = GIN(I_BSG) + ((size_t)l * 4 + h) * 128;
    for (int t4 = 0; t4 < 16; ++t4) { const int t0 = half * 64 + t4 * 4; const int smax = half ? 128 : 64;
        float a0 = bsg[t0], a1 = bsg[t0 + 1], a2 = bsg[t0 + 2], a3 = bsg[t0 + 3];
        const float* w0 = wsg + (size_t)t0 * 128;
        for (int s = 0; s < smax; ++s) { const float v = vn[s * 256 + c]; a0 += w0[s] * v; a1 += w0[128 + s] * v; a2 += w0[256 + s] * v; a3 += w0[384 + s] * v; }
        const float av[4] = {a0, a1, a2, a3};
#pragma unroll
        for (int i = 0; i < 4; ++i) { const size_t r = r0 + t0 + i; Y[r * D + YC_B + c] = (bf16)f2bf(bf2f(P[r * NP + PC_UB + c]) * av[i]); } }
    __syncthreads();
}
__device__ __forceinline__ void pool_simple(Frame& F, int l, int unit) {
    const int b = unit >> 5, t0 = (unit & 31) * 64; const size_t r0 = (size_t)b * SEQ + t0;
    const bf16* P = WSP(bf16, WS_P); bf16* Y = WSP(bf16, WS_Y); LAS float* pl = (LAS float*)F.lds;
    const int c = F.tid & 255, g = __builtin_amdgcn_readfirstlane(c >> 6), half = __builtin_amdgcn_readfirstlane(F.tid >> 8);
    const int W = 2 << g;
    for (int tl = half * 32; tl < half * 32 + 32; ++tl) { const int t = t0 + tl; const int lo = (t + 1 - W) > 0 ? (t + 1 - W) : 0; float s = 0.f;
        for (int q = lo; q <= t; ++q) s += bf2f(P[((size_t)b * SEQ + q) * NP + PC_XC + c]);
        pl[tl * 256 + c] = s / (float)(t + 1 - lo) - bf2f(P[(r0 + tl) * NP + PC_XC + c]); }
    __syncthreads();
    const int d = c & 63; const float* wp = GIN(I_WPOOL) + ((size_t)l * 4 + g) * 64 * 64; const float sp = GIN(I_SPOOL)[l * 256 + c];
    float acc[32];
#pragma unroll
    for (int i = 0; i < 32; ++i) acc[i] = 0.f;
    for (int cc = 0; cc < 64; ++cc) { const float w = wp[cc * 64 + d];
#pragma unroll
        for (int i = 0; i < 32; ++i) acc[i] += pl[(half * 32 + i) * 256 + g * 64 + cc] * w; }
#pragma unroll
    for (int i = 0; i < 32; ++i) Y[(r0 + half * 32 + i) * D + YC_C + c] = (bf16)f2bf(acc[i] * sp);
    __syncthreads();
}
typedef short bf16x8 __attribute__((ext_vector_type(8)));
typedef float f32x16 __attribute__((ext_vector_type(16)));
typedef float f32x2_t __attribute__((ext_vector_type(2))); typedef __bf16 bf16x2_t __attribute__((ext_vector_type(2)));
__device__ __forceinline__ unsigned cvtpk(float lo, float hi) { f32x2_t v = {lo, hi}; bf16x2_t b = __builtin_convertvector(v, bf16x2_t); return __builtin_bit_cast(unsigned, b); }
#define MFMA32(a, b, c) __builtin_amdgcn_mfma_f32_32x32x16_bf16((a), (b), (c), 0, 0, 0)
__device__ __forceinline__ void sb_tile(Frame& F, int l, int b, int h, int qt, LAS unsigned char* wl) {
    int lane_ = F.lane; asm volatile("" : "+v"(lane_));
    const int lane = lane_, r = lane & 31, hf = lane >> 5;
    const bf16* P = WSP(bf16, WS_P); unsigned char* Y = WSP(unsigned char, WS_Y);
    const size_t rowq = (size_t)b * SEQ + qt * 32 + r;
    bf16x8 qf[4];
#pragma unroll
    for (int s = 0; s < 4; ++s) qf[s] = *(const bf16x8*)(P + rowq * NP + PC_QD + h * 64 + 16 * s + 8 * hf);
    const float* go = GIN(I_GOD) + l * 256 + h * 64; f32x4 ggv[2][4];
#pragma unroll
    for (int dt = 0; dt < 2; ++dt)
#pragma unroll
        for (int g4 = 0; g4 < 4; ++g4) ggv[dt][g4] = *(const f32x4*)(go + 32 * dt + 8 * g4 + 4 * hf);
    f32x16 o0, o1;
#pragma unroll
    for (int i = 0; i < 16; ++i) { o0[i] = 0.f; o1[i] = 0.f; }
    float carry = 0.f;
#define SB_LOADK(KF, KT) do { const size_t rowk_ = (size_t)b * SEQ + (KT) * 32; \
        _Pragma("unroll") for (int s_ = 0; s_ < 4; ++s_) KF[s_] = *(const bf16x8*)(P + (rowk_ + r) * NP + PC_KD + h * 64 + 16 * s_ + 8 * hf); } while (0)
#define SB_LOADV(VR, KT) do { const size_t rowk_ = (size_t)b * SEQ + (KT) * 32; \
        _Pragma("unroll") for (int i_ = 0; i_ < 4; ++i_) VR[i_] = *(const u32x4*)(P + (rowk_ + 8 * i_ + (lane >> 3)) * NP + PC_VD + h * 64 + (lane & 7) * 8); } while (0)
#define SB_PUTV(VR, BUF) do { _Pragma("unroll") for (int i_ = 0; i_ < 4; ++i_) *(LAS u32x4*)(wl + (BUF) * 4608 + (8 * i_ + (lane >> 3)) * 144 + (lane & 7) * 16) = VR[i_]; } while (0)
#define SB_GETV(VF, BUF) do { _Pragma("unroll") for (int s2_ = 0; s2_ < 2; ++s2_) _Pragma("unroll") for (int j_ = 0; j_ < 8; ++j_) { const int kk_ = 16 * s2_ + 8 * (j_ >> 2) + 4 * hf + (j_ & 3); const LAS short* vp_ = (const LAS short*)(wl + (BUF) * 4608 + kk_ * 144 + r * 2); \
            VF[0][s2_][j_] = vp_[0]; VF[1][s2_][j_] = vp_[32]; } } while (0)
    bf16x8 kf[4]; int cur = 0;
    { u32x4 vr[4]; SB_LOADK(kf, qt); SB_LOADV(vr, qt); SB_PUTV(vr, 0); }
    for (int kt = qt; kt >= 0; --kt) {
        bf16x8 kfn[4], vf[2][2]; u32x4 vrn[4];
        SB_GETV(vf, cur);
        { const int ktn = kt > 0 ? kt - 1 : 0; SB_LOADK(kfn, ktn); SB_LOADV(vrn, ktn); }
        f32x16 sa;
#pragma unroll
        for (int i = 0; i < 16; ++i) sa[i] = 0.f;
#pragma unroll
        for (int s = 0; s < 4; ++s) sa = MFMA32(kf[s], qf[s], sa);
        const bool diag = (kt == qt);
        float lf[16], ls[16];
#pragma unroll
        for (int i = 0; i < 16; ++i) { const int kk = (i & 3) + 8 * (i >> 2) + 4 * hf; const float z = sa[i] * 0.125f; const float sp = softplus_f(z);
            const bool past = !diag || (kk < r); lf[i] = past ? -sp : 0.f; ls[i] = past ? (z - sp) : -1e30f; }
        float Gs[4], Gp[4];
#pragma unroll
        for (int j = 0; j < 4; ++j) { Gs[j] = (lf[4 * j] + lf[4 * j + 1]) + (lf[4 * j + 2] + lf[4 * j + 3]); Gp[j] = __shfl_xor(Gs[j], 32); }
        float a[16]; float above = 0.f;
#pragma unroll
        for (int j = 3; j >= 0; --j) {
            const float T = carry + above + (hf == 0 ? Gp[j] : 0.f);
            const float e2 = lf[4 * j + 3], e1 = e2 + lf[4 * j + 2], e0 = e1 + lf[4 * j + 1];
            a[4 * j + 3] = __expf(ls[4 * j + 3] + T); a[4 * j + 2] = __expf(ls[4 * j + 2] + T + e2); a[4 * j + 1] = __expf(ls[4 * j + 1] + T + e1); a[4 * j] = __expf(ls[4 * j] + T + e0);
            above += Gs[j] + Gp[j];
        }
        carry += above;
#pragma unroll
        for (int s2 = 0; s2 < 2; ++s2) { u32x4 pw; pw.x = cvtpk(a[8 * s2], a[8 * s2 + 1]); pw.y = cvtpk(a[8 * s2 + 2], a[8 * s2 + 3]); pw.z = cvtpk(a[8 * s2 + 4], a[8 * s2 + 5]); pw.w = cvtpk(a[8 * s2 + 6], a[8 * s2 + 7]);
            const bf16x8 pf = __builtin_bit_cast(bf16x8, pw);
            o0 = MFMA32(vf[0][s2], pf, o0); o1 = MFMA32(vf[1][s2], pf, o1); }
        if (__all(carry < -24.0f)) break;
#pragma unroll
        for (int s_ = 0; s_ < 4; ++s_) kf[s_] = kfn[s_];
        cur ^= 1; SB_PUTV(vrn, cur);
    }
#undef SB_LOADK
#undef SB_LOADV
#undef SB_PUTV
#undef SB_GETV
    float ss = 0.f;
#pragma unroll
    for (int i = 0; i < 16; ++i) ss += o0[i] * o0[i] + o1[i] * o1[i];
    ss += __shfl_xor(ss, 32);
    const float rs = __builtin_amdgcn_rsqf(ss * (1.0f / 64.0f) + EPS);
#pragma unroll
    for (int dt = 0; dt < 2; ++dt)
#pragma unroll
        for (int g4 = 0; g4 < 4; ++g4) { const int d0 = 32 * dt + 8 * g4 + 4 * hf; const f32x4 gg = ggv[dt][g4];
            float v0, v1, v2, v3;
            if (dt == 0) { v0 = o0[4 * g4]; v1 = o0[4 * g4 + 1]; v2 = o0[4 * g4 + 2]; v3 = o0[4 * g4 + 3]; } else { v0 = o1[4 * g4]; v1 = o1[4 * g4 + 1]; v2 = o1[4 * g4 + 2]; v3 = o1[4 * g4 + 3]; }
            *(unsigned*)(Y + rowq * D + YC_D + h * 64 + d0) = q8x4(v0 * rs * gg[0], v1 * rs * gg[1], v2 * rs * gg[2], v3 * rs * gg[3]); }
}
constexpr int CH_UT = 0;
constexpr int CH_WN = 8192;
constexpr int CH_KDT = 16384;
constexpr int CH_QD = 24576;
constexpr int CH_QKF = 32768;
constexpr int CH_EGL = CH_QKF + 2048;
constexpr int CH_STRIDE = 40960;
__device__ __forceinline__ size_t ch_off(int unit) { return unit < 1024 ? WS_CHA + (size_t)unit * CH_STRIDE : WS_CHB + (size_t)(unit - 1024) * CH_STRIDE; }
constexpr int DN_WLDS = 18432;
__device__ __forceinline__ int crow(int reg, int hf) { return (reg & 3) + 8 * (reg >> 2) + 4 * hf; }
__device__ __forceinline__ bf16x8 pack8(float a0, float a1, float a2, float a3, float a4, float a5, float a6, float a7) {
    u32x4 p; p.x = cvtpk(a0, a1); p.y = cvtpk(a2, a3); p.z = cvtpk(a4, a5); p.w = cvtpk(a6, a7); return __builtin_bit_cast(bf16x8, p); }
__device__ __forceinline__ bf16x8 pack_regs(const f32x16& x, int s) { return pack8(x[8 * s], x[8 * s + 1], x[8 * s + 2], x[8 * s + 3], x[8 * s + 4], x[8 * s + 5], x[8 * s + 6], x[8 * s + 7]); }
#define WAVE_LDS_SYNC() asm volatile("s_waitcnt lgkmcnt(0)" ::: "memory")

__device__ __forceinline__ void dn_prep(Frame& F, int l, int unit, LAS unsigned char* wl) {
    int lane = F.lane, r, hf;
#define RELANE() do { asm volatile("" : "+v"(lane)); r = lane & 31; hf = lane >> 5; } while (0)
    RELANE();
    const int bh = unit >> 5, c = unit & 31, b = bh >> 2, h = bh & 3, t0 = c * 64;
    const size_t r0 = (size_t)b * SEQ + t0;
    const bf16* P = WSP(bf16, WS_P); const float* cw = GIN(I_CONV) + (size_t)l * 4 * 768; const float* ab = WSP(float, WS_ABLOG);
    unsigned char* cb = F.ws + ch_off(unit);
    LAS float* Lm = (LAS float*)wl; LAS float* Gt = (LAS float*)(wl + 16896); LAS float* Bt = Gt + 64; LAS float* Rk = Bt + 64; LAS float* Rq = Rk + 64;
    float G63;
    { const float a = ab[(r0 + lane) * 8 + h], bb = ab[(r0 + lane) * 8 + 4 + h];
      float g = -__expf(GIN(I_ALOG)[l * 4 + h]) * softplus_f(a + GIN(I_DTB)[l * 4 + h]);
#pragma unroll
      for (int o = 1; o < 64; o <<= 1) { const float v = __shfl_up(g, o); if (lane >= o) g += v; }
      Gt[lane] = g; Bt[lane] = sigmoid_f(bb); G63 = rdlane(g, 63); }
#define DN_STAGE(colbase, halfoff) do { const bf16* base_ = P + r0 * NP + (colbase) + (lane & 7) * 8; u32x4 w_[8], hw_ = (u32x4){0u, 0u, 0u, 0u}; \
        _Pragma("unroll") for (int k_ = 0; k_ < 8; ++k_) w_[k_] = *(const u32x4*)(base_ + (size_t)(8 * k_ + (lane >> 3)) * NP); \
        if (t0 > 0) { if (lane < 24) hw_ = *(const u32x4*)(base_ + ((long)(lane >> 3) - 3) * NP); } \
        _Pragma("unroll") for (int k_ = 0; k_ < 8; ++k_) { LAS unsigned char* d_ = wl + (8 * k_ + (lane >> 3)) * 264 + (halfoff) + (lane & 7) * 16; *(LAS u32x2*)d_ = (u32x2){w_[k_].x, w_[k_].y}; *(LAS u32x2*)(d_ + 8) = (u32x2){w_[k_].z, w_[k_].w}; } \
        if (lane < 24) *(LAS u32x4*)(wl + 17920 + (lane >> 3) * 128 + (lane & 7) * 16) = hw_; \
        WAVE_LDS_SYNC(); asm volatile("" ::: "memory"); } while (0)
#define DN_RAWCOL(raw, halfoff) do { _Pragma("unroll") for (int i_ = 0; i_ < 3; ++i_) raw[i_] = *(const LAS bf16*)(wl + 17920 + i_ * 128 + lane * 2); \
        _Pragma("unroll") for (int i_ = 0; i_ < 64; ++i_) raw[3 + i_] = *(const LAS bf16*)(wl + i_ * 264 + (halfoff) + lane * 2); } while (0)
    unsigned vpk[32];
    {   const int chv = 512 + h * 64 + lane; const float w0 = cw[chv], w1 = cw[768 + chv], w2 = cw[1536 + chv], w3 = cw[2304 + chv];
        DN_STAGE(512 + h * 64, 0);
        unsigned raw[67]; DN_RAWCOL(raw, 0);
#pragma unroll
        for (int i = 0; i < 64; i += 2) vpk[i >> 1] = cvtpk(silu_f(w0 * bf2f(raw[i]) + w1 * bf2f(raw[i + 1]) + w2 * bf2f(raw[i + 2]) + w3 * bf2f(raw[i + 3])), silu_f(w0 * bf2f(raw[i + 1]) + w1 * bf2f(raw[i + 2]) + w2 * bf2f(raw[i + 3]) + w3 * bf2f(raw[i + 4])));
        WAVE_LDS_SYNC(); asm volatile("" ::: "memory"); }
    {   LAS bf16* T = (LAS bf16*)wl;
#pragma unroll
        for (int which = 0; which < 2; ++which) { const int chn = which * 256 + h * 64 + lane;
            const float w0 = cw[chn], w1 = cw[768 + chn], w2 = cw[1536 + chn], w3 = cw[2304 + chn];
            DN_STAGE(which * 256 + h * 64, which * 128);
            unsigned raw[67]; DN_RAWCOL(raw, which * 128); unsigned kq_[4] = {0u, 0u, 0u, 0u};
            WAVE_LDS_SYNC(); asm volatile("" ::: "memory");
#pragma unroll
            for (int i = 0; i < 64; i += 2) { const unsigned pk_ = cvtpk(silu_f(w0 * bf2f(raw[i]) + w1 * bf2f(raw[i + 1]) + w2 * bf2f(raw[i + 2]) + w3 * bf2f(raw[i + 3])), silu_f(w0 * bf2f(raw[i + 1]) + w1 * bf2f(raw[i + 2]) + w2 * bf2f(raw[i + 3]) + w3 * bf2f(raw[i + 4])));
                T[i * 132 + which * 64 + lane] = (bf16)(pk_ & 0xffffu); T[(i + 1) * 132 + which * 64 + lane] = (bf16)(pk_ >> 16); if (which == 1) { kq_[(i >> 1) & 3] = pk_; if ((i & 6) == 6) *(u32x4*)(cb + CH_WN + lane * 128 + (i >> 3) * 16) = (u32x4){kq_[0], kq_[1], kq_[2], kq_[3]}; } }
            asm volatile("" ::: "memory"); }
    }
    WAVE_LDS_SYNC();
    RELANE();
    bf16x8 qf[2][4], kf[2][4]; float sq[2] = {0.f, 0.f}, sk[2] = {0.f, 0.f};
#pragma unroll
    for (int which = 0; which < 2; ++which)
#pragma unroll
        for (int it = 0; it < 2; ++it)
#pragma unroll
            for (int s = 0; s < 4; ++s) { const LAS unsigned char* tp = wl + (32 * it + r) * 264 + (which * 64 + 16 * s + 4 * hf) * 2;
                const u32x2 lo = *(const LAS u32x2*)tp, hi = *(const LAS u32x2*)(tp + 16); const u32x4 fv = (u32x4){lo.x, lo.y, hi.x, hi.y};
                const float e0 = bf2f(fv.x & 0xffffu), e1 = bf2f(fv.x >> 16), e2 = bf2f(fv.y & 0xffffu), e3 = bf2f(fv.y >> 16), e4 = bf2f(fv.z & 0xffffu), e5 = bf2f(fv.z >> 16), e6 = bf2f(fv.w & 0xffffu), e7 = bf2f(fv.w >> 16);
                const float ss = ((e0 * e0 + e1 * e1) + (e2 * e2 + e3 * e3)) + ((e4 * e4 + e5 * e5) + (e6 * e6 + e7 * e7));
                if (which == 0) { qf[it][s] = __builtin_bit_cast(bf16x8, fv); sq[it] += ss; } else { kf[it][s] = __builtin_bit_cast(bf16x8, fv); sk[it] += ss; } }
#pragma unroll
    for (int it = 0; it < 2; ++it) { sq[it] += __shfl_xor(sq[it], 32); sk[it] += __shfl_xor(sk[it], 32);
        if (hf == 0) { Rq[32 * it + r] = __builtin_amdgcn_rsqf(sq[it] + EPS); Rk[32 * it + r] = __builtin_amdgcn_rsqf(sk[it] + EPS); } }
    WAVE_LDS_SYNC();
#ifndef NO_S3
    RELANE();
#pragma unroll
    for (int tl = 0; tl < 3; ++tl) { const int jt = tl == 2 ? 1 : 0, it = tl == 0 ? 0 : 1;
        RELANE();
        f32x16 acc;
#pragma unroll
        for (int i = 0; i < 16; ++i) acc[i] = 0.f;
#pragma unroll
        for (int s = 0; s < 4; ++s) acc = MFMA32(kf[jt][s], kf[it][s], acc);
        const int i = 32 * it + r; const float ci = Bt[i] * Rk[i], gi = Gt[i];
#pragma unroll
        for (int j16 = 0; j16 < 16; ++j16) { const int j = 32 * jt + crow(j16, hf);
            Lm[j * 64 + i] = (i > j) ? acc[j16] * ci * Rk[j] * __expf(gi - Gt[j]) : 0.f; } }
#endif
#ifndef NO_S4
    RELANE();
#pragma unroll
    for (int tl = 0; tl < 3; ++tl) { const int tt = tl == 0 ? 0 : 1, jt = tl == 2 ? 1 : 0;
        RELANE();
        f32x16 acc;
#pragma unroll
        for (int i = 0; i < 16; ++i) acc[i] = 0.f;
#pragma unroll
        for (int s = 0; s < 4; ++s) acc = MFMA32(kf[jt][s], qf[tt][s], acc);
        const int i = 32 * tt + r; const float ci = Rq[i] * 0.125f, gi = Gt[i];
#pragma unroll
        for (int j16 = 0; j16 < 16; ++j16) { const int j = 32 * jt + crow(j16, hf); acc[j16] = (i >= j) ? acc[j16] * Rk[j] * ci * __expf(gi - Gt[j]) : 0.f; }
#pragma unroll
        for (int s2 = 0; s2 < 2; ++s2) *(bf16x8*)(cb + CH_QKF + (((tt * 2 + jt) * 2 + s2) * 64 + lane) * 16) = pack_regs(acc, s2); }
#pragma unroll
    for (int it = 0; it < 2; ++it) { const int i = 32 * it + r; const float sc = Rq[i] * 0.125f * __expf(Gt[i]);
#pragma unroll
        for (int s = 0; s < 4; ++s) { const u32x4 q = __builtin_bit_cast(u32x4, qf[it][s]);
            *(bf16x8*)(cb + CH_QD + ((it * 4 + s) * 64 + lane) * 16) = pack8(bf2f(q.x & 0xffffu) * sc, bf2f(q.x >> 16) * sc, bf2f(q.y & 0xffffu) * sc, bf2f(q.y >> 16) * sc, bf2f(q.z & 0xffffu) * sc, bf2f(q.z >> 16) * sc, bf2f(q.w & 0xffffu) * sc, bf2f(q.w >> 16) * sc); } }
    WAVE_LDS_SYNC();
#endif
#ifndef NO_S5
    RELANE();
#define DN_SOLVE(X2) do { _Pragma("unroll") for (int j = 0; j < 63; ++j) { const float xj_ = (j & 1) ? X2[j >> 1][1] : X2[j >> 1][0]; const f32x2_t nx_ = (f32x2_t){-xj_, -xj_}; \
        _Pragma("unroll") for (int i4 = (j + 1) / 4; i4 < 16; ++i4) { const f32x4 lv = *(const LAS f32x4*)(Lm + j * 64 + 4 * i4); \
            if (4 * i4 > j) X2[2 * i4] = __builtin_elementwise_fma((f32x2_t){lv[0], lv[1]}, nx_, X2[2 * i4]); \
            else if (4 * i4 + 1 > j) X2[2 * i4][1] = __builtin_fmaf(lv[1], -xj_, X2[2 * i4][1]); \
            if (4 * i4 + 2 > j) X2[2 * i4 + 1] = __builtin_elementwise_fma((f32x2_t){lv[2], lv[3]}, nx_, X2[2 * i4 + 1]); \
            else if (4 * i4 + 3 > j) X2[2 * i4 + 1][1] = __builtin_fmaf(lv[3], -xj_, X2[2 * i4 + 1][1]); } \
        asm volatile("" ::: "memory"); __builtin_amdgcn_sched_barrier(0); } } while (0)
    u32x4 kpk[8];
#pragma unroll
    for (int i8 = 0; i8 < 8; ++i8) kpk[i8] = *(const u32x4*)(cb + CH_WN + lane * 128 + i8 * 16);
    {
#pragma clang fp contract(off)
        f32x2_t X2[32];
        {
#pragma unroll
          for (int i = 0; i < 64; ++i) { X2[i >> 1][i & 1] = ((i & 1) ? bf2f(vpk[i >> 1] >> 16) : bf2f(vpk[i >> 1] & 0xffffu)) * Bt[i];
              if ((i & 7) == 7) { asm volatile("" ::: "memory"); __builtin_amdgcn_sched_barrier(0); } } }
        __builtin_amdgcn_sched_barrier(0);
        DN_SOLVE(X2);
#pragma unroll
        for (int i8 = 0; i8 < 8; ++i8) *(bf16x8*)(cb + CH_UT + (lane * 64 + 8 * i8) * 2) = pack8(X2[4 * i8][0], X2[4 * i8][1], X2[4 * i8 + 1][0], X2[4 * i8 + 1][1], X2[4 * i8 + 2][0], X2[4 * i8 + 2][1], X2[4 * i8 + 3][0], X2[4 * i8 + 3][1]);
    }
    RELANE();
    {
#pragma clang fp contract(off)
        f32x2_t X2[32];
        {
          float kd[8];
#pragma unroll
          for (int i = 0; i < 64; ++i) { const unsigned kw_ = kpk[i >> 3][(i >> 1) & 3]; const float kc = ((i & 1) ? bf2f(kw_ >> 16) : bf2f(kw_ & 0xffffu)) * Rk[i], gi = Gt[i];
              X2[i >> 1][i & 1] = kc * Bt[i] * __expf(gi); kd[i & 7] = kc * __expf(G63 - gi);
              if ((i & 7) == 7) { *(bf16x8*)(cb + CH_KDT + (lane * 64 + i - 7) * 2) = pack8(kd[0], kd[1], kd[2], kd[3], kd[4], kd[5], kd[6], kd[7]); asm volatile("" ::: "memory"); __builtin_amdgcn_sched_barrier(0); } } }
        __builtin_amdgcn_sched_barrier(0);
        DN_SOLVE(X2);
        WAVE_LDS_SYNC(); asm volatile("" ::: "memory");
#pragma unroll
        for (int i = 0; i < 64; ++i) *(LAS bf16*)(wl + i * 264 + lane * 2) = (bf16)f2bf(-X2[i >> 1][i & 1]);
        WAVE_LDS_SYNC(); asm volatile("" ::: "memory");
#pragma unroll
        for (int k = 0; k < 8; ++k) { const LAS unsigned char* sp = wl + (8 * k + (lane >> 3)) * 264 + (lane & 7) * 16; const u32x2 lo = *(const LAS u32x2*)sp, hi = *(const LAS u32x2*)(sp + 8);
            *(u32x4*)(cb + CH_WN + (8 * k + (lane >> 3)) * 128 + (lane & 7) * 16) = (u32x4){lo.x, lo.y, hi.x, hi.y}; }
    }
#undef DN_SOLVE
#undef DN_STAGE
#undef DN_RAWCOL
#endif
#undef RELANE
    if (lane == 0) *(float*)(cb + CH_EGL) = __expf(G63);
    WAVE_LDS_SYNC();
}

constexpr int SCAN_LDS0 = 8192, SCAN_BUF = 49152, SC_GATE = 40960, SCAN_NDMA = 47;
__device__ __forceinline__ void dn_scan_fetch(const unsigned char* cb, const bf16* gate0, LAS unsigned char* buf, int lane) {
    asm volatile("" : "+v"(lane));
    const unsigned rW = lane >> 3, pW = lane & 7;
#pragma unroll
    for (int n = 0; n < 8; ++n) { const unsigned row = 8 * n + rW; const unsigned so = (row * 8 + (pW ^ (row & 7))) * 16;
        __builtin_amdgcn_global_load_lds((const unsigned*)(cb + CH_UT + so), (LAS unsigned*)(buf + CH_UT + n * 1024), 16, 0, 0);
        __builtin_amdgcn_global_load_lds((const unsigned*)(cb + CH_WN + so), (LAS unsigned*)(buf + CH_WN + n * 1024), 16, 0, 0);
        __builtin_amdgcn_global_load_lds((const unsigned*)(cb + CH_KDT + so), (LAS unsigned*)(buf + CH_KDT + n * 1024), 16, 0, 0);
        __builtin_amdgcn_global_load_lds((const unsigned*)(cb + CH_QD + n * 1024 + lane * 16), (LAS unsigned*)(buf + CH_QD + n * 1024), 16, 0, 0);
        if (n != 3) __builtin_amdgcn_global_load_lds((const unsigned*)(cb + CH_QKF + n * 1024 + lane * 16), (LAS unsigned*)(buf + CH_QKF + n * 1024), 16, 0, 0);
        __builtin_amdgcn_global_load_lds((const unsigned*)(gate0 + (size_t)row * NP + 8 * (pW ^ (row & 7))), (LAS unsigned*)(buf + SC_GATE + n * 1024), 16, 0, 0); }
}
__device__ __forceinline__ void dn_scan(Frame& F, int l, int bh) {
    const int lane = F.lane, r = lane & 31, hf = lane >> 5, b = bh >> 2, h = bh & 3;
    const bf16* P = WSP(bf16, WS_P); unsigned char* Y = WSP(unsigned char, WS_Y);
    const unsigned char* cb0 = F.ws + ch_off(bh * 32);
    const bf16* gate00 = P + (size_t)b * SEQ * NP + PC_GATE + h * 64;
    f32x16 S[2][2];
#pragma unroll
    for (int dt = 0; dt < 2; ++dt)
#pragma unroll
        for (int jt = 0; jt < 2; ++jt)
#pragma unroll
            for (int i = 0; i < 16; ++i) S[dt][jt][i] = 0.f;
    dn_scan_fetch(cb0, gate00, F.lds + SCAN_LDS0, lane);
    dn_scan_fetch(cb0 + CH_STRIDE, gate00 + (size_t)64 * NP, F.lds + SCAN_LDS0 + SCAN_BUF, lane);
    asm volatile("s_waitcnt vmcnt(47)" ::: "memory");
    int bi = 0;
    for (int c = 0; c < 32; ++c) {
        asm volatile("s_waitcnt lgkmcnt(0)" ::: "memory");
        { const int cf = (c + 2 < 32) ? c + 2 : 31; const int bf_ = bi == 0 ? 2 : bi - 1;
          dn_scan_fetch(cb0 + (size_t)cf * CH_STRIDE, gate00 + (size_t)cf * 64 * NP, F.lds + SCAN_LDS0 + bf_ * SCAN_BUF, lane); }
        const LAS unsigned char* lb = F.lds + SCAN_LDS0 + bi * SCAN_BUF;
        bi = bi == 2 ? 0 : bi + 1;
        const size_t r0 = (size_t)b * SEQ + c * 64;
        const float egl = *(const LAS float*)(lb + CH_EGL);
        bf16x8 Sp[2][2][2];
#pragma unroll
        for (int dt = 0; dt < 2; ++dt)
#pragma unroll
            for (int jt = 0; jt < 2; ++jt) { Sp[dt][jt][0] = pack_regs(S[dt][jt], 0); Sp[dt][jt][1] = pack_regs(S[dt][jt], 1); }
        f32x16 vn[2][2];
#pragma unroll
        for (int it = 0; it < 2; ++it)
#pragma unroll
            for (int jt = 0; jt < 2; ++jt)
#pragma unroll
                for (int g4 = 0; g4 < 4; ++g4) { const unsigned row = 32 * jt + r; const u32x2 u = *(const LAS u32x2*)(lb + CH_UT + row * 128 + (((4 * it + g4) ^ (row & 7)) * 16) + 8 * hf);
                    vn[it][jt][4 * g4] = bf2f(u.x & 0xffffu); vn[it][jt][4 * g4 + 1] = bf2f(u.x >> 16); vn[it][jt][4 * g4 + 2] = bf2f(u.y & 0xffffu); vn[it][jt][4 * g4 + 3] = bf2f(u.y >> 16); }
#pragma unroll
        for (int it = 0; it < 2; ++it) { bf16x8 wf[4];
#pragma unroll
            for (int s = 0; s < 4; ++s) { const unsigned row = 32 * it + r; const LAS unsigned char* wp = lb + CH_WN + row * 128 + 8 * hf; const unsigned sw = row & 7;
                const u32x2 lo = *(const LAS u32x2*)(wp + (((2 * s) ^ sw) * 16)), hi = *(const LAS u32x2*)(wp + (((2 * s + 1) ^ sw) * 16)); wf[s] = __builtin_bit_cast(bf16x8, (u32x4){lo.x, lo.y, hi.x, hi.y}); }
            asm volatile("" ::: "memory");
#pragma unroll
            for (int s = 0; s < 4; ++s) { vn[it][0] = MFMA32(wf[s], Sp[s >> 1][0][s & 1], vn[it][0]); vn[it][1] = MFMA32(wf[s], Sp[s >> 1][1][s & 1], vn[it][1]); } }
        bf16x8 Vp[2][2][2];
#pragma unroll
        for (int it = 0; it < 2; ++it)
#pragma unroll
            for (int jt = 0; jt < 2; ++jt) { Vp[it][jt][0] = pack_regs(vn[it][jt], 0); Vp[it][jt][1] = pack_regs(vn[it][jt], 1); }
#pragma unroll
        for (int dt = 0; dt < 2; ++dt)
#pragma unroll
            for (int jt = 0; jt < 2; ++jt)
#pragma unroll
                for (int i = 0; i < 16; ++i) S[dt][jt][i] *= egl;
#pragma unroll
        for (int dt = 0; dt < 2; ++dt) { bf16x8 kfr[4];
#pragma unroll
            for (int q = 0; q < 4; ++q) { const unsigned row = 32 * dt + r; const LAS unsigned char* kp = lb + CH_KDT + row * 128 + 8 * hf; const unsigned sw = row & 7, c0 = 2 * q;
                const u32x2 lo = *(const LAS u32x2*)(kp + ((c0 ^ sw) * 16)), hi = *(const LAS u32x2*)(kp + (((c0 + 1) ^ sw) * 16)); kfr[q] = __builtin_bit_cast(bf16x8, (u32x4){lo.x, lo.y, hi.x, hi.y}); }
            asm volatile("" ::: "memory");
#pragma unroll
            for (int q = 0; q < 4; ++q) { S[dt][0] = MFMA32(kfr[q], Vp[q >> 1][0][q & 1], S[dt][0]); S[dt][1] = MFMA32(kfr[q], Vp[q >> 1][1][q & 1], S[dt][1]); } }
#pragma unroll
        for (int tt = 0; tt < 2; ++tt) {
            f32x16 o[2];
#pragma unroll
            for (int jt = 0; jt < 2; ++jt)
#pragma unroll
                for (int i = 0; i < 16; ++i) o[jt][i] = 0.f;
            bf16x8 qd[4], qk[4];
#pragma unroll
            for (int s = 0; s < 4; ++s) qd[s] = *(const LAS bf16x8*)(lb + CH_QD + ((tt * 4 + s) * 64 + lane) * 16);
#pragma unroll
            for (int q = 0; q < 2 * (tt + 1); ++q) qk[q] = *(const LAS bf16x8*)(lb + CH_QKF + ((tt * 4 + q) * 64 + lane) * 16);
            asm volatile("" ::: "memory");
#pragma unroll
            for (int s = 0; s < 4; ++s) { o[0] = MFMA32(Sp[s >> 1][0][s & 1], qd[s], o[0]); o[1] = MFMA32(Sp[s >> 1][1][s & 1], qd[s], o[1]); }
#pragma unroll
            for (int q = 0; q < 2 * (tt + 1); ++q) { o[0] = MFMA32(Vp[q >> 1][0][q & 1], qk[q], o[0]); o[1] = MFMA32(Vp[q >> 1][1][q & 1], qk[q], o[1]); }
            float ss = 0.f;
#pragma unroll
            for (int i = 0; i < 16; ++i) ss += o[0][i] * o[0][i] + o[1][i] * o[1][i];
            ss += __shfl_xor(ss, 32);
            const float rs = __builtin_amdgcn_rsqf(ss * (1.0f / 64.0f) + EPS);
            const size_t row = r0 + 32 * tt + r;
            if (tt == 0) asm volatile("s_waitcnt vmcnt(47)" ::: "memory");
#pragma unroll
            for (int jt = 0; jt < 2; ++jt)
#pragma unroll
                for (int g4 = 0; g4 < 4; ++g4) { const int d0 = 32 * jt + 8 * g4 + 4 * hf;
                    const unsigned trow = 32 * tt + r; const u32x2 gv = *(const LAS u32x2*)(lb + SC_GATE + trow * 128 + (((4 * jt + g4) ^ (trow & 7)) * 16) + 8 * hf);
                    const float y0 = o[jt][4 * g4] * rs * bf2f(gv.x & 0xffffu), y1 = o[jt][4 * g4 + 1] * rs * bf2f(gv.x >> 16);
                    const float y2 = o[jt][4 * g4 + 2] * rs * bf2f(gv.y & 0xffffu), y3 = o[jt][4 * g4 + 3] * rs * bf2f(gv.y >> 16);
                    *(unsigned*)(Y + row * D + YC_A + h * 64 + d0) = q8x4(y0, y1, y2, y3); }
        }
    }
    asm volatile("s_waitcnt vmcnt(0) lgkmcnt(0)" ::: "memory");
}
constexpr int SL_RING = 8192, SL_BUF = 24576, SL_HO = 81920, SL_HOSLOT = 16384, SL_GATE = 131072, SL_FLAGS = 163072;
__device__ __forceinline__ void dn_lead_fetch(const unsigned char* cb, LAS unsigned char* buf, int lane) {
    asm volatile("" : "+v"(lane));
    const unsigned rW = lane >> 3, pW = lane & 7;
#pragma unroll
    for (int n = 0; n < 8; ++n) { const unsigned row = 8 * n + rW; const unsigned so = (row * 8 + (pW ^ (row & 7))) * 16;
        __builtin_amdgcn_global_load_lds((const unsigned*)(cb + CH_UT + so), (LAS unsigned*)(buf + n * 1024), 16, 0, 0);
        __builtin_amdgcn_global_load_lds((const unsigned*)(cb + CH_WN + so), (LAS unsigned*)(buf + 8192 + n * 1024), 16, 0, 0);
        __builtin_amdgcn_global_load_lds((const unsigned*)(cb + CH_KDT + so), (LAS unsigned*)(buf + 16384 + n * 1024), 16, 0, 0); }
}
__device__ __forceinline__ void dn_scan_lead(Frame& F, int l, int bh) {
    int lane = F.lane; asm volatile("" : "+v"(lane)); const int r = lane & 31, hf = lane >> 5;
    const unsigned char* cb0 = F.ws + ch_off(bh * 32);
    volatile LAS unsigned* fl = (volatile LAS unsigned*)(F.lds + SL_FLAGS); volatile LAS unsigned* hand = fl + 1; volatile LAS unsigned* done = fl + 33;
    const unsigned tag = (unsigned)(l + 1);
    const float eglv = *(const float*)(cb0 + (size_t)(lane & 31) * CH_STRIDE + CH_EGL);
    f32x16 S[2][2];
#pragma unroll
    for (int dt = 0; dt < 2; ++dt)
#pragma unroll
        for (int jt = 0; jt < 2; ++jt)
#pragma unroll
            for (int i = 0; i < 16; ++i) S[dt][jt][i] = 0.f;
    asm volatile("s_waitcnt vmcnt(0)" ::: "memory");
    dn_lead_fetch(cb0, F.lds + SL_RING, lane);
    dn_lead_fetch(cb0 + CH_STRIDE, F.lds + SL_RING + SL_BUF, lane);
    asm volatile("s_waitcnt vmcnt(24)" ::: "memory");
    int bi = 0;
    for (int c = 0; c < 32; ++c) {
        asm volatile("s_waitcnt lgkmcnt(0)" ::: "memory");
        { const int cf = (c + 2 < 32) ? c + 2 : 31; const int bf_ = bi == 0 ? 2 : bi - 1;
          dn_lead_fetch(cb0 + (size_t)cf * CH_STRIDE, F.lds + SL_RING + bf_ * SL_BUF, lane); }
        const LAS unsigned char* lb = F.lds + SL_RING + bi * SL_BUF;
        LAS unsigned char* ho = F.lds + SL_HO + bi * SL_HOSLOT;
        bi = bi == 2 ? 0 : bi + 1;
        const float egl = rdlane(eglv, c);
        bf16x8 Sp[2][2][2];
#pragma unroll
        for (int dt = 0; dt < 2; ++dt)
#pragma unroll
            for (int jt = 0; jt < 2; ++jt) { Sp[dt][jt][0] = pack_regs(S[dt][jt], 0); Sp[dt][jt][1] = pack_regs(S[dt][jt], 1); }
        f32x16 vn[2][2];
#pragma unroll
        for (int it = 0; it < 2; ++it)
#pragma unroll
            for (int jt = 0; jt < 2; ++jt)
#pragma unroll
                for (int g4 = 0; g4 < 4; ++g4) { const unsigned row = 32 * jt + r; const u32x2 u = *(const LAS u32x2*)(lb + row * 128 + (((4 * it + g4) ^ (row & 7)) * 16) + 8 * hf);
                    vn[it][jt][4 * g4] = bf2f(u.x & 0xffffu); vn[it][jt][4 * g4 + 1] = bf2f(u.x >> 16); vn[it][jt][4 * g4 + 2] = bf2f(u.y & 0xffffu); vn[it][jt][4 * g4 + 3] = bf2f(u.y >> 16); }
#pragma unroll
        for (int it = 0; it < 2; ++it) { bf16x8 wf[4];
#pragma unroll
            for (int s = 0; s < 4; ++s) { const unsigned row = 32 * it + r; const LAS unsigned char* wp = lb + 8192 + row * 128 + 8 * hf; const unsigned sw = row & 7;
                const u32x2 lo = *(const LAS u32x2*)(wp + (((2 * s) ^ sw) * 16)), hi = *(const LAS u32x2*)(wp + (((2 * s + 1) ^ sw) * 16)); wf[s] = __builtin_bit_cast(bf16x8, (u32x4){lo.x, lo.y, hi.x, hi.y}); }
            asm volatile("" ::: "memory");
#pragma unroll
            for (int s = 0; s < 4; ++s) { vn[it][0] = MFMA32(wf[s], Sp[s >> 1][0][s & 1], vn[it][0]); vn[it][1] = MFMA32(wf[s], Sp[s >> 1][1][s & 1], vn[it][1]); } }
        bf16x8 Vp[2][2][2];
#pragma unroll
        for (int it = 0; it < 2; ++it)
#pragma unroll
            for (int jt = 0; jt < 2; ++jt) { Vp[it][jt][0] = pack_regs(vn[it][jt], 0); Vp[it][jt][1] = pack_regs(vn[it][jt], 1); }
        if (c >= 3) { unsigned spins = 0; while ((unsigned)__builtin_amdgcn_readfirstlane(done[c - 3]) < tag) { if (++spins > (1u << 22)) break; } }
        asm volatile("" ::: "memory");
#pragma unroll
        for (int a = 0; a < 2; ++a)
#pragma unroll
            for (int jt = 0; jt < 2; ++jt)
#pragma unroll
                for (int s2 = 0; s2 < 2; ++s2) { *(LAS bf16x8*)(ho + (((a * 2 + jt) * 2 + s2) * 64 + lane) * 16) = Sp[a][jt][s2]; *(LAS bf16x8*)(ho + 8192 + (((a * 2 + jt) * 2 + s2) * 64 + lane) * 16) = Vp[a][jt][s2]; }
        asm volatile("s_waitcnt lgkmcnt(0)" ::: "memory");
        if (lane == 0) hand[c] = tag;
#pragma unroll
        for (int dt = 0; dt < 2; ++dt)
#pragma unroll
            for (int jt = 0; jt < 2; ++jt)
#pragma unroll
                for (int i = 0; i < 16; ++i) S[dt][jt][i] *= egl;
#pragma unroll
        for (int dt = 0; dt < 2; ++dt) { bf16x8 kfr[4];
#pragma unroll
            for (int q = 0; q < 4; ++q) { const unsigned row = 32 * dt + r; const LAS unsigned char* kp = lb + 16384 + row * 128 + 8 * hf; const unsigned sw = row & 7, c0 = 2 * q;
                const u32x2 lo = *(const LAS u32x2*)(kp + ((c0 ^ sw) * 16)), hi = *(const LAS u32x2*)(kp + (((c0 + 1) ^ sw) * 16)); kfr[q] = __builtin_bit_cast(bf16x8, (u32x4){lo.x, lo.y, hi.x, hi.y}); }
            asm volatile("" ::: "memory");
#pragma unroll
            for (int q = 0; q < 4; ++q) { S[dt][0] = MFMA32(kfr[q], Vp[q >> 1][0][q & 1], S[dt][0]); S[dt][1] = MFMA32(kfr[q], Vp[q >> 1][1][q & 1], S[dt][1]); } }
        asm volatile("s_waitcnt vmcnt(24)" ::: "memory");
    }
    asm volatile("s_waitcnt vmcnt(0) lgkmcnt(0)" ::: "memory");
}
__device__ __forceinline__ void dn_scan_help(Frame& F, int l, int bh, int hidx) {
    int lane = F.lane; asm volatile("" : "+v"(lane)); const int r = lane & 31, hf = lane >> 5, b = bh >> 2, h = bh & 3;
    const bf16* P = WSP(bf16, WS_P); unsigned char* Y = WSP(unsigned char, WS_Y);
    const unsigned char* cb0 = F.ws + ch_off(bh * 32);
    const bf16* gate00 = P + (size_t)b * SEQ * NP + PC_GATE + h * 64;
    volatile LAS unsigned* fl = (volatile LAS unsigned*)(F.lds + SL_FLAGS); volatile LAS unsigned* hand = fl + 1; volatile LAS unsigned* done = fl + 33;
    const unsigned tag = (unsigned)(l + 1);
    LAS unsigned char* gb = F.lds + SL_GATE + hidx * 8192;
    { unsigned spins = 0; while ((unsigned)__builtin_amdgcn_readfirstlane(fl[0]) < tag) { __builtin_amdgcn_s_sleep(2); if (++spins > (1u << 22)) break; } }
    const unsigned rW = lane >> 3, pW = lane & 7;
    for (int c = hidx; c < 32; c += 2) {
        const unsigned char* cb = cb0 + (size_t)c * CH_STRIDE; const size_t r0 = (size_t)b * SEQ + c * 64; const bf16* gate0 = gate00 + (size_t)c * 64 * NP;
        asm volatile("s_waitcnt lgkmcnt(0)" ::: "memory");
#pragma unroll
        for (int n = 0; n < 8; ++n) { const unsigned row = 8 * n + rW;
            __builtin_amdgcn_global_load_lds((const unsigned*)(gate0 + (size_t)row * NP + 8 * (pW ^ (row & 7))), (LAS unsigned*)(gb + n * 1024), 16, 0, 0); }
        bf16x8 qd[8], qk[6];
#pragma unroll
        for (int i = 0; i < 8; ++i) qd[i] = *(const bf16x8*)(cb + CH_QD + (i * 64 + lane) * 16);
#pragma unroll
        for (int i = 0; i < 6; ++i) qk[i] = *(const bf16x8*)(cb + CH_QKF + (((i < 2 ? i : i + 2)) * 64 + lane) * 16);
        { unsigned spins = 0; while ((unsigned)__builtin_amdgcn_readfirstlane(hand[c]) < tag) { if (++spins > (1u << 22)) break; } }
        asm volatile("" ::: "memory");
        const LAS unsigned char* ho = F.lds + SL_HO + (c % 3) * SL_HOSLOT;
        bf16x8 Sp[2][2][2], Vp[2][2][2];
#pragma unroll
        for (int a = 0; a < 2; ++a)
#pragma unroll
            for (int jt = 0; jt < 2; ++jt)
#pragma unroll
                for (int s2 = 0; s2 < 2; ++s2) { Sp[a][jt][s2] = *(const LAS bf16x8*)(ho + (((a * 2 + jt) * 2 + s2) * 64 + lane) * 16); Vp[a][jt][s2] = *(const LAS bf16x8*)(ho + 8192 + (((a * 2 + jt) * 2 + s2) * 64 + lane) * 16); }
        asm volatile("s_waitcnt lgkmcnt(0)" ::: "memory");
        if (lane == 0) done[c] = tag;
        asm volatile("s_waitcnt vmcnt(0)" ::: "memory");
#pragma unroll
        for (int tt = 0; tt < 2; ++tt) {
            f32x16 o[2];
#pragma unroll
            for (int jt = 0; jt < 2; ++jt)
#pragma unroll
                for (int i = 0; i < 16; ++i) o[jt][i] = 0.f;
#pragma unroll
            for (int s = 0; s < 4; ++s) { o[0] = MFMA32(Sp[s >> 1][0][s & 1], qd[tt * 4 + s], o[0]); o[1] = MFMA32(Sp[s >> 1][1][s & 1], qd[tt * 4 + s], o[1]); }
#pragma unroll
            for (int q = 0; q < 2 * (tt + 1); ++q) { o[0] = MFMA32(Vp[q >> 1][0][q & 1], qk[2 * tt + q], o[0]); o[1] = MFMA32(Vp[q >> 1][1][q & 1], qk[2 * tt + q], o[1]); }
            float ss = 0.f;
#pragma unroll
            for (int i = 0; i < 16; ++i) ss += o[0][i] * o[0][i] + o[1][i] * o[1][i];
            ss += __shfl_xor(ss, 32);
            const float rs = __builtin_amdgcn_rsqf(ss * (1.0f / 64.0f) + EPS);
            const size_t row = r0 + 32 * tt + r;
#pragma unroll
            for (int jt = 0; jt < 2; ++jt)
#pragma unroll
                for (int g4 = 0; g4 < 4; ++g4) { const int d0 = 32 * jt + 8 * g4 + 4 * hf;
                    const unsigned trow = 32 * tt + r; const u32x2 gv = *(const LAS u32x2*)(gb + trow * 128 + (((4 * jt + g4) ^ (trow & 7)) * 16) + 8 * hf);
                    const float y0 = o[jt][4 * g4] * rs * bf2f(gv.x & 0xffffu), y1 = o[jt][4 * g4 + 1] * rs * bf2f(gv.x >> 16);
                    const float y2 = o[jt][4 * g4 + 2] * rs * bf2f(gv.y & 0xffffu), y3 = o[jt][4 * g4 + 3] * rs * bf2f(gv.y >> 16);
                    *(unsigned*)(Y + row * D + YC_A + h * 64 + d0) = q8x4(y0, y1, y2, y3); }
        }
    }
    asm volatile("s_waitcnt vmcnt(0) lgkmcnt(0)" ::: "memory");
}
__device__ __forceinline__ void sg_tile(Frame& F, int l, int unit, LAS unsigned char* wl) {
    int lane = F.lane; asm volatile("" : "+v"(lane)); const int r = lane & 31, hf = lane >> 5;
    const int h = unit & 3, bn = unit >> 2; const size_t r0 = (size_t)(bn >> 4) * SEQ + (bn & 15) * 128;
    const bf16* P = WSP(bf16, WS_P); unsigned char* Y = WSP(unsigned char, WS_Y); const bf16* wsg = WSP(bf16, WS_WSG) + (size_t)(l * 4 + h) * 128 * 128;
    LAS float* MU = (LAS float*)wl; LAS float* RS = MU + 128;
    LAS unsigned char* vt = wl + 1024;
    { u32x4 w_[16];
#pragma unroll
      for (int i = 0; i < 16; ++i) w_[i] = *(const u32x4*)(P + (r0 + 8 * i + (lane >> 3)) * NP + PC_VB + h * 64 + (lane & 7) * 8);
#pragma unroll
      for (int i = 0; i < 16; ++i) { LAS unsigned char* d_ = vt + (8 * i + (lane >> 3)) * 136 + (lane & 7) * 16; *(LAS u32x2*)d_ = (u32x2){w_[i].x, w_[i].y}; *(LAS u32x2*)(d_ + 8) = (u32x2){w_[i].z, w_[i].w}; } }
    WAVE_LDS_SYNC(); asm volatile("" ::: "memory");
#pragma unroll
    for (int tk = 0; tk < 2; ++tk) { const int s = lane + 64 * tk; const LAS u32x2* vp = (const LAS u32x2*)(vt + s * 136);
        float x[64];
#pragma unroll
        for (int c4 = 0; c4 < 16; ++c4) { const u32x2 v = vp[c4]; x[4 * c4] = bf2f(v.x & 0xffffu); x[4 * c4 + 1] = bf2f(v.x >> 16); x[4 * c4 + 2] = bf2f(v.y & 0xffffu); x[4 * c4 + 3] = bf2f(v.y >> 16); }
        float sm = 0.f;
#pragma unroll
        for (int i = 0; i < 64; ++i) sm += x[i];
        const float mu = sm * (1.0f / 64.0f); float vr = 0.f;
#pragma unroll
        for (int i = 0; i < 64; ++i) { const float dx = x[i] - mu; vr += dx * dx; }
        MU[s] = mu; RS[s] = __builtin_amdgcn_rsqf(vr * (1.0f / 64.0f) + EPS); }
    WAVE_LDS_SYNC();
    bf16x8 af[2][8];
    { const float g0 = GIN(I_GLNB)[l * 256 + h * 64 + r], g1 = GIN(I_GLNB)[l * 256 + h * 64 + 32 + r];
      const LAS bf16* vcol = (const LAS bf16*)(vt + r * 2);
#pragma unroll
      for (int ks = 0; ks < 8; ++ks) { float a0[8], a1[8];
#pragma unroll
          for (int j = 0; j < 8; ++j) { const int s = 16 * ks + 8 * hf + j; const float mu = MU[s], rs = RS[s];
              a0[j] = (bf2f(vcol[s * 68]) - mu) * rs * g0; a1[j] = (bf2f(vcol[s * 68 + 32]) - mu) * rs * g1; }
          af[0][ks] = pack8(a0[0], a0[1], a0[2], a0[3], a0[4], a0[5], a0[6], a0[7]); af[1][ks] = pack8(a1[0], a1[1], a1[2], a1[3], a1[4], a1[5], a1[6], a1[7]);
          if (ks & 1) asm volatile("" ::: "memory"); } }
#pragma unroll
    for (int tt = 0; tt < 4; ++tt) {
        f32x16 acc[2];
#pragma unroll
        for (int i = 0; i < 16; ++i) { acc[0][i] = 0.f; acc[1][i] = 0.f; }
        const bf16* wrow = wsg + (size_t)(32 * tt + r) * 128 + 8 * hf;
        bf16x8 bw[8];
#pragma unroll
        for (int ks = 0; ks < (tt < 2 ? 4 : 8); ++ks) bw[ks] = *(const bf16x8*)(wrow + 16 * ks);
        asm volatile("" ::: "memory");
#pragma unroll
        for (int ks = 0; ks < (tt < 2 ? 4 : 8); ++ks) { acc[0] = MFMA32(af[0][ks], bw[ks], acc[0]); acc[1] = MFMA32(af[1][ks], bw[ks], acc[1]); }
        const int t = 32 * tt + r; const float bias = GIN(I_BSG)[(l * 4 + h) * 128 + t]; const size_t row = r0 + t;
#pragma unroll
        for (int dt = 0; dt < 2; ++dt)
#pragma unroll
            for (int g4 = 0; g4 < 4; ++g4) { const int d0 = 32 * dt + 8 * g4 + 4 * hf; const u32x2 uv = *(const u32x2*)(P + row * NP + PC_UB + h * 64 + d0);
                *(unsigned*)(Y + row * D + YC_B + h * 64 + d0) = q8x4(bf2f(uv.x & 0xffffu) * (acc[dt][4 * g4] + bias), bf2f(uv.x >> 16) * (acc[dt][4 * g4 + 1] + bias), bf2f(uv.y & 0xffffu) * (acc[dt][4 * g4 + 2] + bias), bf2f(uv.y >> 16) * (acc[dt][4 * g4 + 3] + bias)); }
    }
    WAVE_LDS_SYNC();
}
template <int W> __device__ __forceinline__ void pool_tile_w(Frame& F, int l, int g, int tile) {
    int lane = F.lane; asm volatile("" : "+v"(lane)); const int r = lane & 31, hf = lane >> 5;
    const size_t row = (size_t)tile * 32 + r; const int t = (int)(row & (SEQ - 1));
    const bf16* P = WSP(bf16, WS_P); unsigned char* Y = WSP(unsigned char, WS_Y); const bf16* wpt = WSP(bf16, WS_WPT) + (size_t)(l * 4 + g) * 64 * 64;
    const int cnt = (t + 1 < W) ? (t + 1) : W; const float icnt = 1.0f / (float)cnt;
    f32x16 acc[2];
#pragma unroll
    for (int i = 0; i < 16; ++i) { acc[0][i] = 0.f; acc[1][i] = 0.f; }
    constexpr int KB = W <= 4 ? 4 : (W == 8 ? 2 : 1);
    const float* sp = GIN(I_SPOOL) + l * 256 + g * 64;
    bf16x8 a0[4], a1[4]; f32x4 sv[2][4];
#pragma unroll
    for (int ks = 0; ks < 4; ++ks) { a0[ks] = *(const bf16x8*)(wpt + (size_t)r * 64 + 16 * ks + 8 * hf); a1[ks] = *(const bf16x8*)(wpt + (size_t)(32 + r) * 64 + 16 * ks + 8 * hf); }
#pragma unroll
    for (int dt = 0; dt < 2; ++dt)
#pragma unroll
        for (int g4 = 0; g4 < 4; ++g4) sv[dt][g4] = *(const f32x4*)(sp + 32 * dt + 8 * g4 + 4 * hf);
#pragma unroll
    for (int kb = 0; kb < 4; kb += KB) {
        u32x4 v[KB][W];
#pragma unroll
        for (int k2 = 0; k2 < KB; ++k2) { const bf16* xp = P + row * NP + PC_XC + g * 64 + 16 * (kb + k2) + 8 * hf;
#pragma unroll
            for (int q = 0; q < W; ++q) v[k2][q] = *(const u32x4*)(xp - (size_t)(q < cnt ? q : 0) * NP); }
        asm volatile("" ::: "memory");
#pragma unroll
        for (int k2 = 0; k2 < KB; ++k2) { const int ks = kb + k2;
            float sm[8];
#pragma unroll
            for (int j = 0; j < 8; ++j) sm[j] = 0.f;
#pragma unroll
            for (int q = 0; q < W; ++q) { const float m = (q < cnt) ? 1.0f : 0.0f;
                sm[0] += m * bf2f(v[k2][q].x & 0xffffu); sm[1] += m * bf2f(v[k2][q].x >> 16); sm[2] += m * bf2f(v[k2][q].y & 0xffffu); sm[3] += m * bf2f(v[k2][q].y >> 16);
                sm[4] += m * bf2f(v[k2][q].z & 0xffffu); sm[5] += m * bf2f(v[k2][q].z >> 16); sm[6] += m * bf2f(v[k2][q].w & 0xffffu); sm[7] += m * bf2f(v[k2][q].w >> 16); }
            const bf16x8 bfr = pack8(sm[0] * icnt - bf2f(v[k2][0].x & 0xffffu), sm[1] * icnt - bf2f(v[k2][0].x >> 16), sm[2] * icnt - bf2f(v[k2][0].y & 0xffffu), sm[3] * icnt - bf2f(v[k2][0].y >> 16),
                                     sm[4] * icnt - bf2f(v[k2][0].z & 0xffffu), sm[5] * icnt - bf2f(v[k2][0].z >> 16), sm[6] * icnt - bf2f(v[k2][0].w & 0xffffu), sm[7] * icnt - bf2f(v[k2][0].w >> 16));
            acc[0] = MFMA32(a0[ks], bfr, acc[0]); acc[1] = MFMA32(a1[ks], bfr, acc[1]); }
        asm volatile("" ::: "memory"); }
#pragma unroll
    for (int dt = 0; dt < 2; ++dt)
#pragma unroll
        for (int g4 = 0; g4 < 4; ++g4) { const int d0 = 32 * dt + 8 * g4 + 4 * hf; const f32x4 svv = sv[dt][g4];
            *(unsigned*)(Y + row * D + YC_C + g * 64 + d0) = q8x4(acc[dt][4 * g4] * svv[0], acc[dt][4 * g4 + 1] * svv[1], acc[dt][4 * g4 + 2] * svv[2], acc[dt][4 * g4 + 3] * svv[3]); }
}
__device__ __forceinline__ void pool_tile(Frame& F, int l, int unit) {
    const int g = 3 - (unit >> 10), tile = unit & 1023;
    if (g == 3) pool_tile_w<16>(F, l, 3, tile); else if (g == 2) pool_tile_w<8>(F, l, 2, tile); else if (g == 1) pool_tile_w<4>(F, l, 1, tile); else pool_tile_w<2>(F, l, 0, tile);
}
__device__ __forceinline__ void mix(Frame& F, int l) {
    constexpr int NSC = 64;
    const int gw = F.bid * NWAVES + F.wave, NGW = F.G * NWAVES;
    unsigned* cnt = (unsigned*)(F.ws + WS_CTL) + CW_DNCNT;
    LAS unsigned char* wl = F.lds + F.wave * DN_WLDS;
    for (int u0 = F.bid * NWAVES; u0 < 2048; u0 += NGW) {
        if (u0 + F.wave < 2048) dn_prep(F, l, u0 + F.wave, wl);
        asm volatile("s_waitcnt vmcnt(0)" ::: "memory");
        __syncthreads();
        if (F.tid == 0) { __builtin_amdgcn_fence(__ATOMIC_RELEASE, "agent");
            asm volatile("s_waitcnt vmcnt(0)" ::: "memory");
            const int nch = 2048 - u0 < NWAVES ? 2048 - u0 : NWAVES;
            __hip_atomic_fetch_add(cnt + 64 * (u0 >> 5), (unsigned)nch, __ATOMIC_RELAXED, __HIP_MEMORY_SCOPE_AGENT); }
    }
    if (F.bid < NSC) {
        if (F.wave == 0) {
            const unsigned want = 32u * (unsigned)(l + 1); unsigned spins = 0;
            while ((unsigned)__builtin_amdgcn_readfirstlane(__hip_atomic_load(cnt + 64 * F.bid, __ATOMIC_RELAXED, __HIP_MEMORY_SCOPE_AGENT)) < want) {
                __builtin_amdgcn_s_sleep(2); if (++spins > (1u << 22)) break; }
            __builtin_amdgcn_fence(__ATOMIC_ACQUIRE, "agent");
            asm volatile("s_waitcnt vmcnt(0)" ::: "memory");
            if (F.lane == 0) ((volatile LAS unsigned*)(F.lds + SL_FLAGS))[0] = (unsigned)(l + 1);
            dn_scan_lead(F, l, F.bid);
            return; }
        if (F.wave <= 2) { dn_scan_help(F, l, F.bid, F.wave - 1); return; }
        for (int u = F.bid * 5 + F.wave - 3; u < 1024; u += NSC * 5) pool_tile(F, l, u);
        return; }
    const int wi = (F.bid - NSC) * NWAVES + F.wave, NWI = (F.G - NSC) * NWAVES;
    for (int idx = wi; idx < 8192; idx += NWI) {
        if (idx < 1024) sg_tile(F, l, idx, wl);
        else if (idx < 5120) { const int j = idx - 1024; const int qt = 63 - (j >> 6), bh = j & 63; sb_tile(F, l, bh >> 2, bh & 3, qt, wl); }
        else pool_tile(F, l, idx - 5120 + 1024);
    }
}

__device__ __forceinline__ void fin(Frame& F) {
    const int gw = F.bid * NWAVES + F.wave, NGW = F.G * NWAVES; const float* ssq = WSP(float, WS_SSQ1); const float* gf = GIN(I_GFIN); const bf16* xb = WSP(bf16, WS_XB);
    for (int r = gw; r < M; r += 2 * NGW) { const int r2 = r + NGW < M ? r + NGW : r;
        const float rsa = pg8::row_rstd(ssq, r), rsb = pg8::row_rstd(ssq, r2);
        u32x4 va[2], vb[2];
#pragma unroll
        for (int j = 0; j < 2; ++j) { va[j] = *(const u32x4*)(xb + (size_t)r * D + 512 * j + 8 * F.lane); vb[j] = *(const u32x4*)(xb + (size_t)r2 * D + 512 * j + 8 * F.lane); }
#pragma unroll
        for (int j = 0; j < 2; ++j) { const int cc = 512 * j + 8 * F.lane; const f32x4 g0 = *(const f32x4*)(gf + cc), g1 = *(const f32x4*)(gf + cc + 4);
            const f32x4 a0 = (f32x4){bf2f(va[j].x & 0xffffu), bf2f(va[j].x >> 16), bf2f(va[j].y & 0xffffu), bf2f(va[j].y >> 16)}, a1 = (f32x4){bf2f(va[j].z & 0xffffu), bf2f(va[j].z >> 16), bf2f(va[j].w & 0xffffu), bf2f(va[j].w >> 16)};
            const f32x4 b0 = (f32x4){bf2f(vb[j].x & 0xffffu), bf2f(vb[j].x >> 16), bf2f(vb[j].y & 0xffffu), bf2f(vb[j].y >> 16)}, b1 = (f32x4){bf2f(vb[j].z & 0xffffu), bf2f(vb[j].z >> 16), bf2f(vb[j].w & 0xffffu), bf2f(vb[j].w >> 16)};
            *(f32x4*)(as_global(F.out) + (size_t)r * D + cc) = a0 * rsa * g0; *(f32x4*)(as_global(F.out) + (size_t)r * D + cc + 4) = a1 * rsa * g1;
            if (r2 != r) { *(f32x4*)(as_global(F.out) + (size_t)r2 * D + cc) = b0 * rsb * g0; *(f32x4*)(as_global(F.out) + (size_t)r2 * D + cc + 4) = b1 * rsb * g1; } } }
}
#ifndef MK_PER_PHASE
#define MK_PER_PHASE 0
#endif
constexpr int N_PHASES = 2 + 6 * DEPTH + 1;
struct Args { const float* in[N_IN]; float* out; unsigned char* ws; int ph_lo, ph_hi; };
__global__ void __launch_bounds__(NTHR, 2) fwd(Args args) {
    extern __shared__ __attribute__((aligned(16))) unsigned char lds_raw[];
    Frame F;
    F.lds = (LAS unsigned char*)lds_raw;
    F.tid = threadIdx.x; F.lane = F.tid & 63; F.wave = __builtin_amdgcn_readfirstlane(F.tid >> 6);
    F.G = gridDim.x; F.bid = blockIdx.x; F.ws = args.ws; F.out = args.out;
    F.in = args.in;
    volatile LAS unsigned* MISC = (volatile LAS unsigned*)(F.lds + MISC_OFF);
    if (F.tid < 32) MISC[F.tid] = 0u;
    if (F.tid < 128) ((volatile LAS unsigned*)(F.lds + 163072))[F.tid] = 0u;
    __syncthreads();
    XcdBarrier bar; bar.bar = (unsigned*)(F.ws + WS_CTL) + CW_BAR; bar.x = 0; bar.st = nullptr;
    if (F.tid == 0) { const unsigned xcc = xb_xcc_id(); MISC[12] = xcc; MISC[13] = __hip_atomic_fetch_add((unsigned*)(F.ws + WS_CTL) + CW_XRANK + 64 * (xcc & 15), 1u, __ATOMIC_RELAXED, __HIP_MEMORY_SCOPE_AGENT); }
    int vc = F.bid;
    if (!MK_PER_PHASE) bar = xcd_barrier_post((unsigned*)(F.ws + WS_CTL) + CW_BAR, MISC + 8);
    const int lo = args.ph_lo, hi = args.ph_hi;
#define IN(k) (lo <= (k) && (k) < hi)
#define SEAMX() do { XcdBarrier b2_ = bar; unsigned* p_ = b2_.bar; unsigned x_ = b2_.x; asm volatile("" : "+s"(p_), "+s"(x_)); b2_.bar = p_; b2_.x = x_; xcd_barrier(b2_); } while (0)
#define FILL_TABLES(ssqp, swp, swld, goap, qsap, qsbp) do { const float* q_ = (ssqp); const float* s_ = (swp); const float* g_ = (goap); const float* qa_ = (qsap); const float* qb_ = (qsbp); \
    LAS float* tr_ = (LAS float*)(F.lds + RING_BYTES); LAS float* ts_ = tr_ + 2048; LAS float* tg_ = ts_ + 2048; LAS int* ul_ = (LAS int*)(tg_ + 256); LAS float* tq_ = tg_ + 512; \
      \
    if (F.tid == 0) { for (int i_ = 0; i_ < 8; ++i_) { pg8::Unit u_; const bool k_ = S.next(i_, u_); ul_[2 * i_] = k_ ? u_.pm : -1; ul_[2 * i_ + 1] = k_ ? u_.pn : 0; } } \
    asm volatile("s_waitcnt lgkmcnt(0)" ::: "memory"); __builtin_amdgcn_s_barrier(); \
    if (F.tid < 256) { float t_[8], a_s[8]; \
        _Pragma("unroll") for (int i_ = 0; i_ < 8; ++i_) { const int pm_ = ul_[2 * i_]; t_[i_] = 0.f; a_s[i_] = 1.f; if (pm_ >= 0) { const pg8::f32x4* p_ = (const pg8::f32x4*)(q_ + (size_t)(pm_ * 256 + F.tid) * 16); const pg8::f32x4 a_ = p_[0], b_ = p_[1], c_ = p_[2], d_ = p_[3]; \
            t_[i_] = ((a_[0] + a_[1]) + (a_[2] + a_[3])) + ((b_[0] + b_[1]) + (b_[2] + b_[3])) + ((c_[0] + c_[1]) + (c_[2] + c_[3])) + ((d_[0] + d_[1]) + (d_[2] + d_[3])); if (qa_) a_s[i_] = qa_[pm_ * 256 + F.tid]; } } \
        _Pragma("unroll") for (int i_ = 0; i_ < 8; ++i_) tr_[i_ * 256 + F.tid] = __builtin_amdgcn_rsqf(t_[i_] * (1.0f / 1024.0f) + 1e-6f) * a_s[i_]; \
        if (g_) tg_[F.tid] = g_[F.tid]; } \
    else { float v_[8], w_[8]; \
        _Pragma("unroll") for (int i_ = 0; i_ < 8; ++i_) { const int pm_ = ul_[2 * i_], pn_ = ul_[2 * i_ + 1]; v_[i_] = pm_ >= 0 ? s_[(size_t)(pm_ >> 3) * (swld) + pn_ * 256 + F.tid - 256] : 0.f; w_[i_] = (pm_ >= 0 && qb_) ? qb_[pn_ * 256 + F.tid - 256] : 1.f; } \
        _Pragma("unroll") for (int i_ = 0; i_ < 8; ++i_) { ts_[i_ * 256 + F.tid - 256] = v_[i_]; tq_[i_ * 256 + F.tid - 256] = w_[i_]; } } \
    asm volatile("s_waitcnt lgkmcnt(0)" ::: "memory"); __builtin_amdgcn_s_barrier(); } while (0)
#define FILL_RTAB(gatep, gnp, scp, qrefp, qsap, hsp, hcp) do { const float* ga_ = (gatep); const float* gn_ = (gnp); const float* sc_ = (scp); const float* qr_ = (qrefp); float* qa_ = (qsap); const float* hs_ = (hsp); const int* hc_ = (hcp); \
    LAS float* tis_ = (LAS float*)(F.lds + RING_BYTES); LAS float* tgs_ = tis_ + 1024; LAS float* tG_ = tgs_ + 1024; LAS int* thc_ = (LAS int*)(tG_ + 1024); LAS int* ul_ = thc_ + 1024; \
    if (F.tid == 0) { for (int i_ = 0; i_ < 4; ++i_) { pg8::Unit u_; const bool k_ = S.next(i_, u_); ul_[2 * i_] = k_ ? u_.pm : -1; ul_[2 * i_ + 1] = k_ ? u_.pn : 0; } } \
    asm volatile("s_waitcnt lgkmcnt(0)" ::: "memory"); __builtin_amdgcn_s_barrier(); \
    if (F.tid < 256) { float t_[4]; \
        _Pragma("unroll") for (int i_ = 0; i_ < 4; ++i_) { const int pm_ = ul_[2 * i_]; t_[i_] = 0.f; if (pm_ >= 0 && qr_) { const pg8::f32x4* p_ = (const pg8::f32x4*)(qr_ + (size_t)(pm_ * 256 + F.tid) * 16); const pg8::f32x4 a_ = p_[0], b_ = p_[1], c_ = p_[2], d_ = p_[3]; \
            t_[i_] = ((a_[0] + a_[1]) + (a_[2] + a_[3])) + ((b_[0] + b_[1]) + (b_[2] + b_[3])) + ((c_[0] + c_[1]) + (c_[2] + c_[3])) + ((d_[0] + d_[1]) + (d_[2] + d_[3])); } } \
        _Pragma("unroll") for (int i_ = 0; i_ < 4; ++i_) { const int pm_ = ul_[2 * i_], pn_ = ul_[2 * i_ + 1]; float v_ = 0.f; if (pm_ >= 0 && qr_) { const float rr_ = __builtin_amdgcn_rsqf(t_[i_] * (1.0f / 1024.0f) + 1e-6f); v_ = 127.0f * rr_ * (1.0f / pg8::QCLIP8); if (pn_ == 0) qa_[pm_ * 256 + F.tid] = pg8::QCLIP8 / (127.0f * rr_); } \
            tis_[i_ * 256 + F.tid] = v_; } } \
    else { const int c_ = F.tid - 256; float g_[4], G_[4]; int h_[4]; \
        _Pragma("unroll") for (int i_ = 0; i_ < 4; ++i_) { const int pm_ = ul_[2 * i_], col_ = ul_[2 * i_ + 1] * 256 + c_; g_[i_] = 0.f; G_[i_] = 0.f; h_[i_] = 0; \
            if (pm_ >= 0) { g_[i_] = ga_[(size_t)(pm_ >> 3) * 6144 + col_]; if (hs_) { g_[i_] *= hs_[col_]; if (hc_) h_[i_] = __builtin_bit_cast(int, g_[i_] * (float)(hc_[col_] * 128)); } if (gn_) G_[i_] = gn_[col_] * (sc_[(size_t)(pm_ >> 3) * 6144 + col_] + 1.0f); } } \
        _Pragma("unroll") for (int i_ = 0; i_ < 4; ++i_) { tgs_[i_ * 256 + c_] = g_[i_]; tG_[i_ * 256 + c_] = G_[i_]; thc_[i_ * 256 + c_] = h_[i_]; } } \
    asm volatile("s_waitcnt lgkmcnt(0)" ::: "memory"); __builtin_amdgcn_s_barrier(); } while (0)
#define RTABS (const LAS float*)(F.lds + RING_BYTES), (const LAS float*)(F.lds + RING_BYTES + 4096), (const LAS float*)(F.lds + RING_BYTES + 8192), (const LAS int*)(F.lds + RING_BYTES + 12288)
#define FRESH() do { int t_ = threadIdx.x; asm volatile("" : "+v"(t_)); F.tid = t_; F.lane = t_ & 63; F.wave = __builtin_amdgcn_readfirstlane(t_ >> 6); unsigned long long z_ = 0ull; asm volatile("" : "+s"(z_)); F.ws = args.ws + z_; } while (0)
#define SEAM(k) do { if (!MK_PER_PHASE && IN(k) && IN((k) + 1)) { XcdBarrier b2_ = bar; unsigned* p_ = b2_.bar; unsigned x_ = b2_.x; asm volatile("" : "+s"(p_), "+s"(x_)); b2_.bar = p_; b2_.x = x_; xcd_barrier(b2_); } } while (0)

    #ifndef SKIP_P0
    if (IN(0)) { FRESH(); p0a(F); }
#endif
    SEAM(0);
    if (!MK_PER_PHASE) { bool even = (F.G % 8 == 0); for (int j = 0; j < 16; ++j) { const unsigned n_ = __hip_atomic_load((unsigned*)(F.ws + WS_CTL) + CW_XRANK + 64 * j, __ATOMIC_RELAXED, __HIP_MEMORY_SCOPE_AGENT); even = even && ((unsigned)__builtin_amdgcn_readfirstlane((int)n_) == (j < 8 ? (unsigned)F.G / 8u : 0u)); }
        if (even) vc = __builtin_amdgcn_readfirstlane((int)(MISC[13] * 8u + MISC[12])); }
    #ifndef SKIP_P0
    if (IN(1)) { FRESH(); p0b(F); }
#if defined(PROBE_REP) && PROBE_REP == 9
    SEAMX(); if (IN(0)) { FRESH(); p0a(F); } SEAMX(); if (IN(1)) { FRESH(); p0b(F); }
#endif
#endif
    SEAM(1);
    for (int l = 0; l < DEPTH; ++l) {
        const int pb = 2 + 6 * l;
#define modl (WSP(float, WS_MOD) + (size_t)l * 16 * NMOD)
#ifndef SKIP_G1
        if (IN(pb)) {
            FRESH();
            pg8::Gemm g{WSP(bf16, WS_XG), WSP(bf16, WS_WIN) + (size_t)l * NP * D, M, NP, D / 2, D / 2, D};     pg8::StaticOrder S; S.init(M, NP, F.G, vc);
            pg8::EpiNormed<0, true> E{WSP(bf16, WS_P), NP, (const LAS float*)(F.lds + RING_BYTES), (const LAS float*)(F.lds + RING_BYTES + 8192), (const LAS float*)(F.lds + RING_BYTES + 16384), (const LAS float*)(F.lds + RING_BYTES + 16384 + 2048)};
            { auto pre = [&]() { FILL_TABLES(WSP(float, WS_SSQ1), WSP(float, WS_SW1) + (size_t)l * 16 * NP, NP, GIN(I_GOA) + l * 256, WSP(float, WS_QSA1), WSP(float, WS_QSB1) + (size_t)l * NP); }; pg8::gemm_phase<pg8::EpiNormed<0, true>, pg8::StaticOrder, true, true>(F.lds, g, S, E, pre); }
#if defined(PROBE_REP) && PROBE_REP == 6
            SEAMX(); FRESH(); pg8::gemm_phase<pg8::EpiNormed<0, true>, pg8::StaticOrder, true, true>(F.lds, g, S, E);
#endif
#ifndef SKIP_AB
            FRESH(); ab_logits(F, l);
#if defined(PROBE_REP) && PROBE_REP == 11
            SEAMX(); FRESH(); ab_logits(F, l);
#endif
#endif
        }
#endif
        SEAM(pb);
        if (IN(pb + 1)) { FRESH(); mix(F, l); }
        SEAM(pb + 2);
#ifndef SKIP_G2
        if (IN(pb + 3)) {
            FRESH();
            pg8::Gemm g{WSP(bf16, WS_Y), WSP(bf16, WS_WOUT) + (size_t)l * D * D, M, D, D / 2, D / 2, D};     pg8::StaticOrder S; S.init(M, D, F.G, vc);
            { pg8::EpiResid<false, false, true, true> E{WSP(bf16, WS_XB), WSP(bf16, WS_XB), WSP(bf16, WS_XQ), WSP(float, WS_SSQ2), RTABS};
                auto pre = [&]() { FILL_RTAB(modl + 2 * D, GIN(I_GN2) + (size_t)l * D, modl + 4 * D, WSP(float, WS_SSQ1), WSP(float, WS_QSA), WSP(float, WS_QSBO) + l * D, (const int*)nullptr); }; pg8::gemm_phase<pg8::EpiResid<false, false, true, true>, pg8::StaticOrder, true, true>(F.lds, g, S, E, pre); }
        }
#endif
        SEAM(pb + 3);
#ifndef SKIP_G3
        if (IN(pb + 4)) {
            FRESH();
            pg8::Gemm g{WSP(bf16, WS_XQ), WSP(bf16, WS_WFF1) + (size_t)l * FF * D, M, FF, D / 2, D / 2, D};     pg8::StaticOrder S; S.init(M, FF, F.G, vc);
            pg8::EpiNormed<1, true, true> E{WSP(bf16, WS_HID), FF, (const LAS float*)(F.lds + RING_BYTES), (const LAS float*)(F.lds + RING_BYTES + 8192), (const LAS float*)nullptr, (const LAS float*)(F.lds + RING_BYTES + 16384 + 2048)};
            { auto pre = [&]() { FILL_TABLES(WSP(float, WS_SSQ2), WSP(float, WS_SW2) + (size_t)l * 16 * FF, FF, (const float*)nullptr, WSP(float, WS_QSA), WSP(float, WS_QSB) + (size_t)l * FF); }; pg8::gemm_phase<pg8::EpiNormed<1, true, true>, pg8::StaticOrder, true, true>(F.lds, g, S, E, pre); }
#if defined(PROBE_REP) && PROBE_REP == 8
            { SEAMX(); FRESH(); pg8::EpiNull EN{WSP(float, WS_BETA)}; pg8::gemm_phase<pg8::EpiNull, pg8::StaticOrder, true, true>(F.lds, g, S, EN); }
#endif
#if defined(PROBE_REP) && PROBE_REP == 12
            { SEAMX(); FRESH(); pg8::EpiNormed<1, true, true> E2 = E; E2.nost = (args.ph_hi != 12345); pg8::gemm_phase<pg8::EpiNormed<1, true, true>, pg8::StaticOrder, true, true>(F.lds, g, S, E2); }
#endif
#if defined(PROBE_REP) && PROBE_REP == 7
            SEAMX(); FRESH(); pg8::gemm_phase<pg8::EpiNormed<1, true, true>, pg8::StaticOrder, true, true>(F.lds, g, S, E);
#endif
        }
#endif
        SEAM(pb + 4);
#ifndef SKIP_G4
        if (IN(pb + 5)) {
            FRESH();
            pg8::Gemm g{WSP(bf16, WS_HID), WSP(bf16, WS_WFF2) + (size_t)l * D * FF, M, D, FF / 2, FF / 2, FF};     pg8::StaticOrder S; S.init(M, D, F.G, vc);
            const bool more = l + 1 < DEPTH;
            if (more) {
                pg8::EpiResid<false, false, true, true> E{WSP(bf16, WS_XB), WSP(bf16, WS_XB), WSP(bf16, WS_XG), WSP(float, WS_SSQ1), RTABS};
                auto pre = [&]() { FILL_RTAB(modl + 5 * D, GIN(I_GN1) + (size_t)(l + 1) * D, modl + 16 * NMOD + D, WSP(float, WS_SSQ2), WSP(float, WS_QSA1), WSP(float, WS_QSB2) + l * D, WSP(int, WS_QCS2) + l * D); }; pg8::gemm_phase<pg8::EpiResid<false, false, true, true>, pg8::StaticOrder, true, true>(F.lds, g, S, E, pre); }
            else {
                pg8::EpiResid<false, false, false, true> E{WSP(bf16, WS_XB), WSP(bf16, WS_XB), (bf16*)nullptr, WSP(float, WS_SSQ1), RTABS};
                auto pre = [&]() { FILL_RTAB(modl + 5 * D, (const float*)nullptr, (const float*)nullptr, (const float*)nullptr, (float*)nullptr, WSP(float, WS_QSB2) + l * D, WSP(int, WS_QCS2) + l * D); }; pg8::gemm_phase<pg8::EpiResid<false, false, false, true>, pg8::StaticOrder, true, true>(F.lds, g, S, E, pre); }
        }
#endif
        SEAM(pb + 5);
    }
#ifndef SKIP_FIN
    if (IN(N_PHASES - 1)) { FRESH(); fin(F); }
#endif
#undef modl
#undef IN
#undef SEAM
}

extern "C" void kernel_launch(void* const* d_in, const int* in_sizes, int n_in, void* d_out, int out_size, void* d_ws, size_t ws_size, hipStream_t stream) {
    static int grid = 0;
    if (grid == 0) {
        if (n_in != N_IN || in_sizes[0] != M * D || out_size != M * D || ws_size < WS_END) { fprintf(stderr, "kernel_launch: unexpected shapes (n_in %d, in0 %d, out %d, ws %zu); nothing launched\n", n_in, n_in > 0 ? in_sizes[0] : -1, out_size, ws_size); grid = -1; return; }
        int dev = 0, cus = 0, per_cu = 0;
        if (hipGetDevice(&dev) != hipSuccess || hipDeviceGetAttribute(&cus, hipDeviceAttributeMultiprocessorCount, dev) != hipSuccess) { fprintf(stderr, "kernel_launch: device query failed\n"); grid = -1; return; }
        if (hipFuncSetAttribute((const void*)fwd, hipFuncAttributeMaxDynamicSharedMemorySize, LDS_BYTES) != hipSuccess) { fprintf(stderr, "kernel_launch: hipFuncSetAttribute failed\n"); grid = -1; return; }
        if (hipOccupancyMaxActiveBlocksPerMultiprocessor(&per_cu, (const void*)fwd, NTHR, LDS_BYTES) != hipSuccess || per_cu < 1) fprintf(stderr, "kernel_launch: note: occupancy query reports %d workgroups per CU\n", per_cu);
        (void)hipGetLastError();
        grid = cus;
    }
    if (grid < 0) return;
    if (hipMemsetAsync((char*)d_ws + WS_CTL, 0, CTL_ZERO_BYTES, stream) != hipSuccess) { fprintf(stderr, "kernel_launch: memset failed\n"); return; }
    Args a{};
    for (int i = 0; i < N_IN; ++i) a.in[i] = (const float*)d_in[i];
    a.out = (float*)d_out; a.ws = (unsigned char*)d_ws;
#if MK_PER_PHASE
    for (int ph = 0; ph < N_PHASES; ++ph) { a.ph_lo = ph; a.ph_hi = ph + 1; hipLaunchKernelGGL(fwd, dim3(grid), dim3(NTHR), LDS_BYTES, stream, a); }
#else
    a.ph_lo = 0; a.ph_hi = N_PHASES; hipLaunchKernelGGL(fwd, dim3(grid), dim3(NTHR), LDS_BYTES, stream, a);
#endif
    const hipError_t le = hipPeekAtLastError();
    if (le != hipSuccess) fprintf(stderr, "kernel_launch: launch failed: %s\n", hipGetErrorName(le));
}
```

```cpp
#include <hip/hip_runtime.h>
#include <cstdio>
#include <cstdint>
#define MK_PER_PHASE 0
namespace pg8 {
#define PG8_LAS __attribute__((address_space(3)))
typedef unsigned short bf16_t;
typedef short bf16x8 __attribute__((ext_vector_type(8)));
typedef float f32x4 __attribute__((ext_vector_type(4)));
typedef unsigned u32x4 __attribute__((ext_vector_type(4)));
constexpr int BM = 256, BK = 64, HALF = 128, HTB = HALF * BK * 2  , STAGE_BYTES = 8 * HTB, NXCD = 8, WGM = 8;

__host__ __device__ __forceinline__ int lds_byte(int r, int c) { const int st = (r >> 4) * 2 + (c >> 5), rr = r & 15, cc = c & 31, ob = rr * 64 + cc * 2; return st * 1024 + (ob ^ (((ob >> 9) & 1) << 5)); }
__host__ __device__ __forceinline__ void stage_rc(int b, int& R, int& C) { const int st = b / 1024, sb = b % 1024, swz = sb ^ (((sb >> 9) & 1) << 5); R = (st >> 1) * 16 + swz / 64; C = (st & 1) * 32 + (swz % 64) / 2; }
__host__ __device__ __forceinline__ int perm32(int rho) { const int n = rho >> 4, i = rho & 15; return 8 * (i >> 2) + 4 * n + (i & 3); }

struct Unit { int pm, pn, slot; };
struct Gemm { const bf16_t* A; const bf16_t* Bt; int M, N, K, lda, ldb; };
typedef int i32x4 __attribute__((ext_vector_type(4)));

struct StaticOrder {
    int nM, nN, nwg, G, c;
    __host__ __device__ __forceinline__ void init(int M, int N, int G_, int c_) { nM = M / BM; nN = N / BM; nwg = nM * nN; G = G_; c = c_; }
    __host__ __device__ __forceinline__ bool next(int i, Unit& u) const {
        const int L = i * G + c; if (L >= nwg) return false;
        int wgid = L; { const int q = nwg / NXCD, r = nwg % NXCD, xcd = wgid % NXCD, off = wgid / NXCD; wgid = (xcd < r ? xcd * (q + 1) : r * (q + 1) + (xcd - r) * q) + off; }
        const int nig = WGM * nN, gid = wgid / nig, fm = gid * WGM, gsz = (nM - fm) < WGM ? (nM - fm) : WGM;
        u.pm = fm + ((wgid % nig) % gsz); u.pn = (wgid % nig) / gsz; u.slot = i; return true;
    }
    __device__ __forceinline__ void a_ready(const Unit&) const {}
    __device__ __forceinline__ void done(const Unit&) const {}
};
__device__ __forceinline__ unsigned cvt_pk_bf16(float lo, float hi) { unsigned r; asm volatile("v_cvt_pk_bf16_f32 %0, %1, %2" : "=v"(r) : "v"(lo), "v"(hi)); return r; }
typedef float f32x2 __attribute__((ext_vector_type(2))); typedef unsigned u32x2_t __attribute__((ext_vector_type(2)));
constexpr float QCLIP8 = 8.0f;
constexpr float HCLIP8 = 40.0f;
__device__ __forceinline__ float row_rstd(const float* ssq, int row) {
    const f32x4* p = (const f32x4*)(ssq + (size_t)row * 16);
    const f32x4 a = p[0], b = p[1], c = p[2], d = p[3];
    const float s = ((a[0] + a[1]) + (a[2] + a[3])) + ((b[0] + b[1]) + (b[2] + b[3])) + ((c[0] + c[1]) + (c[2] + c[3])) + ((d[0] + d[1]) + (d[2] + d[3]));
    return __builtin_amdgcn_rsqf(s * (1.0f / 1024.0f) + 1e-6f);
}
template <int ACT, bool I8_ = false, bool OUT8 = false> struct EpiNormed {
    static constexpr bool PERM = true, AFTER_DRAIN = false, I8 = I8_, P16 = OUT8;
    bf16_t* O; int ldc; const PG8_LAS float* rtab; const PG8_LAS float* stab; const PG8_LAS float* gtab; const PG8_LAS float* qtab; int nost = 0;
    __device__ __forceinline__ void operator()(const f32x4 (&acc)[2][2][4][2], const Unit& u, int wr, int wc, int fr, int fq) const {
        const int lc0 = P16 ? wc * 64 + 16 * fq : wc * 32 + 8 * fq;
        constexpr int BJS = P16 ? 8 : HALF;
        const int row0 = u.pm * BM + wr * 64 + fr, col0 = u.pn * BM + lc0;
        f32x4 bv[2][2];
#pragma unroll
        for (int bj = 0; bj < 2; ++bj)
#pragma unroll
            for (int n = 0; n < 2; ++n) { bv[bj][n] = *(const PG8_LAS f32x4*)(stab + u.slot * BM + lc0 + bj * BJS + 4 * n); if (OUT8) bv[bj][n] = bv[bj][n] * __builtin_sqrtf(255.0f / HCLIP8); }
        const bool gsel = (ACT == 0) && gtab != nullptr && u.pn == 3;
        f32x4 gv[2][2];
#pragma unroll
        for (int bj = 0; bj < 2; ++bj)
#pragma unroll
            for (int n = 0; n < 2; ++n) gv[bj][n] = I8 ? *(const PG8_LAS f32x4*)(qtab + u.slot * BM + lc0 + bj * BJS + 4 * n) : (f32x4){1.f, 1.f, 1.f, 1.f};
#pragma unroll
        for (int ai = 0; ai < 2; ++ai)
#pragma unroll
            for (int m = 0; m < 4; ++m) { const int row = row0 + ai * HALF + m * 16; float rs = rtab[u.slot * BM + wr * 64 + fr + ai * HALF + m * 16]; if (OUT8) rs *= __builtin_sqrtf(255.0f / HCLIP8);
                bf16_t* rowp = O + (size_t)row * ldc + col0; u32x2_t wlo = {0u, 0u};
#pragma unroll
                for (int bj = 0; bj < 2; ++bj) { f32x4 a0 = acc[ai][bj][m][0], a1 = acc[ai][bj][m][1];
                    if (I8) { a0 = __builtin_convertvector(__builtin_bit_cast(i32x4, a0), f32x4); a1 = __builtin_convertvector(__builtin_bit_cast(i32x4, a1), f32x4); }
                    f32x4 v0, v1;
                    {
                        const f32x2 rs2 = {rs, rs};
                        f32x2 p0 = {a0[0], a0[1]}, p1 = {a0[2], a0[3]}, p2 = {a1[0], a1[1]}, p3 = {a1[2], a1[3]};
                        if (I8) { p0 = p0 * (f32x2){gv[bj][0][0], gv[bj][0][1]}; p1 = p1 * (f32x2){gv[bj][0][2], gv[bj][0][3]}; p2 = p2 * (f32x2){gv[bj][1][0], gv[bj][1][1]}; p3 = p3 * (f32x2){gv[bj][1][2], gv[bj][1][3]}; }
                        p0 = __builtin_elementwise_fma(p0, rs2, (f32x2){bv[bj][0][0], bv[bj][0][1]}); p1 = __builtin_elementwise_fma(p1, rs2, (f32x2){bv[bj][0][2], bv[bj][0][3]});
                        p2 = __builtin_elementwise_fma(p2, rs2, (f32x2){bv[bj][1][0], bv[bj][1][1]}); p3 = __builtin_elementwise_fma(p3, rs2, (f32x2){bv[bj][1][2], bv[bj][1][3]});
                        v0 = (f32x4){p0[0], p0[1], p1[0], p1[1]}; v1 = (f32x4){p2[0], p2[1], p3[0], p3[1]}; }
                    if (gsel) { const f32x4 gg0 = *(const PG8_LAS f32x4*)(gtab + lc0 + bj * BJS), gg1 = *(const PG8_LAS f32x4*)(gtab + lc0 + bj * BJS + 4);
#pragma unroll
                        for (int j = 0; j < 4; ++j) { v0[j] = v0[j] * __builtin_amdgcn_rcpf(1.0f + __expf(-v0[j])) * gg0[j]; v1[j] = v1[j] * __builtin_amdgcn_rcpf(1.0f + __expf(-v1[j])) * gg1[j]; } }
                    if (ACT == 1 && !OUT8) {
#pragma unroll
                        for (int j = 0; j < 4; ++j) { const float a = fmaxf(v0[j], 0.f), b = fmaxf(v1[j], 0.f); v0[j] = a * a; v1[j] = b * b; } }
                    if (OUT8) {
                        unsigned w0 = 0u, w1 = 0u;
#pragma unroll
                        for (int j = 0; j < 4; ++j) { w0 = __builtin_amdgcn_cvt_pk_u8_f32(v0[j] * __builtin_fabsf(v0[j]), j, w0); w1 = __builtin_amdgcn_cvt_pk_u8_f32(v1[j] * __builtin_fabsf(v1[j]), j, w1); }
                        if (bj == 0) { wlo.x = w0 ^ 0x80808080u; wlo.y = w1 ^ 0x80808080u; }
                        else { u32x4 w; w.x = wlo.x; w.y = wlo.y; w.z = w0 ^ 0x80808080u; w.w = w1 ^ 0x80808080u;
#ifdef PROBE_REP
                            if (nost) { asm volatile("" :: "v"(w.x), "v"(w.y), "v"(w.z), "v"(w.w)); } else
#endif
                            *(u32x4*)((unsigned char*)O + (size_t)row * ldc + col0) = w; } }
                    else { u32x4 w; w.x = cvt_pk_bf16(v0[0], v0[1]); w.y = cvt_pk_bf16(v0[2], v0[3]); w.z = cvt_pk_bf16(v1[0], v1[1]); w.w = cvt_pk_bf16(v1[2], v1[3]);
                        *(u32x4*)(rowp + bj * BJS) = w; } } }
    }
};
template <bool XI32, bool XO32, bool XQ8 = false, bool I8_ = false> struct EpiResid {
    static constexpr bool PERM = true, AFTER_DRAIN = false, I8 = I8_, P16 = false;
    const void* xi; void* xo; bf16_t* xg; float* ssq; const PG8_LAS float* tis; const PG8_LAS float* tgs; const PG8_LAS float* tG; const PG8_LAS int* thc;
    __device__ __forceinline__ void operator()(const f32x4 (&acc)[2][2][4][2], const Unit& u, int wr, int wc, int fr, int fq) const {
        const int row0 = u.pm * BM + wr * 64 + fr, col0 = u.pn * BM + wc * 32 + 8 * fq, lc0 = u.slot * BM + wc * 32 + 8 * fq;
        f32x2 sq[2][4]; float isq[2][4];
#pragma unroll
        for (int ai = 0; ai < 2; ++ai)
#pragma unroll
            for (int m = 0; m < 4; ++m) { sq[ai][m] = (f32x2){0.f, 0.f}; isq[ai][m] = XQ8 ? tis[u.slot * BM + wr * 64 + fr + ai * HALF + m * 16] : 0.f; }
#pragma unroll
        for (int bj = 0; bj < 2; ++bj) {
            const int col = col0 + bj * HALF, lc = lc0 + bj * HALF;
            const f32x4 g0 = *(const PG8_LAS f32x4*)(tgs + lc), g1 = *(const PG8_LAS f32x4*)(tgs + lc + 4);
            f32x4 G0 = (f32x4){0.f, 0.f, 0.f, 0.f}, G1 = G0, hc0 = G0, hc1 = G0;
            if (I8) { hc0 = *(const PG8_LAS f32x4*)((const PG8_LAS float*)thc + lc); hc1 = *(const PG8_LAS f32x4*)((const PG8_LAS float*)thc + lc + 4); }
            if (xg) { G0 = *(const PG8_LAS f32x4*)(tG + lc); G1 = *(const PG8_LAS f32x4*)(tG + lc + 4); }
#pragma unroll
            for (int ai = 0; ai < 2; ++ai)
#pragma unroll
                for (int m = 0; m < 4; ++m) { const int row = row0 + ai * HALF + m * 16; const size_t off = (size_t)row * 1024 + col;
                    f32x4 x0, x1;
                    if (XI32) { x0 = *(const f32x4*)((const float*)xi + off); x1 = *(const f32x4*)((const float*)xi + off + 4); }
                    else { const u32x4 xv = *(const u32x4*)((const bf16_t*)xi + off);
                        x0 = (f32x4){__uint_as_float(xv.x << 16), __uint_as_float(xv.x & 0xffff0000u), __uint_as_float(xv.y << 16), __uint_as_float(xv.y & 0xffff0000u)};
                        x1 = (f32x4){__uint_as_float(xv.z << 16), __uint_as_float(xv.z & 0xffff0000u), __uint_as_float(xv.w << 16), __uint_as_float(xv.w & 0xffff0000u)}; }
                    f32x4 a0 = acc[ai][bj][m][0], a1 = acc[ai][bj][m][1];
                    if (I8) { a0 = __builtin_convertvector(__builtin_bit_cast(i32x4, a0), f32x4); a1 = __builtin_convertvector(__builtin_bit_cast(i32x4, a1), f32x4); x0 = x0 + hc0; x1 = x1 + hc1; }
                    const f32x4 y0 = x0 + g0 * a0, y1 = x1 + g1 * a1;
                    if (XO32) { *(f32x4*)((float*)xo + off) = y0; *(f32x4*)((float*)xo + off + 4) = y1; }
                    else { u32x4 w; w.x = cvt_pk_bf16(y0[0], y0[1]); w.y = cvt_pk_bf16(y0[2], y0[3]); w.z = cvt_pk_bf16(y1[0], y1[1]); w.w = cvt_pk_bf16(y1[2], y1[3]); *(u32x4*)((bf16_t*)xo + off) = w; }
                    { const f32x2 ya = {y0[0], y0[1]}, yb = {y0[2], y0[3]}, yc = {y1[0], y1[1]}, yd = {y1[2], y1[3]}; sq[ai][m] = __builtin_elementwise_fma(ya, ya, sq[ai][m]); sq[ai][m] = __builtin_elementwise_fma(yb, yb, sq[ai][m]); sq[ai][m] = __builtin_elementwise_fma(yc, yc, sq[ai][m]); sq[ai][m] = __builtin_elementwise_fma(yd, yd, sq[ai][m]); }
                    if (xg) { f32x4 z0 = y0 * G0, z1 = y1 * G1;
                        if (XQ8) { const f32x2 is2 = {isq[ai][m], isq[ai][m]}, c128 = {128.0f, 128.0f};
                            { const f32x2 q0 = __builtin_elementwise_fma((f32x2){z0[0], z0[1]}, is2, c128), q1 = __builtin_elementwise_fma((f32x2){z0[2], z0[3]}, is2, c128), q2 = __builtin_elementwise_fma((f32x2){z1[0], z1[1]}, is2, c128), q3 = __builtin_elementwise_fma((f32x2){z1[2], z1[3]}, is2, c128);
                              z0 = (f32x4){q0[0], q0[1], q1[0], q1[1]}; z1 = (f32x4){q2[0], q2[1], q3[0], q3[1]}; }
                            unsigned w0 = 0u, w1 = 0u;
#pragma unroll
                            for (int j = 0; j < 4; ++j) { w0 = __builtin_amdgcn_cvt_pk_u8_f32(z0[j], j, w0); w1 = __builtin_amdgcn_cvt_pk_u8_f32(z1[j], j, w1); }
                            u32x2_t w; w.x = w0 ^ 0x80808080u; w.y = w1 ^ 0x80808080u;
                            *(u32x2_t*)((unsigned char*)xg + off) = w; }
                        else { u32x4 w; w.x = cvt_pk_bf16(z0[0], z0[1]); w.y = cvt_pk_bf16(z0[2], z0[3]); w.z = cvt_pk_bf16(z1[0], z1[1]); w.w = cvt_pk_bf16(z1[2], z1[3]);
                            *(u32x4*)(xg + off) = w; } } }
        }
        float s8[2][4];
#pragma unroll
        for (int ai = 0; ai < 2; ++ai)
#pragma unroll
            for (int m = 0; m < 4; ++m) { float s = sq[ai][m][0] + sq[ai][m][1]; s += __shfl_xor(s, 16); s += __shfl_xor(s, 32); s8[ai][m] = s; }
#pragma unroll
        for (int ai = 0; ai < 2; ++ai) { const float v = fq == 0 ? s8[ai][0] : fq == 1 ? s8[ai][1] : fq == 2 ? s8[ai][2] : s8[ai][3];
            ssq[(size_t)(row0 + ai * HALF + fq * 16) * 16 + u.pn * 4 + wc] = v; }
    }
};
struct EpiNull {
    static constexpr bool PERM = true, AFTER_DRAIN = false, I8 = false, P16 = false;
    float* sink;
    __device__ __forceinline__ void operator()(const f32x4 (&acc)[2][2][4][2], const Unit& u, int wr, int wc, int fr, int fq) const {
        float s = 0.f;
#pragma unroll
        for (int ai = 0; ai < 2; ++ai)
#pragma unroll
            for (int bj = 0; bj < 2; ++bj)
#pragma unroll
                for (int m = 0; m < 4; ++m)
#pragma unroll
                    for (int n = 0; n < 2; ++n) s += acc[ai][bj][m][n][0] + acc[ai][bj][m][n][1] + acc[ai][bj][m][n][2] + acc[ai][bj][m][n][3];
        if (s == 123.456f) sink[0] = s;
    }
};
struct NoPre { __device__ __forceinline__ void operator()() const {} };
template <class Epi, class Sched, bool ALIGN_EPI = false, bool SP2 = false, class Pre = NoPre>
__device__ __forceinline__ void gemm_phase(PG8_LAS unsigned char* lds, const Gemm g, const Sched& S, const Epi& E, const Pre& pre = Pre()) {
    int tid_ = threadIdx.x; asm volatile("" : "+v"(tid_));
    const int tid = tid_, wid = __builtin_amdgcn_readfirstlane(tid >> 6), lane = tid & 63, wr = wid >> 2, wc = wid & 3, fr = lane & 15, fq = lane >> 4;
    const int K = g.K, nt = K / BK;
    unsigned voffA[2], voffB[2];
#pragma unroll
    for (int i = 0; i < 2; ++i) { int R, C; stage_rc(tid * 16 + i * 8192, R, C); const int Rb = Epi::P16 ? ((R >> 5) * 64 + 16 * ((R >> 2) & 3) + 4 * ((R >> 4) & 1) + (R & 3)) : Epi::PERM ? ((R & ~31) + perm32(R & 31)) : R;
        voffA[i] = (unsigned)(R * g.lda + C) * 2u; voffB[i] = (unsigned)(Rb * g.ldb + C) * 2u; }
    const size_t kstep = (size_t)(BK * 2);
    const size_t hstepA = (size_t)HALF * g.lda * 2, tstepA = 2 * hstepA;
    const size_t tstepB = (size_t)2 * HALF * g.ldb * 2, hstepB = Epi::P16 ? (size_t)8 * g.ldb * 2 : (size_t)HALF * g.ldb * 2;
    const unsigned ldsw = (unsigned)wid * 1024u;
    const int aoff = lds_byte(wr * 64 + fr, fq * 8), boff = lds_byte(wc * 32 + fr, fq * 8);
#define PG8_SA(b, h) (((b) * 2 + (h)) * HTB)
#define PG8_SB(b, h) ((4 + (b) * 2 + (h)) * HTB)
#define PG8_STAGE(bufoff, gbase, voff) do { _Pragma("unroll") for (int _i = 0; _i < 2; ++_i) \
        __builtin_amdgcn_global_load_lds((const unsigned*)((const char*)(gbase) + (voff)[_i]), (PG8_LAS unsigned*)(lds + (bufoff) + ldsw + _i * 8192), 16, 0, 0); } while (0)
#define PG8_LDA(dst, b, h) do { _Pragma("unroll") for (int m = 0; m < 4; ++m) _Pragma("unroll") for (int k = 0; k < 2; ++k) dst[m][k] = *(const PG8_LAS bf16x8*)(lds + PG8_SA(b, h) + aoff + m * 2048 + k * 1024); } while (0)
#define PG8_LDB(dst, b, h) do { _Pragma("unroll") for (int n = 0; n < 2; ++n) _Pragma("unroll") for (int k = 0; k < 2; ++k) dst[n][k] = *(const PG8_LAS bf16x8*)(lds + PG8_SB(b, h) + boff + n * 2048 + k * 1024); } while (0)
#define PG8_MMA(ai, bj, At, Bt) do { __builtin_amdgcn_s_setprio(1); _Pragma("unroll") for (int m = 0; m < 4; ++m) _Pragma("unroll") for (int n = 0; n < 2; ++n) _Pragma("unroll") for (int k = 0; k < 2; ++k) \
        { if constexpr (Epi::I8) acc[ai][bj][m][n] = __builtin_bit_cast(f32x4, __builtin_amdgcn_mfma_i32_16x16x64_i8(__builtin_bit_cast(i32x4, Bt[n][k]), __builtin_bit_cast(i32x4, At[m][k]), __builtin_bit_cast(i32x4, acc[ai][bj][m][n]), 0, 0, 0)); \
          else acc[ai][bj][m][n] = __builtin_amdgcn_mfma_f32_16x16x32_bf16(Bt[n][k], At[m][k], acc[ai][bj][m][n], 0, 0, 0); } __builtin_amdgcn_s_setprio(0); } while (0)
#define PG8_WAIT_V(n) asm volatile("s_waitcnt vmcnt(" #n ")" ::: "memory")
#define PG8_WAIT_L(n) asm volatile("s_waitcnt lgkmcnt(" #n ")" ::: "memory")
#define PG8_BAR __builtin_amdgcn_s_barrier()
#define PG8_SCHED __builtin_amdgcn_sched_barrier(0)
    Unit cur, nxt; int ui = 0;
    if (!S.next(0, cur)) return;
    f32x4 acc[2][2][4][2];
#pragma unroll
    for (int a = 0; a < 2; ++a)
#pragma unroll
        for (int b = 0; b < 2; ++b)
#pragma unroll
            for (int m = 0; m < 4; ++m)
#pragma unroll
                for (int n = 0; n < 2; ++n) acc[a][b][m][n] = (f32x4){0.f, 0.f, 0.f, 0.f};
    bf16x8 At[4][2], B0[2][2], B1[2][2];
    const char* cA = (const char*)g.A + (size_t)cur.pm * tstepA; const char* cB = (const char*)g.Bt + (size_t)cur.pn * tstepB;
    S.a_ready(cur);
    if constexpr (SP2) {
        PG8_STAGE(PG8_SB(0, 0), cB, voffB); PG8_STAGE(PG8_SB(0, 1), cB + hstepB, voffB); PG8_STAGE(PG8_SA(0, 0), cA, voffA); PG8_STAGE(PG8_SA(0, 1), cA + hstepA, voffA);
        pre();
        if (wr == 1) PG8_BAR;
        PG8_WAIT_V(2); PG8_BAR;
        PG8_STAGE(PG8_SB(1, 0), cB + kstep, voffB); PG8_STAGE(PG8_SA(1, 0), cA + kstep, voffA); PG8_STAGE(PG8_SB(1, 1), cB + hstepB + kstep, voffB);
        PG8_WAIT_V(6); PG8_BAR;
    } else {
        PG8_STAGE(PG8_SB(0, 0), cB, voffB); PG8_STAGE(PG8_SA(0, 0), cA, voffA); PG8_STAGE(PG8_SB(0, 1), cB + hstepB, voffB); PG8_STAGE(PG8_SA(0, 1), cA + hstepA, voffA);
        if (wr == 1) PG8_BAR;
        PG8_WAIT_V(4); PG8_BAR;
        PG8_STAGE(PG8_SB(1, 0), cB + kstep, voffB); PG8_STAGE(PG8_SA(1, 0), cA + kstep, voffA); PG8_STAGE(PG8_SB(1, 1), cB + hstepB + kstep, voffB);
        PG8_WAIT_V(6); PG8_BAR;
    }
    for (;;) {
        const bool has_next = S.next(ui + 1, nxt);
        const char* nA = has_next ? (const char*)g.A + (size_t)nxt.pm * tstepA : cA; const char* nB = has_next ? (const char*)g.Bt + (size_t)nxt.pn * tstepB : cB;
        for (int t = 0; t < nt; t += 2) {
            const bool last = (t == nt - 2);
            const char* a1 = cA + (size_t)(t + 1) * kstep;
            const char* a2 = last ? nA : cA + (size_t)(t + 2) * kstep; const char* b2 = last ? nB : cB + (size_t)(t + 2) * kstep;
            const char* a3 = a2 + kstep; const char* b3 = b2 + kstep;
            if (last && has_next) S.a_ready(nxt);
            if constexpr (SP2) {
            PG8_LDB(B0, 0, 0); PG8_LDB(B1, 0, 1); PG8_SCHED; PG8_LDA(At, 0, 0); PG8_STAGE(PG8_SA(1, 1), a1 + hstepA, voffA);
            PG8_WAIT_V(8); PG8_WAIT_L(0); PG8_BAR; PG8_MMA(0, 0, At, B0); PG8_MMA(0, 1, At, B1); PG8_BAR; PG8_SCHED;
            PG8_LDA(At, 0, 1); PG8_STAGE(PG8_SB(0, 0), b2, voffB); PG8_STAGE(PG8_SB(0, 1), b2 + hstepB, voffB); PG8_STAGE(PG8_SA(0, 0), a2, voffA);
            PG8_WAIT_V(8); PG8_WAIT_L(0); PG8_BAR; PG8_MMA(1, 0, At, B0); PG8_MMA(1, 1, At, B1); PG8_BAR; PG8_SCHED;
            PG8_LDB(B0, 1, 0); PG8_LDB(B1, 1, 1); PG8_SCHED; PG8_LDA(At, 1, 0); PG8_STAGE(PG8_SA(0, 1), a2 + hstepA, voffA);
            PG8_WAIT_V(8); PG8_WAIT_L(0); PG8_BAR; PG8_MMA(0, 0, At, B0); PG8_MMA(0, 1, At, B1); PG8_BAR; PG8_SCHED;
            PG8_LDA(At, 1, 1); PG8_STAGE(PG8_SB(1, 0), b3, voffB); PG8_STAGE(PG8_SB(1, 1), b3 + hstepB, voffB); PG8_STAGE(PG8_SA(1, 0), a3, voffA);
            PG8_WAIT_V(8); PG8_WAIT_L(0); PG8_BAR; PG8_MMA(1, 0, At, B0); PG8_MMA(1, 1, At, B1); PG8_BAR; PG8_SCHED;
            } else {
            PG8_LDB(B0, 0, 0); PG8_SCHED; PG8_LDA(At, 0, 0); PG8_STAGE(PG8_SA(1, 1), a1 + hstepA, voffA);
            PG8_WAIT_L(8); PG8_BAR; PG8_WAIT_L(0); PG8_MMA(0, 0, At, B0); PG8_BAR; PG8_SCHED;
            PG8_LDB(B1, 0, 1); PG8_STAGE(PG8_SB(0, 0), b2, voffB);
            PG8_BAR; PG8_WAIT_L(0); PG8_MMA(0, 1, At, B1); PG8_BAR;
            PG8_LDA(At, 0, 1); PG8_STAGE(PG8_SA(0, 0), a2, voffA);
            PG8_BAR; PG8_WAIT_L(0); PG8_MMA(1, 0, At, B0); PG8_BAR; PG8_SCHED;
            PG8_STAGE(PG8_SB(0, 1), b2 + hstepB, voffB);
            PG8_WAIT_V(6); PG8_BAR; PG8_MMA(1, 1, At, B1); PG8_BAR;
            PG8_LDB(B0, 1, 0); PG8_SCHED; PG8_LDA(At, 1, 0); PG8_STAGE(PG8_SA(0, 1), a2 + hstepA, voffA);
            PG8_WAIT_L(8); PG8_BAR; PG8_WAIT_L(0); PG8_MMA(0, 0, At, B0); PG8_BAR; PG8_SCHED;
            PG8_LDB(B1, 1, 1); PG8_STAGE(PG8_SB(1, 0), b3, voffB);
            PG8_BAR; PG8_WAIT_L(0); PG8_MMA(0, 1, At, B1); PG8_BAR;
            PG8_LDA(At, 1, 1); PG8_STAGE(PG8_SA(1, 0), a3, voffA);
            PG8_BAR; PG8_WAIT_L(0); PG8_MMA(1, 0, At, B0); PG8_BAR; PG8_SCHED;
            PG8_STAGE(PG8_SB(1, 1), b3 + hstepB, voffB);
            PG8_WAIT_V(6); PG8_BAR; PG8_MMA(1, 1, At, B1); PG8_BAR;
            }
        }
        if constexpr (ALIGN_EPI) { if (wr == 0) PG8_BAR; }
        if constexpr (!Epi::AFTER_DRAIN) { E(acc, cur, wr, wc, fr, fq); S.done(cur); }
        if (!has_next) break;
#pragma unroll
        for (int a = 0; a < 2; ++a)
#pragma unroll
            for (int b = 0; b < 2; ++b)
#pragma unroll
                for (int m = 0; m < 4; ++m)
#pragma unroll
                    for (int n = 0; n < 2; ++n) acc[a][b][m][n] = (f32x4){0.f, 0.f, 0.f, 0.f};
        cur = nxt; cA = nA; cB = nB; ++ui;
        if constexpr (ALIGN_EPI) { if (wr == 1) PG8_BAR; }
    }
    PG8_WAIT_V(0);
    if constexpr (!ALIGN_EPI) { if (wr == 0) PG8_BAR; }
    PG8_BAR;
    if constexpr (Epi::AFTER_DRAIN) { E.fused(acc, cur, wr, wc, fr, fq, lds, wid, lane); S.done(cur); }
#undef PG8_SA
#undef PG8_SB
#undef PG8_STAGE
#undef PG8_LDA
#undef PG8_LDB
#undef PG8_MMA
#undef PG8_WAIT_V
#undef PG8_WAIT_L
#undef PG8_BAR
#undef PG8_SCHED
}
}
constexpr int NB = 16, SEQ = 2048, D = 1024, DEPTH = 4, M = NB * SEQ, PIN = 2568, NP = 2560, FF = 4096, NMOD = 6144;
constexpr int NWAVES = 8, NTHR = 512;
constexpr float EPS = 1e-6f;
constexpr int PC_QA = 0, PC_KA = 256, PC_VA = 512, PC_GATE = 768, PC_UB = 1024, PC_VB = 1280, PC_XC = 1536, PC_QD = 1792, PC_KD = 2048, PC_VD = 2304;
constexpr int YC_A = 0, YC_B = 256, YC_C = 512, YC_D = 768;
enum { I_X = 0, I_C, I_WMOD, I_BMOD, I_GN1, I_GN2, I_WIN, I_CONV, I_ALOG, I_DTB, I_GOA, I_GLNB, I_WSG, I_BSG, I_WPOOL, I_SPOOL, I_GOD, I_WOUT, I_WFF1, I_WFF2, I_GFIN, N_IN };

constexpr size_t MiB = 1u << 20;
constexpr size_t WS_CTL = 0, CTL_ZERO_BYTES = 1 * MiB;
constexpr size_t WS_MOD = 1 * MiB;
constexpr size_t WS_SW1 = 3 * MiB;
constexpr size_t WS_SWAB = 3 * MiB + 768 * 1024;
constexpr size_t WS_SW2 = 4 * MiB;
constexpr size_t WS_WAB = 5 * MiB;
constexpr size_t WS_WSG = 5 * MiB + 256 * 1024;
constexpr size_t WS_WPT = 5 * MiB + 768 * 1024;
constexpr size_t WS_QSA = 7 * MiB + 256 * 1024;
constexpr size_t WS_QSA1 = 7 * MiB + 512 * 1024;
constexpr size_t WS_QSB1 = 7 * MiB + 768 * 1024;
constexpr size_t WS_QSB2 = 7 * MiB + 896 * 1024;
constexpr size_t WS_QCS2 = 7 * MiB + 928 * 1024;
constexpr size_t WS_QSBO = 7 * MiB + 960 * 1024;
constexpr size_t WS_ZERO = 512 * 1024;
constexpr size_t WS_QSB = 7 * MiB;
constexpr size_t WS_ABLOG = 6 * MiB;
constexpr size_t WS_SSQ1 = 8 * MiB, WS_SSQ2 = 10 * MiB;
constexpr size_t WS_BETA = 12 * MiB, WS_GLOG = 13 * MiB;
constexpr size_t WS_WIN = 16 * MiB;
constexpr size_t WS_WOUT = 36 * MiB;
constexpr size_t WS_WFF1 = 44 * MiB;
constexpr size_t WS_WFF2 = 76 * MiB;
constexpr size_t WS_XQ = 144 * MiB;
constexpr size_t WS_XG = 112 * MiB;
constexpr size_t WS_HID = 176 * MiB;
constexpr size_t WS_P = 176 * MiB;
constexpr size_t WS_Y = 336 * MiB;
constexpr size_t WS_CHA = 112 * MiB, WS_CHB = 400 * MiB;
constexpr size_t WS_XB = 448 * MiB;
constexpr size_t WS_END = 512 * MiB;
constexpr int CW_BAR = 4096;
constexpr int CW_XRANK = 24576;
constexpr int CW_DNCNT = 16384;

constexpr int RING_BYTES = 131072, LDS_BYTES = 163840, MISC_OFF = LDS_BYTES - 256;

#define LAS __attribute__((address_space(3)))
typedef unsigned short bf16;
typedef float f32x4 __attribute__((ext_vector_type(4)));
typedef unsigned u32x4 __attribute__((ext_vector_type(4)));
typedef unsigned u32x2 __attribute__((ext_vector_type(2)));
__device__ __forceinline__ float bf2f(unsigned v) { return __uint_as_float(v << 16); }
__device__ __forceinline__ unsigned f2bf(float f) { unsigned u = __float_as_uint(f); return (u + 0x7fffu + ((u >> 16) & 1u)) >> 16; }
__device__ __forceinline__ unsigned pk2(float lo, float hi) { return f2bf(lo) | (f2bf(hi) << 16); }
__device__ __forceinline__ float wave_sum(float v) {
#pragma unroll
    for (int o = 1; o < 64; o <<= 1) v += __shfl_xor(v, o);
    return v;
}
__device__ __forceinline__ float rdlane(float v, int l) { return __builtin_bit_cast(float, __builtin_amdgcn_readlane(__builtin_bit_cast(int, v), l)); }
__device__ __forceinline__ float silu_f(float x) { return x * __builtin_amdgcn_rcpf(1.0f + __expf(-x)); }
__device__ __forceinline__ float sigmoid_f(float x) { return __builtin_amdgcn_rcpf(1.0f + __expf(-x)); }
__device__ __forceinline__ float softplus_f(float x) { return fmaxf(x, 0.f) + __logf(1.0f + __expf(-fabsf(x))); }
#define GAS __attribute__((address_space(1)))
template <class T> __device__ __forceinline__ T* as_global(T* p) { return p; }
constexpr float YCLIP8 = 8.0f;
__device__ __forceinline__ unsigned q8x4(float a, float b, float c, float d) {
    constexpr float k = 127.0f / YCLIP8; unsigned w = 0u;
    w = __builtin_amdgcn_cvt_pk_u8_f32(__builtin_fmaf(a, k, 128.0f), 0, w); w = __builtin_amdgcn_cvt_pk_u8_f32(__builtin_fmaf(b, k, 128.0f), 1, w);
    w = __builtin_amdgcn_cvt_pk_u8_f32(__builtin_fmaf(c, k, 128.0f), 2, w); w = __builtin_amdgcn_cvt_pk_u8_f32(__builtin_fmaf(d, k, 128.0f), 3, w);
    return w ^ 0x80808080u; }
template <class T> __device__ __forceinline__ T* uni_ptr(T* p) { const unsigned long long v = (unsigned long long)p; const unsigned lo = __builtin_amdgcn_readfirstlane((unsigned)v), hi = __builtin_amdgcn_readfirstlane((unsigned)(v >> 32)); return as_global((T*)(((unsigned long long)hi << 32) | lo)); }
#define XB_TMO      128
#define XB_XCNT(j)  (256  + 64 * (j))
#define XB_XSUB(j)  (1280 + 64 * (j))
#define XB_XGEN(j)  (2304 + 64 * (j))
#define XB_TOP      3328
#define XB_TOPGEN   3392
#define XCD_BAR_WORDS 3456
#define XB_SPIN_CAP (1u << 18)

__device__ __forceinline__ unsigned xb_ld(unsigned* p)              { return __hip_atomic_load(p, __ATOMIC_RELAXED, __HIP_MEMORY_SCOPE_AGENT); }
__device__ __forceinline__ unsigned xb_add(unsigned* p, unsigned v) { return __hip_atomic_fetch_add(p, v, __ATOMIC_RELAXED, __HIP_MEMORY_SCOPE_AGENT); }
__device__ __forceinline__ unsigned xb_xcc_id() { return (unsigned)__builtin_amdgcn_s_getreg((3 << 11) | 20) & 0xFu; }
#define XB_SPIN(cond, bar) do { unsigned _sp = 0; while (cond) { __builtin_amdgcn_s_sleep(1); \
    if ((++_sp & 255u) == 0u) { if (xb_ld(&(bar)[XB_TMO])) break; if (_sp > XB_SPIN_CAP) { atomicAdd(&(bar)[XB_TMO], 1u); break; } } } } while (0)

struct XcdBarrier {
    unsigned* bar; unsigned x;
    volatile LAS unsigned* st;
};

__device__ __forceinline__ XcdBarrier xcd_barrier_post(unsigned* bar, volatile LAS unsigned* st) {
    XcdBarrier b; b.bar = bar; b.x = xb_xcc_id(); b.st = st;
    if (threadIdx.x == 0) (void)xb_add(&bar[XB_XCNT(b.x)], 1u);
    return b;
}
__device__ __forceinline__ void xcd_barrier_complete(unsigned* bar, unsigned x, unsigned& nloc, unsigned& nx) {
    const unsigned G = gridDim.x * gridDim.y * gridDim.z;
    unsigned sum, cnt, mine, sp = 0u;
    for (;;) {
        sum = 0u; cnt = 0u; mine = 0u;
#pragma unroll
        for (unsigned j = 0; j < 16; ++j) { const unsigned c = xb_ld(&bar[XB_XCNT(j)]); sum += c; cnt += (c > 0u) ? 1u : 0u; mine = (j == x) ? c : mine; }
        if (sum == G) break;
        __builtin_amdgcn_s_sleep(1);
        if ((++sp & 255u) == 0u) { if (xb_ld(&bar[XB_TMO])) break; if (sp > XB_SPIN_CAP) { atomicAdd(&bar[XB_TMO], 1u); break; } }
    }
    nloc = mine > 0u ? mine : 1u; nx = cnt > 0u ? cnt : 1u;
}

__device__ __forceinline__ void xcd_barrier(const XcdBarrier& b) {
    asm volatile("s_waitcnt vmcnt(0)" ::: "memory");
    __syncthreads();
    if (threadIdx.x == 0) {
        unsigned* bar = b.bar;
        __builtin_amdgcn_s_waitcnt(0);
        unsigned nloc = b.st[0], nx = b.st[1];
        if (nloc == 0u) { xcd_barrier_complete(bar, b.x, nloc, nx); b.st[0] = nloc; b.st[1] = nx; }
        const unsigned old = xb_add(&bar[XB_XSUB(b.x)], 1u);
        const unsigned gen = old / nloc;
        if (old + 1u == (gen + 1u) * nloc) {
            __builtin_amdgcn_fence(__ATOMIC_RELEASE, "agent");
            asm volatile("s_waitcnt vmcnt(0)" ::: "memory");
            const unsigned og = xb_add(&bar[XB_TOP], 1u);
            const unsigned tg = og / nx;
            if (og + 1u == (tg + 1u) * nx) xb_add(&bar[XB_TOPGEN], 1u);
            else XB_SPIN(xb_ld(&bar[XB_TOPGEN]) == tg, bar);
            __builtin_amdgcn_fence(__ATOMIC_ACQUIRE, "agent");
            xb_add(&bar[XB_XGEN(b.x)], 1u);
            asm volatile("s_waitcnt vmcnt(0)" ::: "memory");
        } else {
            XB_SPIN(xb_ld(&bar[XB_XGEN(b.x)]) == gen, bar);
            __builtin_amdgcn_fence(__ATOMIC_ACQUIRE, "agent");
            asm volatile("s_waitcnt vmcnt(0)" ::: "memory");
        }
    }
    __syncthreads();
}
struct Frame {
    LAS unsigned char* lds;
    int tid, lane, wave, G, bid;
    unsigned char* ws;
    const float* const* in;
    float* out;
};
#define WSP(T, off) (as_global((T*)(F.ws + (off))))
#define GIN(i) (as_global(F.in[i]))

template <class Writer>
__device__ __forceinline__ void gemm16_unit(Frame& F, const float* W, int ldw, int N, int n0, LAS float* lhsT, LAS float* red, const Writer& wr) {
    const int n = n0 + F.lane; const bool ok = n < N;
    float acc[16];
#pragma unroll
    for (int b = 0; b < 16; ++b) acc[b] = 0.f;
    const int kbeg = F.wave * 128;
    const float* wp = W + (size_t)kbeg * ldw + (ok ? n : 0);
    for (int k0 = 0; k0 < 128; k0 += 32) {
        float wv[32];
#pragma unroll
        for (int j = 0; j < 32; ++j) wv[j] = ok ? wp[(size_t)(k0 + j) * ldw] : 0.f;
#pragma unroll
        for (int j = 0; j < 32; ++j) { const float w = wv[j];
            const LAS f32x4* lp = (const LAS f32x4*)(lhsT + (kbeg + k0 + j) * 16);
            const f32x4 l0 = lp[0], l1 = lp[1], l2 = lp[2], l3 = lp[3];
            acc[0] += l0[0] * w; acc[1] += l0[1] * w; acc[2] += l0[2] * w; acc[3] += l0[3] * w;
            acc[4] += l1[0] * w; acc[5] += l1[1] * w; acc[6] += l1[2] * w; acc[7] += l1[3] * w;
            acc[8] += l2[0] * w; acc[9] += l2[1] * w; acc[10] += l2[2] * w; acc[11] += l2[3] * w;
            acc[12] += l3[0] * w; acc[13] += l3[1] * w; acc[14] += l3[2] * w; acc[15] += l3[3] * w;
            if ((j & 7) == 7) asm volatile("" ::: "memory"); }
    }
#pragma unroll
    for (int b = 0; b < 16; ++b) red[(F.wave * 16 + b) * 64 + F.lane] = acc[b];
    __syncthreads();
    for (int o_ = F.tid; o_ < 1024; o_ += NTHR) { int o = o_; asm volatile("" : "+v"(o)); const int b = o >> 6, nn = o & 63; float s = 0.f;
#pragma unroll
        for (int w = 0; w < 8; ++w) s += red[(w * 16 + b) * 64 + nn];
        if (n0 + nn < N) wr(b, n0 + nn, s); }
    __syncthreads();
}

__device__ __forceinline__ void transpose_item(const float* W, int ldw, int csrc, int k0, bf16* WT, int Kd, int rdst, LAS float* scr, int lane) {
    float tv[32];
#pragma unroll
    for (int i = 0; i < 32; ++i) tv[i] = W[(size_t)(k0 + 2 * i + (lane >> 5)) * ldw + csrc + (lane & 31)];
#pragma unroll
    for (int i = 0; i < 32; ++i) scr[(2 * i + (lane >> 5)) * 33 + (lane & 31)] = tv[i];
    asm volatile("s_waitcnt lgkmcnt(0)" ::: "memory");
    const int c = lane & 7;
#pragma unroll
    for (int j = 0; j < 4; ++j) { const int n = (lane >> 3) + 8 * j; const LAS float* s = scr + (8 * c) * 33 + n;
        u32x4 o; o.x = pk2(s[0 * 33], s[1 * 33]); o.y = pk2(s[2 * 33], s[3 * 33]); o.z = pk2(s[4 * 33], s[5 * 33]); o.w = pk2(s[6 * 33], s[7 * 33]);
        *(u32x4*)(WT + (size_t)(rdst + n) * Kd + k0 + 8 * c) = o; }
    asm volatile("s_waitcnt lgkmcnt(0)" ::: "memory");
}

__device__ __forceinline__ void p0a(Frame& F) {
    LAS float* lhsT = (LAS float*)F.lds; LAS float* red = (LAS float*)(F.lds + 65536);
    const float* c = GIN(I_C);
    float* mod = WSP(float, WS_MOD);
    bool filled = false;
    for (int u = F.bid; u < DEPTH * 96; u += F.G) {
        if (!filled) { for (int i = F.tid; i < 16384; i += NTHR) { const int b = i >> 10, k = i & 1023; lhsT[k * 16 + b] = silu_f(c[i]); } __syncthreads(); filled = true; }
        const int l = u / 96, n0 = (u % 96) * 64;
        const float* bm = GIN(I_BMOD) + (size_t)l * NMOD; float* mo = mod + (size_t)l * 16 * NMOD;
        gemm16_unit(F, GIN(I_WMOD) + (size_t)l * D * NMOD, NMOD, NMOD, n0, lhsT, red, [=](int b, int n, float s) { mo[(size_t)b * NMOD + n] = s + bm[n]; });
    }
    __syncthreads();
    LAS float* scr = (LAS float*)(F.lds + F.wave * 8448);
    const int gw = F.bid * NWAVES + F.wave, NGW = F.G * NWAVES;
    constexpr int IT_IN = 16 * 80, IT_OUT = 16 * 32, IT_F1 = 16 * 128, IT_F2 = 64 * 32, IT_L = IT_IN + IT_OUT + IT_F1 + IT_F2;
    for (int it = gw; it < DEPTH * IT_L; it += NGW) {
        const int l = it / IT_L; int r = it % IT_L;
        if (r < IT_IN) { const int kb = r / 80, nb = r % 80, n0 = nb * 32; transpose_item(GIN(I_WIN) + (size_t)l * D * PIN, PIN, n0 < 768 ? n0 : n0 + 8, kb * 64, WSP(bf16, WS_WIN) + (size_t)l * NP * D, D, n0, scr, F.lane); continue; }
        r -= IT_IN;
        if (r < IT_OUT) { const int kb = r / 32, nb = r % 32; transpose_item(GIN(I_WOUT) + (size_t)l * D * D, D, nb * 32, kb * 64, WSP(bf16, WS_WOUT) + (size_t)l * D * D, D, nb * 32, scr, F.lane); continue; }
        r -= IT_OUT;
        if (r < IT_F1) { const int kb = r / 128, nb = r % 128; transpose_item(GIN(I_WFF1) + (size_t)l * D * FF, FF, nb * 32, kb * 64, WSP(bf16, WS_WFF1) + (size_t)l * FF * D, D, nb * 32, scr, F.lane); continue; }
        r -= IT_F1;
        { const int kb = r / 32, nb = r % 32; transpose_item(GIN(I_WFF2) + (size_t)l * FF * D, D, nb * 32, kb * 64, WSP(bf16, WS_WFF2) + (size_t)l * D * FF, FF, nb * 32, scr, F.lane); }
    }
    { bf16* wsgb = WSP(bf16, WS_WSG); const float* wsg = GIN(I_WSG);
      for (int i = F.bid * NTHR + F.tid; i < DEPTH * 4 * 128 * 128; i += F.G * NTHR) wsgb[i] = (bf16)f2bf(wsg[i]);
      bf16* wpt = WSP(bf16, WS_WPT); const float* wp = GIN(I_WPOOL);
      for (int i = F.bid * NTHR + F.tid; i < DEPTH * 4 * 64 * 64; i += F.G * NTHR) { const int lg = i >> 12, d = (i >> 6) & 63, c = i & 63; wpt[i] = (bf16)f2bf(wp[(lg * 64 + c) * 64 + d]); } }
    bf16* wab = WSP(bf16, WS_WAB);
    for (int i = F.bid * NTHR + F.tid; i < DEPTH * 16 * D; i += F.G * NTHR) { const int l = i / (16 * D), j = (i / D) & 15, k = i % D;
        wab[i] = j < 8 ? (bf16)f2bf(GIN(I_WIN)[((size_t)l * D + k) * PIN + 768 + j]) : (bf16)0; }
}

__device__ __forceinline__ void p0b(Frame& F) {
    LAS float* lhsT = (LAS float*)F.lds; LAS float* red = (LAS float*)(F.lds + 65536);
    const float* mod = WSP(float, WS_MOD);
    for (int u = F.bid; u < DEPTH * 105; u += F.G) {
        const int l = u / 105, r = u % 105; const bool first = r < 41;
        const float* ml = mod + (size_t)l * 16 * NMOD + (first ? 0 : 3 * D);
        for (int i = F.tid; i < 16384; i += NTHR) { const int b = i >> 10, k = i & 1023; lhsT[k * 16 + b] = ml[(size_t)b * NMOD + k]; }
        __syncthreads();
        if (first) { float* sw1 = WSP(float, WS_SW1) + (size_t)l * 16 * NP; float* swab = WSP(float, WS_SWAB) + (size_t)l * 16 * 8;
            gemm16_unit(F, GIN(I_WIN) + (size_t)l * D * PIN, PIN, PIN, r * 64, lhsT, red, [=](int b, int n, float s) {
                if (n < 768) sw1[b * NP + n] = s; else if (n < 776) swab[b * 8 + (n - 768)] = s; else sw1[b * NP + n - 8] = s; }); }
        else { float* sw2 = WSP(float, WS_SW2) + (size_t)l * 16 * FF;
            gemm16_unit(F, GIN(I_WFF1) + (size_t)l * D * FF, FF, FF, (r - 41) * 64, lhsT, red, [=](int b, int n, float s) { sw2[b * FF + n] = s; }); }
    }
    { const int gw_ = F.bid * NWAVES + F.wave, NGW_ = F.G * NWAVES;
      constexpr int NR1 = DEPTH * FF, NR2 = DEPTH * NP, NR3 = DEPTH * 16, NR4 = DEPTH * D;
      for (int it = gw_; it < NR1 + NR2 + NR3 + NR4; it += NGW_) {
          bf16* wq; float* sc; int n;
          if (it >= NR1 + NR2 + NR3) { n = it - NR1 - NR2 - NR3; wq = WSP(bf16, WS_WOUT); sc = WSP(float, WS_QSBO); } else
          if (it < NR1) { n = it; wq = WSP(bf16, WS_WFF1); sc = WSP(float, WS_QSB); } else if (it < NR1 + NR2) { n = it - NR1; wq = WSP(bf16, WS_WIN); sc = WSP(float, WS_QSB1); } else { n = it - NR1 - NR2; wq = WSP(bf16, WS_WAB); sc = WSP(float, WS_QSB1) + 16384; }
          bf16* rowp = wq + (size_t)n * D + 16 * F.lane; u32x4 a = *(u32x4*)rowp, b = *(u32x4*)(rowp + 8);
          float v[16]; v[0] = bf2f(a.x & 0xffffu); v[1] = bf2f(a.x >> 16); v[2] = bf2f(a.y & 0xffffu); v[3] = bf2f(a.y >> 16); v[4] = bf2f(a.z & 0xffffu); v[5] = bf2f(a.z >> 16); v[6] = bf2f(a.w & 0xffffu); v[7] = bf2f(a.w >> 16);
          v[8] = bf2f(b.x & 0xffffu); v[9] = bf2f(b.x >> 16); v[10] = bf2f(b.y & 0xffffu); v[11] = bf2f(b.y >> 16); v[12] = bf2f(b.z & 0xffffu); v[13] = bf2f(b.z >> 16); v[14] = bf2f(b.w & 0xffffu); v[15] = bf2f(b.w >> 16);
          float mx = 0.f;
#pragma unroll
          for (int j = 0; j < 16; ++j) mx = fmaxf(mx, fabsf(v[j]));
#pragma unroll
          for (int o = 1; o < 64; o <<= 1) mx = fmaxf(mx, __shfl_xor(mx, o));
          const float sc_ = mx > 0.f ? mx * (1.0f / 127.0f) : 1.0f, is_ = 1.0f / sc_;
#pragma unroll
          for (int j = 0; j < 16; ++j) v[j] = __builtin_rintf(v[j] * is_);
          u32x4 oq;
          oq.x = ((unsigned)((int)v[0] & 255)) | ((unsigned)((int)v[1] & 255) << 8) | ((unsigned)((int)v[2] & 255) << 16) | ((unsigned)((int)v[3] & 255) << 24);
          oq.y = ((unsigned)((int)v[4] & 255)) | ((unsigned)((int)v[5] & 255) << 8) | ((unsigned)((int)v[6] & 255) << 16) | ((unsigned)((int)v[7] & 255) << 24);
          oq.z = ((unsigned)((int)v[8] & 255)) | ((unsigned)((int)v[9] & 255) << 8) | ((unsigned)((int)v[10] & 255) << 16) | ((unsigned)((int)v[11] & 255) << 24);
          oq.w = ((unsigned)((int)v[12] & 255)) | ((unsigned)((int)v[13] & 255) << 8) | ((unsigned)((int)v[14] & 255) << 16) | ((unsigned)((int)v[15] & 255) << 24);
          asm volatile("s_waitcnt vmcnt(0)" ::: "memory");
          *(u32x4*)((unsigned char*)(wq + (size_t)n * D) + 16 * F.lane) = oq; if (F.lane == 0) sc[n] = it >= NR1 + NR2 + NR3 ? sc_ * (YCLIP8 / 127.0f) : sc_; } }
    { const int gw_ = F.bid * NWAVES + F.wave, NGW_ = F.G * NWAVES; bf16* wq = WSP(bf16, WS_WFF2); float* sc2 = WSP(float, WS_QSB2); int* cs2 = WSP(int, WS_QCS2);
      for (int n = gw_; n < DEPTH * D; n += NGW_) { const u32x4* rp = (const u32x4*)(wq + (size_t)n * FF + 64 * F.lane); u32x4 in[8]; float mx = 0.f;
#pragma unroll
          for (int j = 0; j < 8; ++j) { in[j] = rp[j]; mx = fmaxf(mx, fmaxf(fmaxf(fmaxf(fabsf(bf2f(in[j].x & 0xffffu)), fabsf(bf2f(in[j].x >> 16))), fmaxf(fabsf(bf2f(in[j].y & 0xffffu)), fabsf(bf2f(in[j].y >> 16)))), fmaxf(fmaxf(fabsf(bf2f(in[j].z & 0xffffu)), fabsf(bf2f(in[j].z >> 16))), fmaxf(fabsf(bf2f(in[j].w & 0xffffu)), fabsf(bf2f(in[j].w >> 16)))))); }
#pragma unroll
          for (int o = 1; o < 64; o <<= 1) mx = fmaxf(mx, __shfl_xor(mx, o));
          const float sc_ = mx > 0.f ? mx * (1.0f / 127.0f) : 1.0f, is_ = 1.0f / sc_; int sum = 0; u32x4 oq[4];
#pragma unroll
          for (int j = 0; j < 8; ++j) { const int q0 = (int)__builtin_rintf(bf2f(in[j].x & 0xffffu) * is_), q1 = (int)__builtin_rintf(bf2f(in[j].x >> 16) * is_), q2 = (int)__builtin_rintf(bf2f(in[j].y & 0xffffu) * is_), q3 = (int)__builtin_rintf(bf2f(in[j].y >> 16) * is_);
              const int q4 = (int)__builtin_rintf(bf2f(in[j].z & 0xffffu) * is_), q5 = (int)__builtin_rintf(bf2f(in[j].z >> 16) * is_), q6 = (int)__builtin_rintf(bf2f(in[j].w & 0xffffu) * is_), q7 = (int)__builtin_rintf(bf2f(in[j].w >> 16) * is_);
              sum += ((q0 + q1) + (q2 + q3)) + ((q4 + q5) + (q6 + q7));
              const unsigned lo = (unsigned)(q0 & 255) | ((unsigned)(q1 & 255) << 8) | ((unsigned)(q2 & 255) << 16) | ((unsigned)(q3 & 255) << 24), hi = (unsigned)(q4 & 255) | ((unsigned)(q5 & 255) << 8) | ((unsigned)(q6 & 255) << 16) | ((unsigned)(q7 & 255) << 24);
              if (j & 1) { oq[j >> 1].z = lo; oq[j >> 1].w = hi; } else { oq[j >> 1].x = lo; oq[j >> 1].y = hi; } }
#pragma unroll
          for (int o = 1; o < 64; o <<= 1) sum += __shfl_xor(sum, o);
          asm volatile("s_waitcnt vmcnt(0)" ::: "memory");
          u32x4* op = (u32x4*)((unsigned char*)(wq + (size_t)n * FF) + 64 * F.lane);
#pragma unroll
          for (int j = 0; j < 4; ++j) op[j] = oq[j];
          if (F.lane == 0) { sc2[n] = sc_ * (pg8::HCLIP8 / 255.0f); cs2[n] = sum; } } }
    const int gw = F.bid * NWAVES + F.wave, NGW = F.G * NWAVES;
    const float* x = GIN(I_X); const float* gn = GIN(I_GN1); bf16* xg = WSP(bf16, WS_XG); float* ssq = WSP(float, WS_SSQ1);
    unsigned char* xq = WSP(unsigned char, WS_XG); float* qsa1 = WSP(float, WS_QSA1); bf16* xb0 = WSP(bf16, WS_XB);
    for (int r = gw; r < M; r += 2 * NGW) {
        const int r2 = r + NGW < M ? r + NGW : r;
        const f32x4* xa = (const f32x4*)(x + (size_t)r * D) + F.lane; const f32x4* xb = (const f32x4*)(x + (size_t)r2 * D) + F.lane; f32x4 va[4], vb[4];
#pragma unroll
        for (int j = 0; j < 4; ++j) { va[j] = xa[64 * j]; vb[j] = xb[64 * j]; }
        float sa = 0.f, sb = 0.f;
#pragma unroll
        for (int j = 0; j < 4; ++j) { sa += (va[j][0] * va[j][0] + va[j][1] * va[j][1]) + (va[j][2] * va[j][2] + va[j][3] * va[j][3]); sb += (vb[j][0] * vb[j][0] + vb[j][1] * vb[j][1]) + (vb[j][2] * vb[j][2] + vb[j][3] * vb[j][3]); }
        sa = wave_sum(sa); sb = wave_sum(sb);
        const float rra = __builtin_amdgcn_rsqf(sa * (1.0f / 1024.0f) + 1e-6f), rrb = __builtin_amdgcn_rsqf(sb * (1.0f / 1024.0f) + 1e-6f), isa = 127.0f * rra * (1.0f / pg8::QCLIP8), isb = 127.0f * rrb * (1.0f / pg8::QCLIP8);
        const float* sca = mod + (size_t)(r >> 11) * NMOD + D; const float* scb = mod + (size_t)(r2 >> 11) * NMOD + D;
#pragma unroll
        for (int j = 0; j < 4; ++j) { const int cc = 256 * j + 4 * F.lane; const f32x4 g = *(const f32x4*)(gn + cc), qa = *(const f32x4*)(sca + cc), qb = *(const f32x4*)(scb + cc);
            const f32x4 za = va[j] * (g * (qa + 1.0f)) * isa, zb = vb[j] * (g * (qb + 1.0f)) * isb; unsigned wa = 0u, wb = 0u;
#pragma unroll
            for (int i = 0; i < 4; ++i) { wa |= ((unsigned)((int)fminf(fmaxf(__builtin_rintf(za[i]), -127.f), 127.f) & 255)) << (8 * i); wb |= ((unsigned)((int)fminf(fmaxf(__builtin_rintf(zb[i]), -127.f), 127.f) & 255)) << (8 * i); }
            *(unsigned*)(xq + (size_t)r * D + cc) = wa; *(unsigned*)(xq + (size_t)r2 * D + cc) = wb;
            *(u32x2*)(xb0 + (size_t)r * D + cc) = (u32x2){pk2(va[j][0], va[j][1]), pk2(va[j][2], va[j][3])}; *(u32x2*)(xb0 + (size_t)r2 * D + cc) = (u32x2){pk2(vb[j][0], vb[j][1]), pk2(vb[j][2], vb[j][3])}; }
        if (F.lane < 16) { ssq[(size_t)r * 16 + F.lane] = F.lane == 0 ? sa : 0.f; ssq[(size_t)r2 * 16 + F.lane] = F.lane == 0 ? sb : 0.f; }
        if (F.lane == 0) { qsa1[r] = pg8::QCLIP8 / (127.0f * rra); qsa1[r2] = pg8::QCLIP8 / (127.0f * rrb); }
    }
}

__device__ __forceinline__ void ab_logits(Frame& F, int l) {
    typedef int i32x4_ __attribute__((ext_vector_type(4)));
    const int gw = F.bid * NWAVES + F.wave, NGW = F.G * NWAVES, n = F.lane & 15, kq = F.lane >> 4;
    const unsigned char* xq = WSP(unsigned char, WS_XG); const unsigned char* wab = (const unsigned char*)(WSP(bf16, WS_WAB) + (size_t)l * 16 * D); const float* ssq = WSP(float, WS_SSQ1);
    const float* swab = WSP(float, WS_SWAB) + (size_t)l * 16 * 8; float* ab = WSP(float, WS_ABLOG); const float* qsa1 = WSP(float, WS_QSA1); const float* qsbab = WSP(float, WS_QSB1) + 16384 + l * 16;
    for (int tile = gw; tile < M / 16; tile += NGW) { const int r0 = tile * 16;
        const unsigned char* ap = xq + (size_t)(r0 + n) * D + 16 * kq; const unsigned char* bp = wab + (size_t)n * (2 * D) + 16 * kq;
        i32x4_ acc0 = (i32x4_){0, 0, 0, 0}, acc1 = acc0;
        float rq[4];
#pragma unroll
        for (int i = 0; i < 4; ++i) { const int row = r0 + 4 * kq + i; rq[i] = pg8::row_rstd(ssq, row) * qsa1[row]; }
        i32x4_ af[16], bw[16];
#pragma unroll
        for (int ks = 0; ks < 16; ++ks) { af[ks] = *(const i32x4_*)(ap + 64 * ks); bw[ks] = *(const i32x4_*)(bp + 64 * ks); }
        asm volatile("" ::: "memory");
#pragma unroll
        for (int ks = 0; ks < 16; ks += 2) {
            acc0 = __builtin_amdgcn_mfma_i32_16x16x64_i8(af[ks], bw[ks], acc0, 0, 0, 0);
            acc1 = __builtin_amdgcn_mfma_i32_16x16x64_i8(af[ks + 1], bw[ks + 1], acc1, 0, 0, 0); }
        const i32x4_ acc = acc0 + acc1;
        if (n < 8) { const int b = r0 >> 11; const float sb_ = swab[b * 8 + n], wsc = qsbab[n];
#pragma unroll
            for (int i = 0; i < 4; ++i) { const int row = r0 + 4 * kq + i; ab[(size_t)row * 8 + n] = rq[i] * wsc * (float)acc[i] + sb_; } }
    }
}

__device__ __forceinline__ void sg_simple(Frame& F, int l, int unit) {
    const int b = unit >> 4, nblk = unit & 15; const size_t r0 = (size_t)b * SEQ + nblk * 128;
    const bf16* P = WSP(bf16, WS_P); bf16* Y = WSP(bf16, WS_Y); LAS float* vn = (LAS float*)F.lds;
    for (int pr = F.wave; pr < 512; pr += NWAVES) { const int tok = pr >> 2, h = pr & 3;
        const float v = bf2f(P[(r0 + tok) * NP + PC_VB + h * 64 + F.lane]);
        const float mu = wave_sum(v) * (1.0f / 64.0f), xc = v - mu, var = wave_sum(xc * xc) * (1.0f / 64.0f);
        vn[tok * 256 + h * 64 + F.lane] = xc * __builtin_amdgcn_rsqf(var + EPS) * GIN(I_GLNB)[l * 256 + h * 64 + F.lane]; }
    __syncthreads();
    const int c = F.tid & 255, h = __builtin_amdgcn_readfirstlane(c >> 6), half = __builtin_amdgcn_readfirstlane(F.tid >> 8);
    const float* wsg = GIN(I_WSG) + ((size_t)l * 4 + h) * 128 * 128; const float* bsg = GIN(I_BSG) + ((size_t)l * 4 + h) * 128;
    for (int t4 = 0; t4 < 16; ++t4) { const int t0 = half * 64 + t4 * 4; const int smax = half ? 128 : 64;
        float a0 = bsg[t0], a1 = bsg[t0 + 1], a2 = bsg[t0 + 2], a3 = bsg[t0 + 3];
        const float* w0 = wsg + (size_t)t0 * 128;
        for (int s = 0; s < smax; ++s) { const float v = vn[s * 256 + c]; a0 += w0[s] * v; a1 += w0[128 + s] * v; a2 += w0[256 + s] * v; a3 += w0[384 + s] * v; }
        const float av[4] = {a0, a1, a2, a3};
#pragma unroll
        for (int i = 0; i < 4; ++i) { const size_t r = r0 + t0 + i; Y[r * D + YC_B + c] = (bf16)f2bf(bf2f(P[r * NP + PC_UB + c]) * av[i]); } }
    __syncthreads();
}
__device__ __forceinline__ void pool_simple(Frame& F, int l, int unit) {
    const int b = unit >> 5, t0 = (unit & 31) * 64; const size_t r0 = (size_t)b * SEQ + t0;
    const bf16* P = WSP(bf16, WS_P); bf16* Y = WSP(bf16, WS_Y); LAS float* pl = (LAS float*)F.lds;
    const int c = F.tid & 255, g = __builtin_amdgcn_readfirstlane(c >> 6), half = __builtin_amdgcn_readfirstlane(F.tid >> 8);
    const int W = 2 << g;
    for (int tl = half * 32; tl < half * 32 + 32; ++tl) { const int t = t0 + tl; const int lo = (t + 1 - W) > 0 ? (t + 1 - W) : 0; float s = 0.f;
        for (int q = lo; q <= t; ++q) s += bf2f(P[((size_t)b * SEQ + q) * NP + PC_XC + c]);
        pl[tl * 256 + c] = s / (float)(t + 1 - lo) - bf2f(P[(r0 + tl) * NP + PC_XC + c]); }
    __syncthreads();
    const int d = c & 63; const float* wp = GIN(I_WPOOL) + ((size_t)l * 4 + g) * 64 * 64; const float sp = GIN(I_SPOOL)[l * 256 + c];
    float acc[32];
#pragma unroll
    for (int i = 0; i < 32; ++i) acc[i] = 0.f;
    for (int cc = 0; cc < 64; ++cc) { const float w = wp[cc * 64 + d];
#pragma unroll
        for (int i = 0; i < 32; ++i) acc[i] += pl[(half * 32 + i) * 256 + g * 64 + cc] * w; }
#pragma unroll
    for (int i = 0; i < 32; ++i) Y[(r0 + half * 32 + i) * D + YC_C + c] = (bf16)f2bf(acc[i] * sp);
    __syncthreads();
}
typedef short bf16x8 __attribute__((ext_vector_type(8)));
typedef short s16x4 __attribute__((ext_vector_type(4)));
typedef float f32x16 __attribute__((ext_vector_type(16)));
typedef float f32x2_t __attribute__((ext_vector_type(2))); typedef __bf16 bf16x2_t __attribute__((ext_vector_type(2)));
__device__ __forceinline__ unsigned cvtpk(float lo, float hi) { f32x2_t v = {lo, hi}; bf16x2_t b = __builtin_convertvector(v, bf16x2_t); return __builtin_bit_cast(unsigned, b); }
#define MFMA32(a, b, c) __builtin_amdgcn_mfma_f32_32x32x16_bf16((a), (b), (c), 0, 0, 0)
__device__ __forceinline__ void sb_tile(Frame& F, int l, int b, int h, int qt, LAS unsigned char* wl) {
    int lane_ = F.lane; asm volatile("" : "+v"(lane_));
    const int lane = lane_, r = lane & 31, hf = lane >> 5;
    const bf16* P = WSP(bf16, WS_P); unsigned char* Y = WSP(unsigned char, WS_Y);
    const size_t rowq = (size_t)b * SEQ + qt * 32 + r;
    bf16x8 qf[4];
#pragma unroll
    for (int s = 0; s < 4; ++s) qf[s] = *(const bf16x8*)(P + rowq * NP + PC_QD + h * 64 + 16 * s + 8 * hf);
    f32x16 o0, o1;
#pragma unroll
    for (int i = 0; i < 16; ++i) { o0[i] = 0.f; o1[i] = 0.f; }
    float carry = 0.f;
#define SB_LOADK(KF, KT) do { const size_t rowk_ = (size_t)b * SEQ + (KT) * 32; \
        _Pragma("unroll") for (int s_ = 0; s_ < 4; ++s_) KF[s_] = *(const bf16x8*)(P + (rowk_ + r) * NP + PC_KD + h * 64 + 16 * s_ + 8 * hf); } while (0)
#define SB_LOADV(VR, KT) do { const size_t rowk_ = (size_t)b * SEQ + (KT) * 32; \
        _Pragma("unroll") for (int i_ = 0; i_ < 4; ++i_) VR[i_] = *(const u32x4*)(P + (rowk_ + 8 * i_ + (lane >> 3)) * NP + PC_VD + h * 64 + (lane & 7) * 8); } while (0)
#define SB_PUTV(VR, BUF) do { _Pragma("unroll") for (int i_ = 0; i_ < 4; ++i_) *(LAS u32x4*)(wl + (BUF) * 5120 + (8 * i_ + (lane >> 3)) * 160 + (lane & 7) * 16) = VR[i_]; } while (0)
#define SB_GETV(VF, BUF) do { const unsigned a_ = (unsigned)(size_t)(wl + (BUF) * 5120) + (unsigned)((4 * hf + ((lane & 15) >> 2)) * 160 + (16 * ((lane >> 4) & 1) + 4 * (lane & 3)) * 2); \
        s16x4 t0_, t1_, t2_, t3_, t4_, t5_, t6_, t7_; \
        asm volatile("ds_read_b64_tr_b16 %0, %8\n\tds_read_b64_tr_b16 %1, %8 offset:1280\n\tds_read_b64_tr_b16 %2, %8 offset:2560\n\tds_read_b64_tr_b16 %3, %8 offset:3840\n\t" \
                     "ds_read_b64_tr_b16 %4, %8 offset:64\n\tds_read_b64_tr_b16 %5, %8 offset:1344\n\tds_read_b64_tr_b16 %6, %8 offset:2624\n\tds_read_b64_tr_b16 %7, %8 offset:3904\n\ts_waitcnt lgkmcnt(0)" \
                     : "=&v"(t0_), "=&v"(t1_), "=&v"(t2_), "=&v"(t3_), "=&v"(t4_), "=&v"(t5_), "=&v"(t6_), "=&v"(t7_) : "v"(a_) : "memory"); \
        VF[0][0] = (bf16x8){t0_[0], t0_[1], t0_[2], t0_[3], t1_[0], t1_[1], t1_[2], t1_[3]}; VF[0][1] = (bf16x8){t2_[0], t2_[1], t2_[2], t2_[3], t3_[0], t3_[1], t3_[2], t3_[3]}; \
        VF[1][0] = (bf16x8){t4_[0], t4_[1], t4_[2], t4_[3], t5_[0], t5_[1], t5_[2], t5_[3]}; VF[1][1] = (bf16x8){t6_[0], t6_[1], t6_[2], t6_[3], t7_[0], t7_[1], t7_[2], t7_[3]}; } while (0)
    bf16x8 kf[4]; int cur = 0;
    { u32x4 vr[4]; SB_LOADK(kf, qt); SB_LOADV(vr, qt); SB_PUTV(vr, 0); }
    for (int kt = qt; kt >= 0; --kt) {
        bf16x8 kfn[4], vf[2][2]; u32x4 vrn[4];
        SB_GETV(vf, cur);
        { const int ktn = kt > 0 ? kt - 1 : 0; SB_LOADK(kfn, ktn); SB_LOADV(vrn, ktn); }
        f32x16 sa;
#pragma unroll
        for (int i = 0; i < 16; ++i) sa[i] = 0.f;
#pragma unroll
        for (int s = 0; s < 4; ++s) sa = MFMA32(kf[s], qf[s], sa);
        const bool diag = (kt == qt);
        float lf[16], ls[16];
#pragma unroll
        for (int i = 0; i < 16; ++i) { const int kk = (i & 3) + 8 * (i >> 2) + 4 * hf; const float z = sa[i] * 0.125f; const float sp = softplus_f(z);
            const bool past = !diag || (kk < r); lf[i] = past ? -sp : 0.f; ls[i] = past ? (z - sp) : -1e30f; }
        float Gs[4], Gp[4];
#pragma unroll
        for (int j = 0; j < 4; ++j) { Gs[j] = (lf[4 * j] + lf[4 * j + 1]) + (lf[4 * j + 2] + lf[4 * j + 3]); Gp[j] = __shfl_xor(Gs[j], 32); }
        float a[16]; float above = 0.f;
#pragma unroll
        for (int j = 3; j >= 0; --j) {
            const float T = carry + above + (hf == 0 ? Gp[j] : 0.f);
            const float e2 = lf[4 * j + 3], e1 = e2 + lf[4 * j + 2], e0 = e1 + lf[4 * j + 1];
            a[4 * j + 3] = __expf(ls[4 * j + 3] + T); a[4 * j + 2] = __expf(ls[4 * j + 2] + T + e2); a[4 * j + 1] = __expf(ls[4 * j + 1] + T + e1); a[4 * j] = __expf(ls[4 * j] + T + e0);
            above += Gs[j] + Gp[j];
        }
        carry += above;
#pragma unroll
        for (int s2 = 0; s2 < 2; ++s2) { u32x4 pw; pw.x = cvtpk(a[8 * s2], a[8 * s2 + 1]); pw.y = cvtpk(a[8 * s2 + 2], a[8 * s2 + 3]); pw.z = cvtpk(a[8 * s2 + 4], a[8 * s2 + 5]); pw.w = cvtpk(a[8 * s2 + 6], a[8 * s2 + 7]);
            const bf16x8 pf = __builtin_bit_cast(bf16x8, pw);
            o0 = MFMA32(vf[0][s2], pf, o0); o1 = MFMA32(vf[1][s2], pf, o1); }
        if (__all(carry < -24.0f)) break;
#pragma unroll
        for (int s_ = 0; s_ < 4; ++s_) kf[s_] = kfn[s_];
        cur ^= 1; SB_PUTV(vrn, cur);
    }
#undef SB_LOADK
#undef SB_LOADV
#undef SB_PUTV
#undef SB_GETV
    float ss = 0.f;
#pragma unroll
    for (int i = 0; i < 16; ++i) ss += o0[i] * o0[i] + o1[i] * o1[i];
    ss += __shfl_xor(ss, 32);
    const float rs = __builtin_amdgcn_rsqf(ss * (1.0f / 64.0f) + EPS);
    const float* go = GIN(I_GOD) + l * 256 + h * 64;
#pragma unroll
    for (int dt = 0; dt < 2; ++dt)
#pragma unroll
        for (int g4 = 0; g4 < 4; ++g4) { const int d0 = 32 * dt + 8 * g4 + 4 * hf; const f32x4 gg = *(const f32x4*)(go + d0);
            float v0, v1, v2, v3;
            if (dt == 0) { v0 = o0[4 * g4]; v1 = o0[4 * g4 + 1]; v2 = o0[4 * g4 + 2]; v3 = o0[4 * g4 + 3]; } else { v0 = o1[4 * g4]; v1 = o1[4 * g4 + 1]; v2 = o1[4 * g4 + 2]; v3 = o1[4 * g4 + 3]; }
            *(unsigned*)(Y + rowq * D + YC_D + h * 64 + d0) = q8x4(v0 * rs * gg[0], v1 * rs * gg[1], v2 * rs * gg[2], v3 * rs * gg[3]); }
}
constexpr int CH_UT = 0;
constexpr int CH_WN = 8192;
constexpr int CH_KDT = 16384;
constexpr int CH_QD = 24576;
constexpr int CH_QKF = 32768;
constexpr int CH_EGL = CH_QKF + 2048;
constexpr int CH_STRIDE = 40960;
__device__ __forceinline__ size_t ch_off(int unit) { return unit < 1024 ? WS_CHA + (size_t)unit * CH_STRIDE : WS_CHB + (size_t)(unit - 1024) * CH_STRIDE; }
constexpr int DN_WLDS = 18432;
__device__ __forceinline__ int crow(int reg, int hf) { return (reg & 3) + 8 * (reg >> 2) + 4 * hf; }
__device__ __forceinline__ bf16x8 pack8(float a0, float a1, float a2, float a3, float a4, float a5, float a6, float a7) {
    u32x4 p; p.x = cvtpk(a0, a1); p.y = cvtpk(a2, a3); p.z = cvtpk(a4, a5); p.w = cvtpk(a6, a7); return __builtin_bit_cast(bf16x8, p); }
__device__ __forceinline__ bf16x8 pack_regs(const f32x16& x, int s) { return pack8(x[8 * s], x[8 * s + 1], x[8 * s + 2], x[8 * s + 3], x[8 * s + 4], x[8 * s + 5], x[8 * s + 6], x[8 * s + 7]); }
#define WAVE_LDS_SYNC() asm volatile("s_waitcnt lgkmcnt(0)" ::: "memory")

__device__ __forceinline__ void dn_prep(Frame& F, int l, int unit, LAS unsigned char* wl) {
    int lane = F.lane, r, hf;
#define RELANE() do { asm volatile("" : "+v"(lane)); r = lane & 31; hf = lane >> 5; } while (0)
    RELANE();
    const int bh = unit >> 5, c = unit & 31, b = bh >> 2, h = bh & 3, t0 = c * 64;
    const size_t r0 = (size_t)b * SEQ + t0;
    const bf16* P = WSP(bf16, WS_P); const float* cw = GIN(I_CONV) + (size_t)l * 4 * 768; const float* ab = WSP(float, WS_ABLOG);
    unsigned char* cb = F.ws + ch_off(unit);
    LAS float* Lm = (LAS float*)wl; LAS float* Gt = (LAS float*)(wl + 16896); LAS float* Bt = Gt + 64; LAS float* Rk = Bt + 64; LAS float* Rq = Rk + 64;
    float G63;
    { const float a = ab[(r0 + lane) * 8 + h], bb = ab[(r0 + lane) * 8 + 4 + h];
      float g = -__expf(GIN(I_ALOG)[l * 4 + h]) * softplus_f(a + GIN(I_DTB)[l * 4 + h]);
#pragma unroll
      for (int o = 1; o < 64; o <<= 1) { const float v = __shfl_up(g, o); if (lane >= o) g += v; }
      Gt[lane] = g; Bt[lane] = sigmoid_f(bb); G63 = rdlane(g, 63); }
#define DN_STAGE(colbase, halfoff) do { const bf16* base_ = P + r0 * NP + (colbase) + (lane & 7) * 8; u32x4 w_[8], hw_ = (u32x4){0u, 0u, 0u, 0u}; \
        _Pragma("unroll") for (int k_ = 0; k_ < 8; ++k_) w_[k_] = *(const u32x4*)(base_ + (size_t)(8 * k_ + (lane >> 3)) * NP); \
        if (t0 > 0) { if (lane < 24) hw_ = *(const u32x4*)(base_ + ((long)(lane >> 3) - 3) * NP); } \
        _Pragma("unroll") for (int k_ = 0; k_ < 8; ++k_) { LAS unsigned char* d_ = wl + (8 * k_ + (lane >> 3)) * 264 + (halfoff) + (lane & 7) * 16; *(LAS u32x2*)d_ = (u32x2){w_[k_].x, w_[k_].y}; *(LAS u32x2*)(d_ + 8) = (u32x2){w_[k_].z, w_[k_].w}; } \
        if (lane < 24) *(LAS u32x4*)(wl + 17920 + (lane >> 3) * 128 + (lane & 7) * 16) = hw_; \
        WAVE_LDS_SYNC(); asm volatile("" ::: "memory"); } while (0)
#define DN_RAWCOL(raw, halfoff) do { _Pragma("unroll") for (int i_ = 0; i_ < 3; ++i_) raw[i_] = *(const LAS bf16*)(wl + 17920 + i_ * 128 + lane * 2); \
        _Pragma("unroll") for (int i_ = 0; i_ < 64; ++i_) raw[3 + i_] = *(const LAS bf16*)(wl + i_ * 264 + (halfoff) + lane * 2); } while (0)
    unsigned vpk[32];
    {   const int chv = 512 + h * 64 + lane; const float w0 = cw[chv], w1 = cw[768 + chv], w2 = cw[1536 + chv], w3 = cw[2304 + chv];
        DN_STAGE(512 + h * 64, 0);
        unsigned raw[67]; DN_RAWCOL(raw, 0);
#pragma unroll
        for (int i = 0; i < 64; i += 2) vpk[i >> 1] = cvtpk(silu_f(w0 * bf2f(raw[i]) + w1 * bf2f(raw[i + 1]) + w2 * bf2f(raw[i + 2]) + w3 * bf2f(raw[i + 3])), silu_f(w0 * bf2f(raw[i + 1]) + w1 * bf2f(raw[i + 2]) + w2 * bf2f(raw[i + 3]) + w3 * bf2f(raw[i + 4])));
        WAVE_LDS_SYNC(); asm volatile("" ::: "memory"); }
    {   LAS bf16* T = (LAS bf16*)wl;
#pragma unroll
        for (int which = 0; which < 2; ++which) { const int chn = which * 256 + h * 64 + lane;
            const float w0 = cw[chn], w1 = cw[768 + chn], w2 = cw[1536 + chn], w3 = cw[2304 + chn];
            DN_STAGE(which * 256 + h * 64, which * 128);
            unsigned raw[67]; DN_RAWCOL(raw, which * 128); unsigned kq_[4] = {0u, 0u, 0u, 0u};
            WAVE_LDS_SYNC(); asm volatile("" ::: "memory");
#pragma unroll
            for (int i = 0; i < 64; i += 2) { const unsigned pk_ = cvtpk(silu_f(w0 * bf2f(raw[i]) + w1 * bf2f(raw[i + 1]) + w2 * bf2f(raw[i + 2]) + w3 * bf2f(raw[i + 3])), silu_f(w0 * bf2f(raw[i + 1]) + w1 * bf2f(raw[i + 2]) + w2 * bf2f(raw[i + 3]) + w3 * bf2f(raw[i + 4])));
                T[i * 132 + which * 64 + lane] = (bf16)(pk_ & 0xffffu); T[(i + 1) * 132 + which * 64 + lane] = (bf16)(pk_ >> 16); if (which == 1) { kq_[(i >> 1) & 3] = pk_; if ((i & 6) == 6) *(u32x4*)(cb + CH_WN + lane * 128 + (i >> 3) * 16) = (u32x4){kq_[0], kq_[1], kq_[2], kq_[3]}; } }
            asm volatile("" ::: "memory"); }
    }
    WAVE_LDS_SYNC();
    RELANE();
    bf16x8 qf[2][4], kf[2][4]; float sq[2] = {0.f, 0.f}, sk[2] = {0.f, 0.f};
#pragma unroll
    for (int which = 0; which < 2; ++which)
#pragma unroll
        for (int it = 0; it < 2; ++it)
#pragma unroll
            for (int s = 0; s < 4; ++s) { const LAS unsigned char* tp = wl + (32 * it + r) * 264 + (which * 64 + 16 * s + 4 * hf) * 2;
                const u32x2 lo = *(const LAS u32x2*)tp, hi = *(const LAS u32x2*)(tp + 16); const u32x4 fv = (u32x4){lo.x, lo.y, hi.x, hi.y};
                const float e0 = bf2f(fv.x & 0xffffu), e1 = bf2f(fv.x >> 16), e2 = bf2f(fv.y & 0xffffu), e3 = bf2f(fv.y >> 16), e4 = bf2f(fv.z & 0xffffu), e5 = bf2f(fv.z >> 16), e6 = bf2f(fv.w & 0xffffu), e7 = bf2f(fv.w >> 16);
                const float ss = ((e0 * e0 + e1 * e1) + (e2 * e2 + e3 * e3)) + ((e4 * e4 + e5 * e5) + (e6 * e6 + e7 * e7));
                if (which == 0) { qf[it][s] = __builtin_bit_cast(bf16x8, fv); sq[it] += ss; } else { kf[it][s] = __builtin_bit_cast(bf16x8, fv); sk[it] += ss; } }
#pragma unroll
    for (int it = 0; it < 2; ++it) { sq[it] += __shfl_xor(sq[it], 32); sk[it] += __shfl_xor(sk[it], 32);
        if (hf == 0) { Rq[32 * it + r] = __builtin_amdgcn_rsqf(sq[it] + EPS); Rk[32 * it + r] = __builtin_amdgcn_rsqf(sk[it] + EPS); } }
    WAVE_LDS_SYNC();
#ifndef NO_S3
    RELANE();
#pragma unroll
    for (int tl = 0; tl < 3; ++tl) { const int jt = tl == 2 ? 1 : 0, it = tl == 0 ? 0 : 1;
        RELANE();
        f32x16 acc;
#pragma unroll
        for (int i = 0; i < 16; ++i) acc[i] = 0.f;
#pragma unroll
        for (int s = 0; s < 4; ++s) acc = MFMA32(kf[jt][s], kf[it][s], acc);
        const int i = 32 * it + r; const float ci = Bt[i] * Rk[i], gi = Gt[i];
#pragma unroll
        for (int j16 = 0; j16 < 16; ++j16) { const int j = 32 * jt + crow(j16, hf);
            Lm[j * 64 + i] = (i > j) ? acc[j16] * ci * Rk[j] * __expf(gi - Gt[j]) : 0.f; } }
#endif
#ifndef NO_S4
    RELANE();
#pragma unroll
    for (int tl = 0; tl < 3; ++tl) { const int tt = tl == 0 ? 0 : 1, jt = tl == 2 ? 1 : 0;
        RELANE();
        f32x16 acc;
#pragma unroll
        for (int i = 0; i < 16; ++i) acc[i] = 0.f;
#pragma unroll
        for (int s = 0; s < 4; ++s) acc = MFMA32(kf[jt][s], qf[tt][s], acc);
        const int i = 32 * tt + r; const float ci = Rq[i] * 0.125f, gi = Gt[i];
#pragma unroll
        for (int j16 = 0; j16 < 16; ++j16) { const int j = 32 * jt + crow(j16, hf); acc[j16] = (i >= j) ? acc[j16] * Rk[j] * ci * __expf(gi - Gt[j]) : 0.f; }
#pragma unroll
        for (int s2 = 0; s2 < 2; ++s2) *(bf16x8*)(cb + CH_QKF + (((tt * 2 + jt) * 2 + s2) * 64 + lane) * 16) = pack_regs(acc, s2); }
#pragma unroll
    for (int it = 0; it < 2; ++it) { const int i = 32 * it + r; const float sc = Rq[i] * 0.125f * __expf(Gt[i]);
#pragma unroll
        for (int s = 0; s < 4; ++s) { const u32x4 q = __builtin_bit_cast(u32x4, qf[it][s]);
            *(bf16x8*)(cb + CH_QD + ((it * 4 + s) * 64 + lane) * 16) = pack8(bf2f(q.x & 0xffffu) * sc, bf2f(q.x >> 16) * sc, bf2f(q.y & 0xffffu) * sc, bf2f(q.y >> 16) * sc, bf2f(q.z & 0xffffu) * sc, bf2f(q.z >> 16) * sc, bf2f(q.w & 0xffffu) * sc, bf2f(q.w >> 16) * sc); } }
    WAVE_LDS_SYNC();
#endif
#ifndef NO_S5
    RELANE();
#define DN_SOLVE(X2) do { _Pragma("unroll") for (int j = 0; j < 63; ++j) { const float xj_ = (j & 1) ? X2[j >> 1][1] : X2[j >> 1][0]; const f32x2_t nx_ = (f32x2_t){-xj_, -xj_}; \
        _Pragma("unroll") for (int i4 = (j + 1) / 4; i4 < 16; ++i4) { const f32x4 lv = *(const LAS f32x4*)(Lm + j * 64 + 4 * i4); \
            if (4 * i4 > j) X2[2 * i4] = __builtin_elementwise_fma((f32x2_t){lv[0], lv[1]}, nx_, X2[2 * i4]); \
            else if (4 * i4 + 1 > j) X2[2 * i4][1] = __builtin_fmaf(lv[1], -xj_, X2[2 * i4][1]); \
            if (4 * i4 + 2 > j) X2[2 * i4 + 1] = __builtin_elementwise_fma((f32x2_t){lv[2], lv[3]}, nx_, X2[2 * i4 + 1]); \
            else if (4 * i4 + 3 > j) X2[2 * i4 + 1][1] = __builtin_fmaf(lv[3], -xj_, X2[2 * i4 + 1][1]); } \
        asm volatile("" ::: "memory"); __builtin_amdgcn_sched_barrier(0); } } while (0)
    u32x4 kpk[8];
#pragma unroll
    for (int i8 = 0; i8 < 8; ++i8) kpk[i8] = *(const u32x4*)(cb + CH_WN + lane * 128 + i8 * 16);
    {
#pragma clang fp contract(off)
        f32x2_t X2[32];
        {
#pragma unroll
          for (int i = 0; i < 64; ++i) { X2[i >> 1][i & 1] = ((i & 1) ? bf2f(vpk[i >> 1] >> 16) : bf2f(vpk[i >> 1] & 0xffffu)) * Bt[i];
              if ((i & 7) == 7) { asm volatile("" ::: "memory"); __builtin_amdgcn_sched_barrier(0); } } }
        __builtin_amdgcn_sched_barrier(0);
        DN_SOLVE(X2);
#pragma unroll
        for (int i8 = 0; i8 < 8; ++i8) *(bf16x8*)(cb + CH_UT + (lane * 64 + 8 * i8) * 2) = pack8(X2[4 * i8][0], X2[4 * i8][1], X2[4 * i8 + 1][0], X2[4 * i8 + 1][1], X2[4 * i8 + 2][0], X2[4 * i8 + 2][1], X2[4 * i8 + 3][0], X2[4 * i8 + 3][1]);
    }
    RELANE();
    {
#pragma clang fp contract(off)
        f32x2_t X2[32];
        {
          float kd[8];
#pragma unroll
          for (int i = 0; i < 64; ++i) { const unsigned kw_ = kpk[i >> 3][(i >> 1) & 3]; const float kc = ((i & 1) ? bf2f(kw_ >> 16) : bf2f(kw_ & 0xffffu)) * Rk[i], gi = Gt[i];
              X2[i >> 1][i & 1] = kc * Bt[i] * __expf(gi); kd[i & 7] = kc * __expf(G63 - gi);
              if ((i & 7) == 7) { *(bf16x8*)(cb + CH_KDT + (lane * 64 + i - 7) * 2) = pack8(kd[0], kd[1], kd[2], kd[3], kd[4], kd[5], kd[6], kd[7]); asm volatile("" ::: "memory"); __builtin_amdgcn_sched_barrier(0); } } }
        __builtin_amdgcn_sched_barrier(0);
        DN_SOLVE(X2);
        WAVE_LDS_SYNC(); asm volatile("" ::: "memory");
#pragma unroll
        for (int i = 0; i < 64; ++i) *(LAS bf16*)(wl + i * 264 + lane * 2) = (bf16)f2bf(-X2[i >> 1][i & 1]);
        WAVE_LDS_SYNC(); asm volatile("" ::: "memory");
#pragma unroll
        for (int k = 0; k < 8; ++k) { const LAS unsigned char* sp = wl + (8 * k + (lane >> 3)) * 264 + (lane & 7) * 16; const u32x2 lo = *(const LAS u32x2*)sp, hi = *(const LAS u32x2*)(sp + 8);
            *(u32x4*)(cb + CH_WN + (8 * k + (lane >> 3)) * 128 + (lane & 7) * 16) = (u32x4){lo.x, lo.y, hi.x, hi.y}; }
    }
#undef DN_SOLVE
#undef DN_STAGE
#undef DN_RAWCOL
#endif
#undef RELANE
    if (lane == 0) *(float*)(cb + CH_EGL) = __expf(G63);
    WAVE_LDS_SYNC();
}

constexpr int SCAN_LDS0 = 8192, SCAN_BUF = 49152, SC_GATE = 40960, SCAN_NDMA = 47;
__device__ __forceinline__ void dn_scan_fetch(const unsigned char* cb, const bf16* gate0, LAS unsigned char* buf, int lane) {
    asm volatile("" : "+v"(lane));
    const unsigned rW = lane >> 3, pW = lane & 7;
#pragma unroll
    for (int n = 0; n < 8; ++n) { const unsigned row = 8 * n + rW; const unsigned so = (row * 8 + (pW ^ (row & 7))) * 16;
        __builtin_amdgcn_global_load_lds((const unsigned*)(cb + CH_UT + so), (LAS unsigned*)(buf + CH_UT + n * 1024), 16, 0, 0);
        __builtin_amdgcn_global_load_lds((const unsigned*)(cb + CH_WN + so), (LAS unsigned*)(buf + CH_WN + n * 1024), 16, 0, 0);
        __builtin_amdgcn_global_load_lds((const unsigned*)(cb + CH_KDT + so), (LAS unsigned*)(buf + CH_KDT + n * 1024), 16, 0, 0);
        __builtin_amdgcn_global_load_lds((const unsigned*)(cb + CH_QD + n * 1024 + lane * 16), (LAS unsigned*)(buf + CH_QD + n * 1024), 16, 0, 0);
        if (n != 3) __builtin_amdgcn_global_load_lds((const unsigned*)(cb + CH_QKF + n * 1024 + lane * 16), (LAS unsigned*)(buf + CH_QKF + n * 1024), 16, 0, 0);
        __builtin_amdgcn_global_load_lds((const unsigned*)(gate0 + (size_t)row * NP + 8 * (pW ^ (row & 7))), (LAS unsigned*)(buf + SC_GATE + n * 1024), 16, 0, 0); }
}
__device__ __forceinline__ void dn_scan(Frame& F, int l, int bh) {
    const int lane = F.lane, r = lane & 31, hf = lane >> 5, b = bh >> 2, h = bh & 3;
    const bf16* P = WSP(bf16, WS_P); unsigned char* Y = WSP(unsigned char, WS_Y);
    const unsigned char* cb0 = F.ws + ch_off(bh * 32);
    const bf16* gate00 = P + (size_t)b * SEQ * NP + PC_GATE + h * 64;
    f32x16 S[2][2];
#pragma unroll
    for (int dt = 0; dt < 2; ++dt)
#pragma unroll
        for (int jt = 0; jt < 2; ++jt)
#pragma unroll
            for (int i = 0; i < 16; ++i) S[dt][jt][i] = 0.f;
    dn_scan_fetch(cb0, gate00, F.lds + SCAN_LDS0, lane);
    dn_scan_fetch(cb0 + CH_STRIDE, gate00 + (size_t)64 * NP, F.lds + SCAN_LDS0 + SCAN_BUF, lane);
    asm volatile("s_waitcnt vmcnt(47)" ::: "memory");
    int bi = 0;
    for (int c = 0; c < 32; ++c) {
        asm volatile("s_waitcnt lgkmcnt(0)" ::: "memory");
        { const int cf = (c + 2 < 32) ? c + 2 : 31; const int bf_ = bi == 0 ? 2 : bi - 1;
          dn_scan_fetch(cb0 + (size_t)cf * CH_STRIDE, gate00 + (size_t)cf * 64 * NP, F.lds + SCAN_LDS0 + bf_ * SCAN_BUF, lane); }
        const LAS unsigned char* lb = F.lds + SCAN_LDS0 + bi * SCAN_BUF;
        bi = bi == 2 ? 0 : bi + 1;
        const size_t r0 = (size_t)b * SEQ + c * 64;
        const float egl = *(const LAS float*)(lb + CH_EGL);
        bf16x8 Sp[2][2][2];
#pragma unroll
        for (int dt = 0; dt < 2; ++dt)
#pragma unroll
            for (int jt = 0; jt < 2; ++jt) { Sp[dt][jt][0] = pack_regs(S[dt][jt], 0); Sp[dt][jt][1] = pack_regs(S[dt][jt], 1); }
        f32x16 vn[2][2];
#pragma unroll
        for (int it = 0; it < 2; ++it)
#pragma unroll
            for (int jt = 0; jt < 2; ++jt)
#pragma unroll
                for (int g4 = 0; g4 < 4; ++g4) { const unsigned row = 32 * jt + r; const u32x2 u = *(const LAS u32x2*)(lb + CH_UT + row * 128 + (((4 * it + g4) ^ (row & 7)) * 16) + 8 * hf);
                    vn[it][jt][4 * g4] = bf2f(u.x & 0xffffu); vn[it][jt][4 * g4 + 1] = bf2f(u.x >> 16); vn[it][jt][4 * g4 + 2] = bf2f(u.y & 0xffffu); vn[it][jt][4 * g4 + 3] = bf2f(u.y >> 16); }
#pragma unroll
        for (int it = 0; it < 2; ++it) { bf16x8 wf[4];
#pragma unroll
            for (int s = 0; s < 4; ++s) { const unsigned row = 32 * it + r; const LAS unsigned char* wp = lb + CH_WN + row * 128 + 8 * hf; const unsigned sw = row & 7;
                const u32x2 lo = *(const LAS u32x2*)(wp + (((2 * s) ^ sw) * 16)), hi = *(const LAS u32x2*)(wp + (((2 * s + 1) ^ sw) * 16)); wf[s] = __builtin_bit_cast(bf16x8, (u32x4){lo.x, lo.y, hi.x, hi.y}); }
            asm volatile("" ::: "memory");
#pragma unroll
            for (int s = 0; s < 4; ++s) { vn[it][0] = MFMA32(wf[s], Sp[s >> 1][0][s & 1], vn[it][0]); vn[it][1] = MFMA32(wf[s], Sp[s >> 1][1][s & 1], vn[it][1]); } }
        bf16x8 Vp[2][2][2];
#pragma unroll
        for (int it = 0; it < 2; ++it)
#pragma unroll
            for (int jt = 0; jt < 2; ++jt) { Vp[it][jt][0] = pack_regs(vn[it][jt], 0); Vp[it][jt][1] = pack_regs(vn[it][jt], 1); }
#pragma unroll
        for (int dt = 0; dt < 2; ++dt)
#pragma unroll
            for (int jt = 0; jt < 2; ++jt)
#pragma unroll
                for (int i = 0; i < 16; ++i) S[dt][jt][i] *= egl;
#pragma unroll
        for (int dt = 0; dt < 2; ++dt) { bf16x8 kfr[4];
#pragma unroll
            for (int q = 0; q < 4; ++q) { const unsigned row = 32 * dt + r; const LAS unsigned char* kp = lb + CH_KDT + row * 128 + 8 * hf; const unsigned sw = row & 7, c0 = 2 * q;
                const u32x2 lo = *(const LAS u32x2*)(kp + ((c0 ^ sw) * 16)), hi = *(const LAS u32x2*)(kp + (((c0 + 1) ^ sw) * 16)); kfr[q] = __builtin_bit_cast(bf16x8, (u32x4){lo.x, lo.y, hi.x, hi.y}); }
            asm volatile("" ::: "memory");
#pragma unroll
            for (int q = 0; q < 4; ++q) { S[dt][0] = MFMA32(kfr[q], Vp[q >> 1][0][q & 1], S[dt][0]); S[dt][1] = MFMA32(kfr[q], Vp[q >> 1][1][q & 1], S[dt][1]); } }
#pragma unroll
        for (int tt = 0; tt < 2; ++tt) {
            f32x16 o[2];
#pragma unroll
            for (int jt = 0; jt < 2; ++jt)
#pragma unroll
                for (int i = 0; i < 16; ++i) o[jt][i] = 0.f;
            bf16x8 qd[4], qk[4];
#pragma unroll
            for (int s = 0; s < 4; ++s) qd[s] = *(const LAS bf16x8*)(lb + CH_QD + ((tt * 4 + s) * 64 + lane) * 16);
#pragma unroll
            for (int q = 0; q < 2 * (tt + 1); ++q) qk[q] = *(const LAS bf16x8*)(lb + CH_QKF + ((tt * 4 + q) * 64 + lane) * 16);
            asm volatile("" ::: "memory");
#pragma unroll
            for (int s = 0; s < 4; ++s) { o[0] = MFMA32(Sp[s >> 1][0][s & 1], qd[s], o[0]); o[1] = MFMA32(Sp[s >> 1][1][s & 1], qd[s], o[1]); }
#pragma unroll
            for (int q = 0; q < 2 * (tt + 1); ++q) { o[0] = MFMA32(Vp[q >> 1][0][q & 1], qk[q], o[0]); o[1] = MFMA32(Vp[q >> 1][1][q & 1], qk[q], o[1]); }
            float ss = 0.f;
#pragma unroll
            for (int i = 0; i < 16; ++i) ss += o[0][i] * o[0][i] + o[1][i] * o[1][i];
            ss += __shfl_xor(ss, 32);
            const float rs = __builtin_amdgcn_rsqf(ss * (1.0f / 64.0f) + EPS);
            const size_t row = r0 + 32 * tt + r;
            if (tt == 0) asm volatile("s_waitcnt vmcnt(47)" ::: "memory");
#pragma unroll
            for (int jt = 0; jt < 2; ++jt)
#pragma unroll
                for (int g4 = 0; g4 < 4; ++g4) { const int d0 = 32 * jt + 8 * g4 + 4 * hf;
                    const unsigned trow = 32 * tt + r; const u32x2 gv = *(const LAS u32x2*)(lb + SC_GATE + trow * 128 + (((4 * jt + g4) ^ (trow & 7)) * 16) + 8 * hf);
                    const float y0 = o[jt][4 * g4] * rs * bf2f(gv.x & 0xffffu), y1 = o[jt][4 * g4 + 1] * rs * bf2f(gv.x >> 16);
                    const float y2 = o[jt][4 * g4 + 2] * rs * bf2f(gv.y & 0xffffu), y3 = o[jt][4 * g4 + 3] * rs * bf2f(gv.y >> 16);
                    *(unsigned*)(Y + row * D + YC_A + h * 64 + d0) = q8x4(y0, y1, y2, y3); }
        }
    }
    asm volatile("s_waitcnt vmcnt(0) lgkmcnt(0)" ::: "memory");
}
__device__ __forceinline__ void sg_tile(Frame& F, int l, int unit, LAS unsigned char* wl) {
    int lane = F.lane; asm volatile("" : "+v"(lane)); const int r = lane & 31, hf = lane >> 5;
    const int h = unit & 3, bn = unit >> 2; const size_t r0 = (size_t)(bn >> 4) * SEQ + (bn & 15) * 128;
    const bf16* P = WSP(bf16, WS_P); unsigned char* Y = WSP(unsigned char, WS_Y); const bf16* wsg = WSP(bf16, WS_WSG) + (size_t)(l * 4 + h) * 128 * 128;
    LAS float* MU = (LAS float*)wl; LAS float* RS = MU + 128;
    LAS unsigned char* vt = wl + 1024;
    { u32x4 w_[16];
#pragma unroll
      for (int i = 0; i < 16; ++i) w_[i] = *(const u32x4*)(P + (r0 + 8 * i + (lane >> 3)) * NP + PC_VB + h * 64 + (lane & 7) * 8);
#pragma unroll
      for (int i = 0; i < 16; ++i) { LAS unsigned char* d_ = vt + (8 * i + (lane >> 3)) * 136 + (lane & 7) * 16; *(LAS u32x2*)d_ = (u32x2){w_[i].x, w_[i].y}; *(LAS u32x2*)(d_ + 8) = (u32x2){w_[i].z, w_[i].w}; } }
    WAVE_LDS_SYNC(); asm volatile("" ::: "memory");
#pragma unroll
    for (int tk = 0; tk < 2; ++tk) { const int s = lane + 64 * tk; const LAS u32x2* vp = (const LAS u32x2*)(vt + s * 136);
        float x[64];
#pragma unroll
        for (int c4 = 0; c4 < 16; ++c4) { const u32x2 v = vp[c4]; x[4 * c4] = bf2f(v.x & 0xffffu); x[4 * c4 + 1] = bf2f(v.x >> 16); x[4 * c4 + 2] = bf2f(v.y & 0xffffu); x[4 * c4 + 3] = bf2f(v.y >> 16); }
        float sm = 0.f;
#pragma unroll
        for (int i = 0; i < 64; ++i) sm += x[i];
        const float mu = sm * (1.0f / 64.0f); float vr = 0.f;
#pragma unroll
        for (int i = 0; i < 64; ++i) { const float dx = x[i] - mu; vr += dx * dx; }
        MU[s] = mu; RS[s] = __builtin_amdgcn_rsqf(vr * (1.0f / 64.0f) + EPS); }
    WAVE_LDS_SYNC();
    bf16x8 af[2][8];
    { const float g0 = GIN(I_GLNB)[l * 256 + h * 64 + r], g1 = GIN(I_GLNB)[l * 256 + h * 64 + 32 + r];
      const LAS bf16* vcol = (const LAS bf16*)(vt + r * 2);
#pragma unroll
      for (int ks = 0; ks < 8; ++ks) { float a0[8], a1[8];
#pragma unroll
          for (int j = 0; j < 8; ++j) { const int s = 16 * ks + 8 * hf + j; const float mu = MU[s], rs = RS[s];
              a0[j] = (bf2f(vcol[s * 68]) - mu) * rs * g0; a1[j] = (bf2f(vcol[s * 68 + 32]) - mu) * rs * g1; }
          af[0][ks] = pack8(a0[0], a0[1], a0[2], a0[3], a0[4], a0[5], a0[6], a0[7]); af[1][ks] = pack8(a1[0], a1[1], a1[2], a1[3], a1[4], a1[5], a1[6], a1[7]);
          if (ks & 1) asm volatile("" ::: "memory"); } }
#pragma unroll
    for (int tt = 0; tt < 4; ++tt) {
        f32x16 acc[2];
#pragma unroll
        for (int i = 0; i < 16; ++i) { acc[0][i] = 0.f; acc[1][i] = 0.f; }
        const bf16* wrow = wsg + (size_t)(32 * tt + r) * 128 + 8 * hf;
        bf16x8 bw[8];
#pragma unroll
        for (int ks = 0; ks < (tt < 2 ? 4 : 8); ++ks) bw[ks] = *(const bf16x8*)(wrow + 16 * ks);
        asm volatile("" ::: "memory");
#pragma unroll
        for (int ks = 0; ks < (tt < 2 ? 4 : 8); ++ks) { acc[0] = MFMA32(af[0][ks], bw[ks], acc[0]); acc[1] = MFMA32(af[1][ks], bw[ks], acc[1]); }
        const int t = 32 * tt + r; const float bias = GIN(I_BSG)[(l * 4 + h) * 128 + t]; const size_t row = r0 + t;
#pragma unroll
        for (int dt = 0; dt < 2; ++dt)
#pragma unroll
            for (int g4 = 0; g4 < 4; ++g4) { const int d0 = 32 * dt + 8 * g4 + 4 * hf; const u32x2 uv = *(const u32x2*)(P + row * NP + PC_UB + h * 64 + d0);
                *(unsigned*)(Y + row * D + YC_B + h * 64 + d0) = q8x4(bf2f(uv.x & 0xffffu) * (acc[dt][4 * g4] + bias), bf2f(uv.x >> 16) * (acc[dt][4 * g4 + 1] + bias), bf2f(uv.y & 0xffffu) * (acc[dt][4 * g4 + 2] + bias), bf2f(uv.y >> 16) * (acc[dt][4 * g4 + 3] + bias)); }
    }
    WAVE_LDS_SYNC();
}
template <int W> __device__ __forceinline__ void pool_tile_w(Frame& F, int l, int g, int tile) {
    int lane = F.lane; asm volatile("" : "+v"(lane)); const int r = lane & 31, hf = lane >> 5;
    const size_t row = (size_t)tile * 32 + r; const int t = (int)(row & (SEQ - 1));
    const bf16* P = WSP(bf16, WS_P); unsigned char* Y = WSP(unsigned char, WS_Y); const bf16* wpt = WSP(bf16, WS_WPT) + (size_t)(l * 4 + g) * 64 * 64;
    const int cnt = (t + 1 < W) ? (t + 1) : W; const float icnt = 1.0f / (float)cnt;
    f32x16 acc[2];
#pragma unroll
    for (int i = 0; i < 16; ++i) { acc[0][i] = 0.f; acc[1][i] = 0.f; }
#pragma unroll
    for (int ks = 0; ks < 4; ++ks) { const bf16* xp = P + row * NP + PC_XC + g * 64 + 16 * ks + 8 * hf;
        u32x4 v[W];
#pragma unroll
        for (int q = 0; q < W; ++q) v[q] = *(const u32x4*)(xp - (size_t)(q < cnt ? q : 0) * NP);
        float sm[8];
#pragma unroll
        for (int j = 0; j < 8; ++j) sm[j] = 0.f;
#pragma unroll
        for (int q = 0; q < W; ++q) { const float m = (q < cnt) ? 1.0f : 0.0f;
            sm[0] += m * bf2f(v[q].x & 0xffffu); sm[1] += m * bf2f(v[q].x >> 16); sm[2] += m * bf2f(v[q].y & 0xffffu); sm[3] += m * bf2f(v[q].y >> 16);
            sm[4] += m * bf2f(v[q].z & 0xffffu); sm[5] += m * bf2f(v[q].z >> 16); sm[6] += m * bf2f(v[q].w & 0xffffu); sm[7] += m * bf2f(v[q].w >> 16); }
        const bf16x8 bfr = pack8(sm[0] * icnt - bf2f(v[0].x & 0xffffu), sm[1] * icnt - bf2f(v[0].x >> 16), sm[2] * icnt - bf2f(v[0].y & 0xffffu), sm[3] * icnt - bf2f(v[0].y >> 16),
                                 sm[4] * icnt - bf2f(v[0].z & 0xffffu), sm[5] * icnt - bf2f(v[0].z >> 16), sm[6] * icnt - bf2f(v[0].w & 0xffffu), sm[7] * icnt - bf2f(v[0].w >> 16));
        const bf16x8 a0 = *(const bf16x8*)(wpt + (size_t)r * 64 + 16 * ks + 8 * hf), a1 = *(const bf16x8*)(wpt + (size_t)(32 + r) * 64 + 16 * ks + 8 * hf);
        acc[0] = MFMA32(a0, bfr, acc[0]); acc[1] = MFMA32(a1, bfr, acc[1]);
        if (W == 16) asm volatile("" ::: "memory"); }
    const float* sp = GIN(I_SPOOL) + l * 256 + g * 64;
#pragma unroll
    for (int dt = 0; dt < 2; ++dt)
#pragma unroll
        for (int g4 = 0; g4 < 4; ++g4) { const int d0 = 32 * dt + 8 * g4 + 4 * hf; const f32x4 sv = *(const f32x4*)(sp + d0);
            *(unsigned*)(Y + row * D + YC_C + g * 64 + d0) = q8x4(acc[dt][4 * g4] * sv[0], acc[dt][4 * g4 + 1] * sv[1], acc[dt][4 * g4 + 2] * sv[2], acc[dt][4 * g4 + 3] * sv[3]); }
}
__device__ __forceinline__ void pool_tile(Frame& F, int l, int unit) {
    const int g = 3 - (unit >> 10), tile = unit & 1023;
    if (g == 3) pool_tile_w<16>(F, l, 3, tile); else if (g == 2) pool_tile_w<8>(F, l, 2, tile); else if (g == 1) pool_tile_w<4>(F, l, 1, tile); else pool_tile_w<2>(F, l, 0, tile);
}
__device__ __forceinline__ void mix(Frame& F, int l) {
    constexpr int NSC = 64;
    const int gw = F.bid * NWAVES + F.wave, NGW = F.G * NWAVES;
    unsigned* cnt = (unsigned*)(F.ws + WS_CTL) + CW_DNCNT;
    LAS unsigned char* wl = F.lds + F.wave * DN_WLDS;
    for (int u0 = F.bid * NWAVES; u0 < 2048; u0 += NGW) {
        if (u0 + F.wave < 2048) dn_prep(F, l, u0 + F.wave, wl);
        asm volatile("s_waitcnt vmcnt(0)" ::: "memory");
        __syncthreads();
        if (F.tid == 0) { __builtin_amdgcn_fence(__ATOMIC_RELEASE, "agent");
            asm volatile("s_waitcnt vmcnt(0)" ::: "memory");
            const int nch = 2048 - u0 < NWAVES ? 2048 - u0 : NWAVES;
            __hip_atomic_fetch_add(cnt + 64 * (u0 >> 5), (unsigned)nch, __ATOMIC_RELAXED, __HIP_MEMORY_SCOPE_AGENT); }
    }
    if (F.bid < NSC) {
        if (F.wave == 0) {
            const unsigned want = 32u * (unsigned)(l + 1); unsigned spins = 0;
            while ((unsigned)__builtin_amdgcn_readfirstlane(__hip_atomic_load(cnt + 64 * F.bid, __ATOMIC_RELAXED, __HIP_MEMORY_SCOPE_AGENT)) < want) {
                __builtin_amdgcn_s_sleep(2); if (++spins > (1u << 22)) break; }
            __builtin_amdgcn_fence(__ATOMIC_ACQUIRE, "agent");
            asm volatile("s_waitcnt vmcnt(0)" ::: "memory");
            dn_scan(F, l, F.bid);
#ifdef PROBE_SCAN2
            dn_scan(F, l, F.bid);
#endif
            return; }
        const int wi = F.bid * 7 + F.wave - 1, NWI = NSC * 7;
        return; }
    const int wi = (F.bid - NSC) * NWAVES + F.wave, NWI = (F.G - NSC) * NWAVES;
    for (int idx = wi; idx < 9216; idx += NWI) {
        if (idx < 1024) sg_tile(F, l, idx, wl);
        else if (idx < 2048) pool_tile(F, l, idx - 1024);
        else if (idx >= 6144) pool_tile(F, l, idx - 6144 + 1024);
        else { const int j = idx - 2048; const int qt = 63 - (j >> 6), bh = j & 63; sb_tile(F, l, bh >> 2, bh & 3, qt, wl); }
    }
}

__device__ __forceinline__ void fin(Frame& F) {
    const int gw = F.bid * NWAVES + F.wave, NGW = F.G * NWAVES; const float* ssq = WSP(float, WS_SSQ1); const float* gf = GIN(I_GFIN); const bf16* xb = WSP(bf16, WS_XB);
    for (int r = gw; r < M; r += 2 * NGW) { const int r2 = r + NGW < M ? r + NGW : r;
        const float rsa = pg8::row_rstd(ssq, r), rsb = pg8::row_rstd(ssq, r2);
        u32x4 va[2], vb[2];
#pragma unroll
        for (int j = 0; j < 2; ++j) { va[j] = *(const u32x4*)(xb + (size_t)r * D + 512 * j + 8 * F.lane); vb[j] = *(const u32x4*)(xb + (size_t)r2 * D + 512 * j + 8 * F.lane); }
#pragma unroll
        for (int j = 0; j < 2; ++j) { const int cc = 512 * j + 8 * F.lane; const f32x4 g0 = *(const f32x4*)(gf + cc), g1 = *(const f32x4*)(gf + cc + 4);
            const f32x4 a0 = (f32x4){bf2f(va[j].x & 0xffffu), bf2f(va[j].x >> 16), bf2f(va[j].y & 0xffffu), bf2f(va[j].y >> 16)}, a1 = (f32x4){bf2f(va[j].z & 0xffffu), bf2f(va[j].z >> 16), bf2f(va[j].w & 0xffffu), bf2f(va[j].w >> 16)};
            const f32x4 b0 = (f32x4){bf2f(vb[j].x & 0xffffu), bf2f(vb[j].x >> 16), bf2f(vb[j].y & 0xffffu), bf2f(vb[j].y >> 16)}, b1 = (f32x4){bf2f(vb[j].z & 0xffffu), bf2f(vb[j].z >> 16), bf2f(vb[j].w & 0xffffu), bf2f(vb[j].w >> 16)};
            *(f32x4*)(as_global(F.out) + (size_t)r * D + cc) = a0 * rsa * g0; *(f32x4*)(as_global(F.out) + (size_t)r * D + cc + 4) = a1 * rsa * g1;
            if (r2 != r) { *(f32x4*)(as_global(F.out) + (size_t)r2 * D + cc) = b0 * rsb * g0; *(f32x4*)(as_global(F.out) + (size_t)r2 * D + cc + 4) = b1 * rsb * g1; } } }
}
#ifndef MK_PER_PHASE
#define MK_PER_PHASE 0
#endif
constexpr int N_PHASES = 2 + 6 * DEPTH + 1;
struct Args { const float* in[N_IN]; float* out; unsigned char* ws; int ph_lo, ph_hi; };
__global__ void __launch_bounds__(NTHR, 2) fwd(Args args) {
    extern __shared__ __attribute__((aligned(16))) unsigned char lds_raw[];
    Frame F;
    F.lds = (LAS unsigned char*)lds_raw;
    F.tid = threadIdx.x; F.lane = F.tid & 63; F.wave = __builtin_amdgcn_readfirstlane(F.tid >> 6);
    F.G = gridDim.x; F.bid = blockIdx.x; F.ws = args.ws; F.out = args.out;
    F.in = args.in;
    volatile LAS unsigned* MISC = (volatile LAS unsigned*)(F.lds + MISC_OFF);
    if (F.tid < 32) MISC[F.tid] = 0u;
    __syncthreads();
    XcdBarrier bar; bar.bar = (unsigned*)(F.ws + WS_CTL) + CW_BAR; bar.x = 0; bar.st = nullptr;
    if (F.tid == 0) { const unsigned xcc = xb_xcc_id(); MISC[12] = xcc; MISC[13] = __hip_atomic_fetch_add((unsigned*)(F.ws + WS_CTL) + CW_XRANK + 64 * (xcc & 15), 1u, __ATOMIC_RELAXED, __HIP_MEMORY_SCOPE_AGENT); }
    int vc = F.bid;
    if (!MK_PER_PHASE) bar = xcd_barrier_post((unsigned*)(F.ws + WS_CTL) + CW_BAR, MISC + 8);
    const int lo = args.ph_lo, hi = args.ph_hi;
#define IN(k) (lo <= (k) && (k) < hi)
#define SEAMX() do { XcdBarrier b2_ = bar; unsigned* p_ = b2_.bar; unsigned x_ = b2_.x; asm volatile("" : "+s"(p_), "+s"(x_)); b2_.bar = p_; b2_.x = x_; xcd_barrier(b2_); } while (0)
#define FILL_TABLES(ssqp, swp, swld, goap, qsap, qsbp) do { const float* q_ = (ssqp); const float* s_ = (swp); const float* g_ = (goap); const float* qa_ = (qsap); const float* qb_ = (qsbp); \
    LAS float* tr_ = (LAS float*)(F.lds + RING_BYTES); LAS float* ts_ = tr_ + 2048; LAS float* tg_ = ts_ + 2048; LAS int* ul_ = (LAS int*)(tg_ + 256); LAS float* tq_ = tg_ + 512; \
      \
    if (F.tid == 0) { for (int i_ = 0; i_ < 8; ++i_) { pg8::Unit u_; const bool k_ = S.next(i_, u_); ul_[2 * i_] = k_ ? u_.pm : -1; ul_[2 * i_ + 1] = k_ ? u_.pn : 0; } } \
    asm volatile("s_waitcnt lgkmcnt(0)" ::: "memory"); __builtin_amdgcn_s_barrier(); \
    if (F.tid < 256) { float t_[8], a_s[8]; \
        _Pragma("unroll") for (int i_ = 0; i_ < 8; ++i_) { const int pm_ = ul_[2 * i_]; t_[i_] = 0.f; a_s[i_] = 1.f; if (pm_ >= 0) { const pg8::f32x4* p_ = (const pg8::f32x4*)(q_ + (size_t)(pm_ * 256 + F.tid) * 16); const pg8::f32x4 a_ = p_[0], b_ = p_[1], c_ = p_[2], d_ = p_[3]; \
            t_[i_] = ((a_[0] + a_[1]) + (a_[2] + a_[3])) + ((b_[0] + b_[1]) + (b_[2] + b_[3])) + ((c_[0] + c_[1]) + (c_[2] + c_[3])) + ((d_[0] + d_[1]) + (d_[2] + d_[3])); if (qa_) a_s[i_] = qa_[pm_ * 256 + F.tid]; } } \
        _Pragma("unroll") for (int i_ = 0; i_ < 8; ++i_) tr_[i_ * 256 + F.tid] = __builtin_amdgcn_rsqf(t_[i_] * (1.0f / 1024.0f) + 1e-6f) * a_s[i_]; \
        if (g_) tg_[F.tid] = g_[F.tid]; } \
    else { float v_[8], w_[8]; \
        _Pragma("unroll") for (int i_ = 0; i_ < 8; ++i_) { const int pm_ = ul_[2 * i_], pn_ = ul_[2 * i_ + 1]; v_[i_] = pm_ >= 0 ? s_[(size_t)(pm_ >> 3) * (swld) + pn_ * 256 + F.tid - 256] : 0.f; w_[i_] = (pm_ >= 0 && qb_) ? qb_[pn_ * 256 + F.tid - 256] : 1.f; } \
        _Pragma("unroll") for (int i_ = 0; i_ < 8; ++i_) { ts_[i_ * 256 + F.tid - 256] = v_[i_]; tq_[i_ * 256 + F.tid - 256] = w_[i_]; } } \
    asm volatile("s_waitcnt lgkmcnt(0)" ::: "memory"); __builtin_amdgcn_s_barrier(); } while (0)
#define FILL_RTAB(gatep, gnp, scp, qrefp, qsap, hsp, hcp) do { const float* ga_ = (gatep); const float* gn_ = (gnp); const float* sc_ = (scp); const float* qr_ = (qrefp); float* qa_ = (qsap); const float* hs_ = (hsp); const int* hc_ = (hcp); \
    LAS float* tis_ = (LAS float*)(F.lds + RING_BYTES); LAS float* tgs_ = tis_ + 1024; LAS float* tG_ = tgs_ + 1024; LAS int* thc_ = (LAS int*)(tG_ + 1024); LAS int* ul_ = thc_ + 1024; \
    if (F.tid == 0) { for (int i_ = 0; i_ < 4; ++i_) { pg8::Unit u_; const bool k_ = S.next(i_, u_); ul_[2 * i_] = k_ ? u_.pm : -1; ul_[2 * i_ + 1] = k_ ? u_.pn : 0; } } \
    asm volatile("s_waitcnt lgkmcnt(0)" ::: "memory"); __builtin_amdgcn_s_barrier(); \
    if (F.tid < 256) { float t_[4]; \
        _Pragma("unroll") for (int i_ = 0; i_ < 4; ++i_) { const int pm_ = ul_[2 * i_]; t_[i_] = 0.f; if (pm_ >= 0 && qr_) { const pg8::f32x4* p_ = (const pg8::f32x4*)(qr_ + (size_t)(pm_ * 256 + F.tid) * 16); const pg8::f32x4 a_ = p_[0], b_ = p_[1], c_ = p_[2], d_ = p_[3]; \
            t_[i_] = ((a_[0] + a_[1]) + (a_[2] + a_[3])) + ((b_[0] + b_[1]) + (b_[2] + b_[3])) + ((c_[0] + c_[1]) + (c_[2] + c_[3])) + ((d_[0] + d_[1]) + (d_[2] + d_[3])); } } \
        _Pragma("unroll") for (int i_ = 0; i_ < 4; ++i_) { const int pm_ = ul_[2 * i_], pn_ = ul_[2 * i_ + 1]; float v_ = 0.f; if (pm_ >= 0 && qr_) { const float rr_ = __builtin_amdgcn_rsqf(t_[i_] * (1.0f / 1024.0f) + 1e-6f); v_ = 127.0f * rr_ * (1.0f / pg8::QCLIP8); if (pn_ == 0) qa_[pm_ * 256 + F.tid] = pg8::QCLIP8 / (127.0f * rr_); } \
            tis_[i_ * 256 + F.tid] = v_; } } \
    else { const int c_ = F.tid - 256; float g_[4], G_[4]; int h_[4]; \
        _Pragma("unroll") for (int i_ = 0; i_ < 4; ++i_) { const int pm_ = ul_[2 * i_], col_ = ul_[2 * i_ + 1] * 256 + c_; g_[i_] = 0.f; G_[i_] = 0.f; h_[i_] = 0; \
            if (pm_ >= 0) { g_[i_] = ga_[(size_t)(pm_ >> 3) * 6144 + col_]; if (hs_) { g_[i_] *= hs_[col_]; if (hc_) h_[i_] = __builtin_bit_cast(int, g_[i_] * (float)(hc_[col_] * 128)); } if (gn_) G_[i_] = gn_[col_] * (sc_[(size_t)(pm_ >> 3) * 6144 + col_] + 1.0f); } } \
        _Pragma("unroll") for (int i_ = 0; i_ < 4; ++i_) { tgs_[i_ * 256 + c_] = g_[i_]; tG_[i_ * 256 + c_] = G_[i_]; thc_[i_ * 256 + c_] = h_[i_]; } } \
    asm volatile("s_waitcnt lgkmcnt(0)" ::: "memory"); __builtin_amdgcn_s_barrier(); } while (0)
#define RTABS (const LAS float*)(F.lds + RING_BYTES), (const LAS float*)(F.lds + RING_BYTES + 4096), (const LAS float*)(F.lds + RING_BYTES + 8192), (const LAS int*)(F.lds + RING_BYTES + 12288)
#define FRESH() do { int t_ = threadIdx.x; asm volatile("" : "+v"(t_)); F.tid = t_; F.lane = t_ & 63; F.wave = __builtin_amdgcn_readfirstlane(t_ >> 6); unsigned long long z_ = 0ull; asm volatile("" : "+s"(z_)); F.ws = args.ws + z_; } while (0)
#define SEAM(k) do { if (!MK_PER_PHASE && IN(k) && IN((k) + 1)) { XcdBarrier b2_ = bar; unsigned* p_ = b2_.bar; unsigned x_ = b2_.x; asm volatile("" : "+s"(p_), "+s"(x_)); b2_.bar = p_; b2_.x = x_; xcd_barrier(b2_); } } while (0)

    #ifndef SKIP_P0
    if (IN(0)) { FRESH(); p0a(F); }
#endif
    SEAM(0);
    if (!MK_PER_PHASE) { bool even = (F.G % 8 == 0); for (int j = 0; j < 16; ++j) { const unsigned n_ = __hip_atomic_load((unsigned*)(F.ws + WS_CTL) + CW_XRANK + 64 * j, __ATOMIC_RELAXED, __HIP_MEMORY_SCOPE_AGENT); even = even && ((unsigned)__builtin_amdgcn_readfirstlane((int)n_) == (j < 8 ? (unsigned)F.G / 8u : 0u)); }
        if (even) vc = __builtin_amdgcn_readfirstlane((int)(MISC[13] * 8u + MISC[12])); }
    #ifndef SKIP_P0
    if (IN(1)) { FRESH(); p0b(F); }
#if defined(PROBE_REP) && PROBE_REP == 9
    SEAMX(); if (IN(0)) { FRESH(); p0a(F); } SEAMX(); if (IN(1)) { FRESH(); p0b(F); }
#endif
#endif
    SEAM(1);
    for (int l = 0; l < DEPTH; ++l) {
        const int pb = 2 + 6 * l;
#define modl (WSP(float, WS_MOD) + (size_t)l * 16 * NMOD)
#ifndef SKIP_G1
        if (IN(pb)) {
            FRESH();
            pg8::Gemm g{WSP(bf16, WS_XG), WSP(bf16, WS_WIN) + (size_t)l * NP * D, M, NP, D / 2, D / 2, D};     pg8::StaticOrder S; S.init(M, NP, F.G, vc);
            pg8::EpiNormed<0, true> E{WSP(bf16, WS_P), NP, (const LAS float*)(F.lds + RING_BYTES), (const LAS float*)(F.lds + RING_BYTES + 8192), (const LAS float*)(F.lds + RING_BYTES + 16384), (const LAS float*)(F.lds + RING_BYTES + 16384 + 2048)};
            { auto pre = [&]() { FILL_TABLES(WSP(float, WS_SSQ1), WSP(float, WS_SW1) + (size_t)l * 16 * NP, NP, GIN(I_GOA) + l * 256, WSP(float, WS_QSA1), WSP(float, WS_QSB1) + (size_t)l * NP); }; pg8::gemm_phase<pg8::EpiNormed<0, true>, pg8::StaticOrder, true, true>(F.lds, g, S, E, pre); }
#if defined(PROBE_REP) && PROBE_REP == 6
            SEAMX(); FRESH(); pg8::gemm_phase<pg8::EpiNormed<0, true>, pg8::StaticOrder, true, true>(F.lds, g, S, E);
#endif
#ifndef SKIP_AB
            FRESH(); ab_logits(F, l);
#if defined(PROBE_REP) && PROBE_REP == 11
            SEAMX(); FRESH(); ab_logits(F, l);
#endif
#endif
        }
#endif
        SEAM(pb);
        if (IN(pb + 1)) { FRESH(); mix(F, l); }
        SEAM(pb + 2);
#ifndef SKIP_G2
        if (IN(pb + 3)) {
            FRESH();
            pg8::Gemm g{WSP(bf16, WS_Y), WSP(bf16, WS_WOUT) + (size_t)l * D * D, M, D, D / 2, D / 2, D};     pg8::StaticOrder S; S.init(M, D, F.G, vc);
            { pg8::EpiResid<false, false, true, true> E{WSP(bf16, WS_XB), WSP(bf16, WS_XB), WSP(bf16, WS_XQ), WSP(float, WS_SSQ2), RTABS};
                auto pre = [&]() { FILL_RTAB(modl + 2 * D, GIN(I_GN2) + (size_t)l * D, modl + 4 * D, WSP(float, WS_SSQ1), WSP(float, WS_QSA), WSP(float, WS_QSBO) + l * D, (const int*)nullptr); }; pg8::gemm_phase<pg8::EpiResid<false, false, true, true>, pg8::StaticOrder, true, true>(F.lds, g, S, E, pre); }
        }
#endif
        SEAM(pb + 3);
#ifndef SKIP_G3
        if (IN(pb + 4)) {
            FRESH();
            pg8::Gemm g{WSP(bf16, WS_XQ), WSP(bf16, WS_WFF1) + (size_t)l * FF * D, M, FF, D / 2, D / 2, D};     pg8::StaticOrder S; S.init(M, FF, F.G, vc);
            pg8::EpiNormed<1, true, true> E{WSP(bf16, WS_HID), FF, (const LAS float*)(F.lds + RING_BYTES), (const LAS float*)(F.lds + RING_BYTES + 8192), (const LAS float*)nullptr, (const LAS float*)(F.lds + RING_BYTES + 16384 + 2048)};
            { auto pre = [&]() { FILL_TABLES(WSP(float, WS_SSQ2), WSP(float, WS_SW2) + (size_t)l * 16 * FF, FF, (const float*)nullptr, WSP(float, WS_QSA), WSP(float, WS_QSB) + (size_t)l * FF); }; pg8::gemm_phase<pg8::EpiNormed<1, true, true>, pg8::StaticOrder, true, true>(F.lds, g, S, E, pre); }
#if defined(PROBE_REP) && PROBE_REP == 8
            { SEAMX(); FRESH(); pg8::EpiNull EN{WSP(float, WS_BETA)}; pg8::gemm_phase<pg8::EpiNull, pg8::StaticOrder, true, true>(F.lds, g, S, EN); }
#endif
#if defined(PROBE_REP) && PROBE_REP == 12
            { SEAMX(); FRESH(); pg8::EpiNormed<1, true, true> E2 = E; E2.nost = (args.ph_hi != 12345); pg8::gemm_phase<pg8::EpiNormed<1, true, true>, pg8::StaticOrder, true, true>(F.lds, g, S, E2); }
#endif
#if defined(PROBE_REP) && PROBE_REP == 7
            SEAMX(); FRESH(); pg8::gemm_phase<pg8::EpiNormed<1, true, true>, pg8::StaticOrder, true, true>(F.lds, g, S, E);
#endif
        }
#endif
        SEAM(pb + 4);
#ifndef SKIP_G4
        if (IN(pb + 5)) {
            FRESH();
            pg8::Gemm g{WSP(bf16, WS_HID), WSP(bf16, WS_WFF2) + (size_t)l * D * FF, M, D, FF / 2, FF / 2, FF};     pg8::StaticOrder S; S.init(M, D, F.G, vc);
            const bool more = l + 1 < DEPTH;
            if (more) {
                pg8::EpiResid<false, false, true, true> E{WSP(bf16, WS_XB), WSP(bf16, WS_XB), WSP(bf16, WS_XG), WSP(float, WS_SSQ1), RTABS};
                auto pre = [&]() { FILL_RTAB(modl + 5 * D, GIN(I_GN1) + (size_t)(l + 1) * D, modl + 16 * NMOD + D, WSP(float, WS_SSQ2), WSP(float, WS_QSA1), WSP(float, WS_QSB2) + l * D, WSP(int, WS_QCS2) + l * D); }; pg8::gemm_phase<pg8::EpiResid<false, false, true, true>, pg8::StaticOrder, true, true>(F.lds, g, S, E, pre); }
            else {
                pg8::EpiResid<false, false, false, true> E{WSP(bf16, WS_XB), WSP(bf16, WS_XB), (bf16*)nullptr, WSP(float, WS_SSQ1), RTABS};
                auto pre = [&]() { FILL_RTAB(modl + 5 * D, (const float*)nullptr, (const float*)nullptr, (const float*)nullptr, (float*)nullptr, WSP(float, WS_QSB2) + l * D, WSP(int, WS_QCS2) + l * D); }; pg8::gemm_phase<pg8::EpiResid<false, false, false, true>, pg8::StaticOrder, true, true>(F.lds, g, S, E, pre); }
        }
#endif
        SEAM(pb + 5);
    }
#ifndef SKIP_FIN
    if (IN(N_PHASES - 1)) { FRESH(); fin(F); }
#endif
#undef modl
#undef IN
#undef SEAM
}

extern "C" void kernel_launch(void* const* d_in, const int* in_sizes, int n_in, void* d_out, int out_size, void* d_ws, size_t ws_size, hipStream_t stream) {
    static int grid = 0;
    if (grid == 0) {
        if (n_in != N_IN || in_sizes[0] != M * D || out_size != M * D || ws_size < WS_END) { fprintf(stderr, "kernel_launch: unexpected shapes (n_in %d, in0 %d, out %d, ws %zu); nothing launched\n", n_in, n_in > 0 ? in_sizes[0] : -1, out_size, ws_size); grid = -1; return; }
        int dev = 0, cus = 0, per_cu = 0;
        if (hipGetDevice(&dev) != hipSuccess || hipDeviceGetAttribute(&cus, hipDeviceAttributeMultiprocessorCount, dev) != hipSuccess) { fprintf(stderr, "kernel_launch: device query failed\n"); grid = -1; return; }
        if (hipFuncSetAttribute((const void*)fwd, hipFuncAttributeMaxDynamicSharedMemorySize, LDS_BYTES) != hipSuccess) { fprintf(stderr, "kernel_launch: hipFuncSetAttribute failed\n"); grid = -1; return; }
        if (hipOccupancyMaxActiveBlocksPerMultiprocessor(&per_cu, (const void*)fwd, NTHR, LDS_BYTES) != hipSuccess || per_cu < 1) fprintf(stderr, "kernel_launch: note: occupancy query reports %d workgroups per CU\n", per_cu);
        (void)hipGetLastError();
        grid = cus;
    }
    if (grid < 0) return;
    if (hipMemsetAsync((char*)d_ws + WS_CTL, 0, CTL_ZERO_BYTES, stream) != hipSuccess) { fprintf(stderr, "kernel_launch: memset failed\n"); return; }
    Args a{};
    for (int i = 0; i < N_IN; ++i) a.in[i] = (const float*)d_in[i];
    a.out = (float*)d_out; a.ws = (unsigned char*)d_ws;
#if MK_PER_PHASE
    for (int ph = 0; ph < N_PHASES; ++ph) { a.ph_lo = ph; a.ph_hi = ph + 1; hipLaunchKernelGGL(fwd, dim3(grid), dim3(NTHR), LDS_BYTES, stream, a); }
#else
    a.ph_lo = 0; a.ph_hi = N_PHASES; hipLaunchKernelGGL(fwd, dim3(grid), dim3(NTHR), LDS_BYTES, stream, a);
#endif
    const hipError_t le = hipPeekAtLastError();
    if (le != hipSuccess) fprintf(stderr, "kernel_launch: launch failed: %s\n", hipGetErrorName(le));
}
```

```cpp
#include <hip/hip_runtime.h>
#include <cstdio>
#include <cstdint>
#define MK_PER_PHASE 0
namespace pg8 {
#define PG8_LAS __attribute__((address_space(3)))
typedef unsigned short bf16_t;
typedef short bf16x8 __attribute__((ext_vector_type(8)));
typedef float f32x4 __attribute__((ext_vector_type(4)));
typedef unsigned u32x4 __attribute__((ext_vector_type(4)));
constexpr int BM = 256, BK = 64, HALF = 128, HTB = HALF * BK * 2  , STAGE_BYTES = 8 * HTB, NXCD = 8, WGM = 8;

__host__ __device__ __forceinline__ int lds_byte(int r, int c) { const int st = (r >> 4) * 2 + (c >> 5), rr = r & 15, cc = c & 31, ob = rr * 64 + cc * 2; return st * 1024 + (ob ^ (((ob >> 9) & 1) << 5)); }
__host__ __device__ __forceinline__ void stage_rc(int b, int& R, int& C) { const int st = b / 1024, sb = b % 1024, swz = sb ^ (((sb >> 9) & 1) << 5); R = (st >> 1) * 16 + swz / 64; C = (st & 1) * 32 + (swz % 64) / 2; }
__host__ __device__ __forceinline__ int perm32(int rho) { const int n = rho >> 4, i = rho & 15; return 8 * (i >> 2) + 4 * n + (i & 3); }

struct Unit { int pm, pn, slot; };
struct Gemm { const bf16_t* A; const bf16_t* Bt; int M, N, K, lda, ldb; };
typedef int i32x4 __attribute__((ext_vector_type(4)));

struct StaticOrder {
    int nM, nN, nwg, G, c;
    __host__ __device__ __forceinline__ void init(int M, int N, int G_, int c_) { nM = M / BM; nN = N / BM; nwg = nM * nN; G = G_; c = c_; }
    __host__ __device__ __forceinline__ bool next(int i, Unit& u) const {
        const int L = i * G + c; if (L >= nwg) return false;
        int wgid = L; { const int q = nwg / NXCD, r = nwg % NXCD, xcd = wgid % NXCD, off = wgid / NXCD; wgid = (xcd < r ? xcd * (q + 1) : r * (q + 1) + (xcd - r) * q) + off; }
        const int nig = WGM * nN, gid = wgid / nig, fm = gid * WGM, gsz = (nM - fm) < WGM ? (nM - fm) : WGM;
        u.pm = fm + ((wgid % nig) % gsz); u.pn = (wgid % nig) / gsz; u.slot = i; return true;
    }
    __device__ __forceinline__ void a_ready(const Unit&) const {}
    __device__ __forceinline__ void done(const Unit&) const {}
};
__device__ __forceinline__ unsigned cvt_pk_bf16(float lo, float hi) { unsigned r; asm volatile("v_cvt_pk_bf16_f32 %0, %1, %2" : "=v"(r) : "v"(lo), "v"(hi)); return r; }
typedef float f32x2 __attribute__((ext_vector_type(2))); typedef unsigned u32x2_t __attribute__((ext_vector_type(2)));
constexpr float QCLIP8 = 8.0f;
constexpr float HCLIP8 = 40.0f;
__device__ __forceinline__ float row_rstd(const float* ssq, int row) {
    const f32x4* p = (const f32x4*)(ssq + (size_t)row * 16);
    const f32x4 a = p[0], b = p[1], c = p[2], d = p[3];
    const float s = ((a[0] + a[1]) + (a[2] + a[3])) + ((b[0] + b[1]) + (b[2] + b[3])) + ((c[0] + c[1]) + (c[2] + c[3])) + ((d[0] + d[1]) + (d[2] + d[3]));
    return __builtin_amdgcn_rsqf(s * (1.0f / 1024.0f) + 1e-6f);
}
template <int ACT, bool I8_ = false, bool OUT8 = false> struct EpiNormed {
    static constexpr bool PERM = true, AFTER_DRAIN = false, I8 = I8_, P16 = OUT8;
    bf16_t* O; int ldc; const PG8_LAS float* rtab; const PG8_LAS float* stab; const PG8_LAS float* gtab; const PG8_LAS float* qtab; int nost = 0;
    __device__ __forceinline__ void operator()(const f32x4 (&acc)[2][2][4][2], const Unit& u, int wr, int wc, int fr, int fq) const {
        const int lc0 = P16 ? wc * 64 + 16 * fq : wc * 32 + 8 * fq;
        constexpr int BJS = P16 ? 8 : HALF;
        const int row0 = u.pm * BM + wr * 64 + fr, col0 = u.pn * BM + lc0;
        f32x4 bv[2][2];
#pragma unroll
        for (int bj = 0; bj < 2; ++bj)
#pragma unroll
            for (int n = 0; n < 2; ++n) { bv[bj][n] = *(const PG8_LAS f32x4*)(stab + u.slot * BM + lc0 + bj * BJS + 4 * n); if (OUT8) bv[bj][n] = bv[bj][n] * __builtin_sqrtf(255.0f / HCLIP8); }
        const bool gsel = (ACT == 0) && gtab != nullptr && u.pn == 3;
        f32x4 gv[2][2];
#pragma unroll
        for (int bj = 0; bj < 2; ++bj)
#pragma unroll
            for (int n = 0; n < 2; ++n) gv[bj][n] = I8 ? *(const PG8_LAS f32x4*)(qtab + u.slot * BM + lc0 + bj * BJS + 4 * n) : (f32x4){1.f, 1.f, 1.f, 1.f};
#pragma unroll
        for (int ai = 0; ai < 2; ++ai)
#pragma unroll
            for (int m = 0; m < 4; ++m) { const int row = row0 + ai * HALF + m * 16; float rs = rtab[u.slot * BM + wr * 64 + fr + ai * HALF + m * 16]; if (OUT8) rs *= __builtin_sqrtf(255.0f / HCLIP8);
                bf16_t* rowp = O + (size_t)row * ldc + col0; u32x2_t wlo = {0u, 0u};
#pragma unroll
                for (int bj = 0; bj < 2; ++bj) { f32x4 a0 = acc[ai][bj][m][0], a1 = acc[ai][bj][m][1];
                    if (I8) { a0 = __builtin_convertvector(__builtin_bit_cast(i32x4, a0), f32x4); a1 = __builtin_convertvector(__builtin_bit_cast(i32x4, a1), f32x4); }
                    f32x4 v0, v1;
                    {
                        const f32x2 rs2 = {rs, rs};
                        f32x2 p0 = {a0[0], a0[1]}, p1 = {a0[2], a0[3]}, p2 = {a1[0], a1[1]}, p3 = {a1[2], a1[3]};
                        if (I8) { p0 = p0 * (f32x2){gv[bj][0][0], gv[bj][0][1]}; p1 = p1 * (f32x2){gv[bj][0][2], gv[bj][0][3]}; p2 = p2 * (f32x2){gv[bj][1][0], gv[bj][1][1]}; p3 = p3 * (f32x2){gv[bj][1][2], gv[bj][1][3]}; }
                        p0 = __builtin_elementwise_fma(p0, rs2, (f32x2){bv[bj][0][0], bv[bj][0][1]}); p1 = __builtin_elementwise_fma(p1, rs2, (f32x2){bv[bj][0][2], bv[bj][0][3]});
                        p2 = __builtin_elementwise_fma(p2, rs2, (f32x2){bv[bj][1][0], bv[bj][1][1]}); p3 = __builtin_elementwise_fma(p3, rs2, (f32x2){bv[bj][1][2], bv[bj][1][3]});
                        v0 = (f32x4){p0[0], p0[1], p1[0], p1[1]}; v1 = (f32x4){p2[0], p2[1], p3[0], p3[1]}; }
                    if (gsel) { const f32x4 gg0 = *(const PG8_LAS f32x4*)(gtab + lc0 + bj * BJS), gg1 = *(const PG8_LAS f32x4*)(gtab + lc0 + bj * BJS + 4);
#pragma unroll
                        for (int j = 0; j < 4; ++j) { v0[j] = v0[j] * __builtin_amdgcn_rcpf(1.0f + __expf(-v0[j])) * gg0[j]; v1[j] = v1[j] * __builtin_amdgcn_rcpf(1.0f + __expf(-v1[j])) * gg1[j]; } }
                    if (ACT == 1 && !OUT8) {
#pragma unroll
                        for (int j = 0; j < 4; ++j) { const float a = fmaxf(v0[j], 0.f), b = fmaxf(v1[j], 0.f); v0[j] = a * a; v1[j] = b * b; } }
                    if (OUT8) {
                        unsigned w0 = 0u, w1 = 0u;
#pragma unroll
                        for (int j = 0; j < 4; ++j) { w0 = __builtin_amdgcn_cvt_pk_u8_f32(v0[j] * __builtin_fabsf(v0[j]), j, w0); w1 = __builtin_amdgcn_cvt_pk_u8_f32(v1[j] * __builtin_fabsf(v1[j]), j, w1); }
                        if (bj == 0) { wlo.x = w0 ^ 0x80808080u; wlo.y = w1 ^ 0x80808080u; }
                        else { u32x4 w; w.x = wlo.x; w.y = wlo.y; w.z = w0 ^ 0x80808080u; w.w = w1 ^ 0x80808080u;
#ifdef PROBE_REP
                            if (nost) { asm volatile("" :: "v"(w.x), "v"(w.y), "v"(w.z), "v"(w.w)); } else
#endif
                            *(u32x4*)((unsigned char*)O + (size_t)row * ldc + col0) = w; } }
                    else { u32x4 w; w.x = cvt_pk_bf16(v0[0], v0[1]); w.y = cvt_pk_bf16(v0[2], v0[3]); w.z = cvt_pk_bf16(v1[0], v1[1]); w.w = cvt_pk_bf16(v1[2], v1[3]);
                        *(u32x4*)(rowp + bj * BJS) = w; } } }
    }
};
template <bool XI32, bool XO32, bool XQ8 = false, bool I8_ = false> struct EpiResid {
    static constexpr bool PERM = true, AFTER_DRAIN = false, I8 = I8_, P16 = false;
    const void* xi; void* xo; bf16_t* xg; float* ssq; const PG8_LAS float* tis; const PG8_LAS float* tgs; const PG8_LAS float* tG; const PG8_LAS int* thc;
    __device__ __forceinline__ void operator()(const f32x4 (&acc)[2][2][4][2], const Unit& u, int wr, int wc, int fr, int fq) const {
        const int row0 = u.pm * BM + wr * 64 + fr, col0 = u.pn * BM + wc * 32 + 8 * fq, lc0 = u.slot * BM + wc * 32 + 8 * fq;
        f32x2 sq[2][4]; float isq[2][4];
#pragma unroll
        for (int ai = 0; ai < 2; ++ai)
#pragma unroll
            for (int m = 0; m < 4; ++m) { sq[ai][m] = (f32x2){0.f, 0.f}; isq[ai][m] = XQ8 ? tis[u.slot * BM + wr * 64 + fr + ai * HALF + m * 16] : 0.f; }
#pragma unroll
        for (int bj = 0; bj < 2; ++bj) {
            const int col = col0 + bj * HALF, lc = lc0 + bj * HALF;
            const f32x4 g0 = *(const PG8_LAS f32x4*)(tgs + lc), g1 = *(const PG8_LAS f32x4*)(tgs + lc + 4);
            f32x4 G0 = (f32x4){0.f, 0.f, 0.f, 0.f}, G1 = G0, hc0 = G0, hc1 = G0;
            if (I8) { hc0 = *(const PG8_LAS f32x4*)((const PG8_LAS float*)thc + lc); hc1 = *(const PG8_LAS f32x4*)((const PG8_LAS float*)thc + lc + 4); }
            if (xg) { G0 = *(const PG8_LAS f32x4*)(tG + lc); G1 = *(const PG8_LAS f32x4*)(tG + lc + 4); }
#pragma unroll
            for (int ai = 0; ai < 2; ++ai)
#pragma unroll
                for (int m = 0; m < 4; ++m) { const int row = row0 + ai * HALF + m * 16; const size_t off = (size_t)row * 1024 + col;
                    f32x4 x0, x1;
                    if (XI32) { x0 = *(const f32x4*)((const float*)xi + off); x1 = *(const f32x4*)((const float*)xi + off + 4); }
                    else { const u32x4 xv = *(const u32x4*)((const bf16_t*)xi + off);
                        x0 = (f32x4){__uint_as_float(xv.x << 16), __uint_as_float(xv.x & 0xffff0000u), __uint_as_float(xv.y << 16), __uint_as_float(xv.y & 0xffff0000u)};
                        x1 = (f32x4){__uint_as_float(xv.z << 16), __uint_as_float(xv.z & 0xffff0000u), __uint_as_float(xv.w << 16), __uint_as_float(xv.w & 0xffff0000u)}; }
                    f32x4 a0 = acc[ai][bj][m][0], a1 = acc[ai][bj][m][1];
                    if (I8) { a0 = __builtin_convertvector(__builtin_bit_cast(i32x4, a0), f32x4); a1 = __builtin_convertvector(__builtin_bit_cast(i32x4, a1), f32x4); x0 = x0 + hc0; x1 = x1 + hc1; }
                    const f32x4 y0 = x0 + g0 * a0, y1 = x1 + g1 * a1;
                    if (XO32) { *(f32x4*)((float*)xo + off) = y0; *(f32x4*)((float*)xo + off + 4) = y1; }
                    else { u32x4 w; w.x = cvt_pk_bf16(y0[0], y0[1]); w.y = cvt_pk_bf16(y0[2], y0[3]); w.z = cvt_pk_bf16(y1[0], y1[1]); w.w = cvt_pk_bf16(y1[2], y1[3]); *(u32x4*)((bf16_t*)xo + off) = w; }
                    { const f32x2 ya = {y0[0], y0[1]}, yb = {y0[2], y0[3]}, yc = {y1[0], y1[1]}, yd = {y1[2], y1[3]}; sq[ai][m] = __builtin_elementwise_fma(ya, ya, sq[ai][m]); sq[ai][m] = __builtin_elementwise_fma(yb, yb, sq[ai][m]); sq[ai][m] = __builtin_elementwise_fma(yc, yc, sq[ai][m]); sq[ai][m] = __builtin_elementwise_fma(yd, yd, sq[ai][m]); }
                    if (xg) { f32x4 z0 = y0 * G0, z1 = y1 * G1;
                        if (XQ8) { const f32x2 is2 = {isq[ai][m], isq[ai][m]}, c128 = {128.0f, 128.0f};
                            { const f32x2 q0 = __builtin_elementwise_fma((f32x2){z0[0], z0[1]}, is2, c128), q1 = __builtin_elementwise_fma((f32x2){z0[2], z0[3]}, is2, c128), q2 = __builtin_elementwise_fma((f32x2){z1[0], z1[1]}, is2, c128), q3 = __builtin_elementwise_fma((f32x2){z1[2], z1[3]}, is2, c128);
                              z0 = (f32x4){q0[0], q0[1], q1[0], q1[1]}; z1 = (f32x4){q2[0], q2[1], q3[0], q3[1]}; }
                            unsigned w0 = 0u, w1 = 0u;
#pragma unroll
                            for (int j = 0; j < 4; ++j) { w0 = __builtin_amdgcn_cvt_pk_u8_f32(z0[j], j, w0); w1 = __builtin_amdgcn_cvt_pk_u8_f32(z1[j], j, w1); }
                            u32x2_t w; w.x = w0 ^ 0x80808080u; w.y = w1 ^ 0x80808080u;
                            *(u32x2_t*)((unsigned char*)xg + off) = w; }
                        else { u32x4 w; w.x = cvt_pk_bf16(z0[0], z0[1]); w.y = cvt_pk_bf16(z0[2], z0[3]); w.z = cvt_pk_bf16(z1[0], z1[1]); w.w = cvt_pk_bf16(z1[2], z1[3]);
                            *(u32x4*)(xg + off) = w; } } }
        }
        float s8[2][4];
#pragma unroll
        for (int ai = 0; ai < 2; ++ai)
#pragma unroll
            for (int m = 0; m < 4; ++m) { float s = sq[ai][m][0] + sq[ai][m][1]; s += __shfl_xor(s, 16); s += __shfl_xor(s, 32); s8[ai][m] = s; }
#pragma unroll
        for (int ai = 0; ai < 2; ++ai) { const float v = fq == 0 ? s8[ai][0] : fq == 1 ? s8[ai][1] : fq == 2 ? s8[ai][2] : s8[ai][3];
            ssq[(size_t)(row0 + ai * HALF + fq * 16) * 16 + u.pn * 4 + wc] = v; }
    }
};
struct EpiNull {
    static constexpr bool PERM = true, AFTER_DRAIN = false, I8 = false, P16 = false;
    float* sink;
    __device__ __forceinline__ void operator()(const f32x4 (&acc)[2][2][4][2], const Unit& u, int wr, int wc, int fr, int fq) const {
        float s = 0.f;
#pragma unroll
        for (int ai = 0; ai < 2; ++ai)
#pragma unroll
            for (int bj = 0; bj < 2; ++bj)
#pragma unroll
                for (int m = 0; m < 4; ++m)
#pragma unroll
                    for (int n = 0; n < 2; ++n) s += acc[ai][bj][m][n][0] + acc[ai][bj][m][n][1] + acc[ai][bj][m][n][2] + acc[ai][bj][m][n][3];
        if (s == 123.456f) sink[0] = s;
    }
};
struct NoPre { __device__ __forceinline__ void operator()() const {} };
template <class Epi, class Sched, bool ALIGN_EPI = false, bool SP2 = false, class Pre = NoPre>
__device__ __forceinline__ void gemm_phase(PG8_LAS unsigned char* lds, const Gemm g, const Sched& S, const Epi& E, const Pre& pre = Pre()) {
    int tid_ = threadIdx.x; asm volatile("" : "+v"(tid_));
    const int tid = tid_, wid = __builtin_amdgcn_readfirstlane(tid >> 6), lane = tid & 63, wr = wid >> 2, wc = wid & 3, fr = lane & 15, fq = lane >> 4;
    const int K = g.K, nt = K / BK;
    unsigned voffA[2], voffB[2];
#pragma unroll
    for (int i = 0; i < 2; ++i) { int R, C; stage_rc(tid * 16 + i * 8192, R, C); const int Rb = Epi::P16 ? ((R >> 5) * 64 + 16 * ((R >> 2) & 3) + 4 * ((R >> 4) & 1) + (R & 3)) : Epi::PERM ? ((R & ~31) + perm32(R & 31)) : R;
        voffA[i] = (unsigned)(R * g.lda + C) * 2u; voffB[i] = (unsigned)(Rb * g.ldb + C) * 2u; }
    const size_t kstep = (size_t)(BK * 2);
    const size_t hstepA = (size_t)HALF * g.lda * 2, tstepA = 2 * hstepA;
    const size_t tstepB = (size_t)2 * HALF * g.ldb * 2, hstepB = Epi::P16 ? (size_t)8 * g.ldb * 2 : (size_t)HALF * g.ldb * 2;
    const unsigned ldsw = (unsigned)wid * 1024u;
    const int aoff = lds_byte(wr * 64 + fr, fq * 8), boff = lds_byte(wc * 32 + fr, fq * 8);
#define PG8_SA(b, h) (((b) * 2 + (h)) * HTB)
#define PG8_SB(b, h) ((4 + (b) * 2 + (h)) * HTB)
#define PG8_STAGE(bufoff, gbase, voff) do { _Pragma("unroll") for (int _i = 0; _i < 2; ++_i) \
        __builtin_amdgcn_global_load_lds((const unsigned*)((const char*)(gbase) + (voff)[_i]), (PG8_LAS unsigned*)(lds + (bufoff) + ldsw + _i * 8192), 16, 0, 0); } while (0)
#define PG8_LDA(dst, b, h) do { _Pragma("unroll") for (int m = 0; m < 4; ++m) _Pragma("unroll") for (int k = 0; k < 2; ++k) dst[m][k] = *(const PG8_LAS bf16x8*)(lds + PG8_SA(b, h) + aoff + m * 2048 + k * 1024); } while (0)
#define PG8_LDB(dst, b, h) do { _Pragma("unroll") for (int n = 0; n < 2; ++n) _Pragma("unroll") for (int k = 0; k < 2; ++k) dst[n][k] = *(const PG8_LAS bf16x8*)(lds + PG8_SB(b, h) + boff + n * 2048 + k * 1024); } while (0)
#define PG8_MMA(ai, bj, At, Bt) do { __builtin_amdgcn_s_setprio(1); _Pragma("unroll") for (int m = 0; m < 4; ++m) _Pragma("unroll") for (int n = 0; n < 2; ++n) _Pragma("unroll") for (int k = 0; k < 2; ++k) \
        { if constexpr (Epi::I8) acc[ai][bj][m][n] = __builtin_bit_cast(f32x4, __builtin_amdgcn_mfma_i32_16x16x64_i8(__builtin_bit_cast(i32x4, Bt[n][k]), __builtin_bit_cast(i32x4, At[m][k]), __builtin_bit_cast(i32x4, acc[ai][bj][m][n]), 0, 0, 0)); \
          else acc[ai][bj][m][n] = __builtin_amdgcn_mfma_f32_16x16x32_bf16(Bt[n][k], At[m][k], acc[ai][bj][m][n], 0, 0, 0); } __builtin_amdgcn_s_setprio(0); } while (0)
#define PG8_WAIT_V(n) asm volatile("s_waitcnt vmcnt(" #n ")" ::: "memory")
#define PG8_WAIT_L(n) asm volatile("s_waitcnt lgkmcnt(" #n ")" ::: "memory")
#define PG8_BAR __builtin_amdgcn_s_barrier()
#define PG8_SCHED __builtin_amdgcn_sched_barrier(0)
    Unit cur, nxt; int ui = 0;
    if (!S.next(0, cur)) return;
    f32x4 acc[2][2][4][2];
#pragma unroll
    for (int a = 0; a < 2; ++a)
#pragma unroll
        for (int b = 0; b < 2; ++b)
#pragma unroll
            for (int m = 0; m < 4; ++m)
#pragma unroll
                for (int n = 0; n < 2; ++n) acc[a][b][m][n] = (f32x4){0.f, 0.f, 0.f, 0.f};
    bf16x8 At[4][2], B0[2][2], B1[2][2];
    const char* cA = (const char*)g.A + (size_t)cur.pm * tstepA; const char* cB = (const char*)g.Bt + (size_t)cur.pn * tstepB;
    S.a_ready(cur);
    if constexpr (SP2) {
        PG8_STAGE(PG8_SB(0, 0), cB, voffB); PG8_STAGE(PG8_SB(0, 1), cB + hstepB, voffB); PG8_STAGE(PG8_SA(0, 0), cA, voffA); PG8_STAGE(PG8_SA(0, 1), cA + hstepA, voffA);
        pre();
        if (wr == 1) PG8_BAR;
        PG8_WAIT_V(2); PG8_BAR;
        PG8_STAGE(PG8_SB(1, 0), cB + kstep, voffB); PG8_STAGE(PG8_SA(1, 0), cA + kstep, voffA); PG8_STAGE(PG8_SB(1, 1), cB + hstepB + kstep, voffB);
        PG8_WAIT_V(6); PG8_BAR;
    } else {
        PG8_STAGE(PG8_SB(0, 0), cB, voffB); PG8_STAGE(PG8_SA(0, 0), cA, voffA); PG8_STAGE(PG8_SB(0, 1), cB + hstepB, voffB); PG8_STAGE(PG8_SA(0, 1), cA + hstepA, voffA);
        if (wr == 1) PG8_BAR;
        PG8_WAIT_V(4); PG8_BAR;
        PG8_STAGE(PG8_SB(1, 0), cB + kstep, voffB); PG8_STAGE(PG8_SA(1, 0), cA + kstep, voffA); PG8_STAGE(PG8_SB(1, 1), cB + hstepB + kstep, voffB);
        PG8_WAIT_V(6); PG8_BAR;
    }
    for (;;) {
        const bool has_next = S.next(ui + 1, nxt);
        const char* nA = has_next ? (const char*)g.A + (size_t)nxt.pm * tstepA : cA; const char* nB = has_next ? (const char*)g.Bt + (size_t)nxt.pn * tstepB : cB;
        for (int t = 0; t < nt; t += 2) {
            const bool last = (t == nt - 2);
            const char* a1 = cA + (size_t)(t + 1) * kstep;
            const char* a2 = last ? nA : cA + (size_t)(t + 2) * kstep; const char* b2 = last ? nB : cB + (size_t)(t + 2) * kstep;
            const char* a3 = a2 + kstep; const char* b3 = b2 + kstep;
            if (last && has_next) S.a_ready(nxt);
            if constexpr (SP2) {
            PG8_LDB(B0, 0, 0); PG8_LDB(B1, 0, 1); PG8_SCHED; PG8_LDA(At, 0, 0); PG8_STAGE(PG8_SA(1, 1), a1 + hstepA, voffA);
            PG8_WAIT_V(8); PG8_WAIT_L(0); PG8_BAR; PG8_MMA(0, 0, At, B0); PG8_MMA(0, 1, At, B1); PG8_BAR; PG8_SCHED;
            PG8_LDA(At, 0, 1); PG8_STAGE(PG8_SB(0, 0), b2, voffB); PG8_STAGE(PG8_SB(0, 1), b2 + hstepB, voffB); PG8_STAGE(PG8_SA(0, 0), a2, voffA);
            PG8_WAIT_V(8); PG8_WAIT_L(0); PG8_BAR; PG8_MMA(1, 0, At, B0); PG8_MMA(1, 1, At, B1); PG8_BAR; PG8_SCHED;
            PG8_LDB(B0, 1, 0); PG8_LDB(B1, 1, 1); PG8_SCHED; PG8_LDA(At, 1, 0); PG8_STAGE(PG8_SA(0, 1), a2 + hstepA, voffA);
            PG8_WAIT_V(8); PG8_WAIT_L(0); PG8_BAR; PG8_MMA(0, 0, At, B0); PG8_MMA(0, 1, At, B1); PG8_BAR; PG8_SCHED;
            PG8_LDA(At, 1, 1); PG8_STAGE(PG8_SB(1, 0), b3, voffB); PG8_STAGE(PG8_SB(1, 1), b3 + hstepB, voffB); PG8_STAGE(PG8_SA(1, 0), a3, voffA);
            PG8_WAIT_V(8); PG8_WAIT_L(0); PG8_BAR; PG8_MMA(1, 0, At, B0); PG8_MMA(1, 1, At, B1); PG8_BAR; PG8_SCHED;
            } else {
            PG8_LDB(B0, 0, 0); PG8_SCHED; PG8_LDA(At, 0, 0); PG8_STAGE(PG8_SA(1, 1), a1 + hstepA, voffA);
            PG8_WAIT_L(8); PG8_BAR; PG8_WAIT_L(0); PG8_MMA(0, 0, At, B0); PG8_BAR; PG8_SCHED;
            PG8_LDB(B1, 0, 1); PG8_STAGE(PG8_SB(0, 0), b2, voffB);
            PG8_BAR; PG8_WAIT_L(0); PG8_MMA(0, 1, At, B1); PG8_BAR;
            PG8_LDA(At, 0, 1); PG8_STAGE(PG8_SA(0, 0), a2, voffA);
            PG8_BAR; PG8_WAIT_L(0); PG8_MMA(1, 0, At, B0); PG8_BAR; PG8_SCHED;
            PG8_STAGE(PG8_SB(0, 1), b2 + hstepB, voffB);
            PG8_WAIT_V(6); PG8_BAR; PG8_MMA(1, 1, At, B1); PG8_BAR;
            PG8_LDB(B0, 1, 0); PG8_SCHED; PG8_LDA(At, 1, 0); PG8_STAGE(PG8_SA(0, 1), a2 + hstepA, voffA);
            PG8_WAIT_L(8); PG8_BAR; PG8_WAIT_L(0); PG8_MMA(0, 0, At, B0); PG8_BAR; PG8_SCHED;
            PG8_LDB(B1, 1, 1); PG8_STAGE(PG8_SB(1, 0), b3, voffB);
            PG8_BAR; PG8_WAIT_L(0); PG8_MMA(0, 1, At, B1); PG8_BAR;
            PG8_LDA(At, 1, 1); PG8_STAGE(PG8_SA(1, 0), a3, voffA);
            PG8_BAR; PG8_WAIT_L(0); PG8_MMA(1, 0, At, B0); PG8_BAR; PG8_SCHED;
            PG8_STAGE(PG8_SB(1, 1), b3 + hstepB, voffB);
            PG8_WAIT_V(6); PG8_BAR; PG8_MMA(1, 1, At, B1); PG8_BAR;
            }
        }
        if constexpr (ALIGN_EPI) { if (wr == 0) PG8_BAR; }
        if constexpr (!Epi::AFTER_DRAIN) { E(acc, cur, wr, wc, fr, fq); S.done(cur); }
        if (!has_next) break;
#pragma unroll
        for (int a = 0; a < 2; ++a)
#pragma unroll
            for (int b = 0; b < 2; ++b)
#pragma unroll
                for (int m = 0; m < 4; ++m)
#pragma unroll
                    for (int n = 0; n < 2; ++n) acc[a][b][m][n] = (f32x4){0.f, 0.f, 0.f, 0.f};
        cur = nxt; cA = nA; cB = nB; ++ui;
        if constexpr (ALIGN_EPI) { if (wr == 1) PG8_BAR; }
    }
    PG8_WAIT_V(0);
    if constexpr (!ALIGN_EPI) { if (wr == 0) PG8_BAR; }
    PG8_BAR;
    if constexpr (Epi::AFTER_DRAIN) { E.fused(acc, cur, wr, wc, fr, fq, lds, wid, lane); S.done(cur); }
#undef PG8_SA
#undef PG8_SB
#undef PG8_STAGE
#undef PG8_LDA
#undef PG8_LDB
#undef PG8_MMA
#undef PG8_WAIT_V
#undef PG8_WAIT_L
#undef PG8_BAR
#undef PG8_SCHED
}
}
constexpr int NB = 16, SEQ = 2048, D = 1024, DEPTH = 4, M = NB * SEQ, PIN = 2568, NP = 2560, FF = 4096, NMOD = 6144;
constexpr int NWAVES = 8, NTHR = 512;
constexpr float EPS = 1e-6f;
constexpr int PC_QA = 0, PC_KA = 256, PC_VA = 512, PC_GATE = 768, PC_UB = 1024, PC_VB = 1280, PC_XC = 1536, PC_QD = 1792, PC_KD = 2048, PC_VD = 2304;
constexpr int YC_A = 0, YC_B = 256, YC_C = 512, YC_D = 768;
enum { I_X = 0, I_C, I_WMOD, I_BMOD, I_GN1, I_GN2, I_WIN, I_CONV, I_ALOG, I_DTB, I_GOA, I_GLNB, I_WSG, I_BSG, I_WPOOL, I_SPOOL, I_GOD, I_WOUT, I_WFF1, I_WFF2, I_GFIN, N_IN };

constexpr size_t MiB = 1u << 20;
constexpr size_t WS_CTL = 0, CTL_ZERO_BYTES = 1 * MiB;
constexpr size_t WS_MOD = 1 * MiB;
constexpr size_t WS_SW1 = 3 * MiB;
constexpr size_t WS_SWAB = 3 * MiB + 768 * 1024;
constexpr size_t WS_SW2 = 4 * MiB;
constexpr size_t WS_WAB = 5 * MiB;
constexpr size_t WS_WSG = 5 * MiB + 256 * 1024;
constexpr size_t WS_WPT = 5 * MiB + 768 * 1024;
constexpr size_t WS_QSA = 7 * MiB + 256 * 1024;
constexpr size_t WS_QSA1 = 7 * MiB + 512 * 1024;
constexpr size_t WS_QSB1 = 7 * MiB + 768 * 1024;
constexpr size_t WS_QSB2 = 7 * MiB + 896 * 1024;
constexpr size_t WS_QCS2 = 7 * MiB + 928 * 1024;
constexpr size_t WS_QSBO = 7 * MiB + 960 * 1024;
constexpr size_t WS_ZERO = 512 * 1024;
constexpr size_t WS_QSB = 7 * MiB;
constexpr size_t WS_ABLOG = 6 * MiB;
constexpr size_t WS_SSQ1 = 8 * MiB, WS_SSQ2 = 10 * MiB;
constexpr size_t WS_BETA = 12 * MiB, WS_GLOG = 13 * MiB;
constexpr size_t WS_WIN = 16 * MiB;
constexpr size_t WS_WOUT = 36 * MiB;
constexpr size_t WS_WFF1 = 44 * MiB;
constexpr size_t WS_WFF2 = 76 * MiB;
constexpr size_t WS_XQ = 144 * MiB;
constexpr size_t WS_XG = 112 * MiB;
constexpr size_t WS_HID = 176 * MiB;
constexpr size_t WS_P = 176 * MiB;
constexpr size_t WS_Y = 336 * MiB;
constexpr size_t WS_CHA = 112 * MiB, WS_CHB = 400 * MiB;
constexpr size_t WS_XB = 448 * MiB;
constexpr size_t WS_END = 512 * MiB;
constexpr int CW_BAR = 4096;
constexpr int CW_XRANK = 24576;
constexpr int CW_DNCNT = 16384;

constexpr int RING_BYTES = 131072, LDS_BYTES = 163840, MISC_OFF = LDS_BYTES - 256;

#define LAS __attribute__((address_space(3)))
typedef unsigned short bf16;
typedef float f32x4 __attribute__((ext_vector_type(4)));
typedef unsigned u32x4 __attribute__((ext_vector_type(4)));
typedef unsigned u32x2 __attribute__((ext_vector_type(2)));
__device__ __forceinline__ float bf2f(unsigned v) { return __uint_as_float(v << 16); }
__device__ __forceinline__ unsigned f2bf(float f) { unsigned u = __float_as_uint(f); return (u + 0x7fffu + ((u >> 16) & 1u)) >> 16; }
__device__ __forceinline__ unsigned pk2(float lo, float hi) { return f2bf(lo) | (f2bf(hi) << 16); }
__device__ __forceinline__ float wave_sum(float v) {
#pragma unroll
    for (int o = 1; o < 64; o <<= 1) v += __shfl_xor(v, o);
    return v;
}
__device__ __forceinline__ float rdlane(float v, int l) { return __builtin_bit_cast(float, __builtin_amdgcn_readlane(__builtin_bit_cast(int, v), l)); }
__device__ __forceinline__ float silu_f(float x) { return x * __builtin_amdgcn_rcpf(1.0f + __expf(-x)); }
__device__ __forceinline__ float sigmoid_f(float x) { return __builtin_amdgcn_rcpf(1.0f + __expf(-x)); }
__device__ __forceinline__ float softplus_f(float x) { return fmaxf(x, 0.f) + __logf(1.0f + __expf(-fabsf(x))); }
#define GAS __attribute__((address_space(1)))
template <class T> __device__ __forceinline__ T* as_global(T* p) { return p; }
constexpr float YCLIP8 = 8.0f;
__device__ __forceinline__ unsigned q8x4(float a, float b, float c, float d) {
    constexpr float k = 127.0f / YCLIP8; unsigned w = 0u;
    w = __builtin_amdgcn_cvt_pk_u8_f32(__builtin_fmaf(a, k, 128.0f), 0, w); w = __builtin_amdgcn_cvt_pk_u8_f32(__builtin_fmaf(b, k, 128.0f), 1, w);
    w = __builtin_amdgcn_cvt_pk_u8_f32(__builtin_fmaf(c, k, 128.0f), 2, w); w = __builtin_amdgcn_cvt_pk_u8_f32(__builtin_fmaf(d, k, 128.0f), 3, w);
    return w ^ 0x80808080u; }
template <class T> __device__ __forceinline__ T* uni_ptr(T* p) { const unsigned long long v = (unsigned long long)p; const unsigned lo = __builtin_amdgcn_readfirstlane((unsigned)v), hi = __builtin_amdgcn_readfirstlane((unsigned)(v >> 32)); return as_global((T*)(((unsigned long long)hi << 32) | lo)); }
#define XB_TMO      128
#define XB_XCNT(j)  (256  + 64 * (j))
#define XB_XSUB(j)  (1280 + 64 * (j))
#define XB_XGEN(j)  (2304 + 64 * (j))
#define XB_TOP      3328
#define XB_TOPGEN   3392
#define XCD_BAR_WORDS 3456
#define XB_SPIN_CAP (1u << 18)

__device__ __forceinline__ unsigned xb_ld(unsigned* p)              { return __hip_atomic_load(p, __ATOMIC_RELAXED, __HIP_MEMORY_SCOPE_AGENT); }
__device__ __forceinline__ unsigned xb_add(unsigned* p, unsigned v) { return __hip_atomic_fetch_add(p, v, __ATOMIC_RELAXED, __HIP_MEMORY_SCOPE_AGENT); }
__device__ __forceinline__ unsigned xb_xcc_id() { return (unsigned)__builtin_amdgcn_s_getreg((3 << 11) | 20) & 0xFu; }
#define XB_SPIN(cond, bar) do { unsigned _sp = 0; while (cond) { __builtin_amdgcn_s_sleep(1); \
    if ((++_sp & 255u) == 0u) { if (xb_ld(&(bar)[XB_TMO])) break; if (_sp > XB_SPIN_CAP) { atomicAdd(&(bar)[XB_TMO], 1u); break; } } } } while (0)

struct XcdBarrier {
    unsigned* bar; unsigned x;
    volatile LAS unsigned* st;
};

__device__ __forceinline__ XcdBarrier xcd_barrier_post(unsigned* bar, volatile LAS unsigned* st) {
    XcdBarrier b; b.bar = bar; b.x = xb_xcc_id(); b.st = st;
    if (threadIdx.x == 0) (void)xb_add(&bar[XB_XCNT(b.x)], 1u);
    return b;
}
__device__ __forceinline__ void xcd_barrier_complete(unsigned* bar, unsigned x, unsigned& nloc, unsigned& nx) {
    const unsigned G = gridDim.x * gridDim.y * gridDim.z;
    unsigned sum, cnt, mine, sp = 0u;
    for (;;) {
        sum = 0u; cnt = 0u; mine = 0u;
#pragma unroll
        for (unsigned j = 0; j < 16; ++j) { const unsigned c = xb_ld(&bar[XB_XCNT(j)]); sum += c; cnt += (c > 0u) ? 1u : 0u; mine = (j == x) ? c : mine; }
        if (sum == G) break;
        __builtin_amdgcn_s_sleep(1);
        if ((++sp & 255u) == 0u) { if (xb_ld(&bar[XB_TMO])) break; if (sp > XB_SPIN_CAP) { atomicAdd(&bar[XB_TMO], 1u); break; } }
    }
    nloc = mine > 0u ? mine : 1u; nx = cnt > 0u ? cnt : 1u;
}

__device__ __forceinline__ void xcd_barrier(const XcdBarrier& b) {
    asm volatile("s_waitcnt vmcnt(0)" ::: "memory");
    __syncthreads();
    if (threadIdx.x == 0) {
        unsigned* bar = b.bar;
        __builtin_amdgcn_s_waitcnt(0);
        unsigned nloc = b.st[0], nx = b.st[1];
        if (nloc == 0u) { xcd_barrier_complete(bar, b.x, nloc, nx); b.st[0] = nloc; b.st[1] = nx; }
        const unsigned old = xb_add(&bar[XB_XSUB(b.x)], 1u);
        const unsigned gen = old / nloc;
        if (old + 1u == (gen + 1u) * nloc) {
            __builtin_amdgcn_fence(__ATOMIC_RELEASE, "agent");
            asm volatile("s_waitcnt vmcnt(0)" ::: "memory");
            const unsigned og = xb_add(&bar[XB_TOP], 1u);
            const unsigned tg = og / nx;
            if (og + 1u == (tg + 1u) * nx) xb_add(&bar[XB_TOPGEN], 1u);
            else XB_SPIN(xb_ld(&bar[XB_TOPGEN]) == tg, bar);
            __builtin_amdgcn_fence(__ATOMIC_ACQUIRE, "agent");
            xb_add(&bar[XB_XGEN(b.x)], 1u);
            asm volatile("s_waitcnt vmcnt(0)" ::: "memory");
        } else {
            XB_SPIN(xb_ld(&bar[XB_XGEN(b.x)]) == gen, bar);
            __builtin_amdgcn_fence(__ATOMIC_ACQUIRE, "agent");
            asm volatile("s_waitcnt vmcnt(0)" ::: "memory");
        }
    }
    __syncthreads();
}
struct Frame {
    LAS unsigned char* lds;
    int tid, lane, wave, G, bid;
    unsigned char* ws;
    const float* const* in;
    float* out;
};
#define WSP(T, off) (as_global((T*)(F.ws + (off))))
#define GIN(i) (as_global(F.in[i]))

template <class Writer>
__device__ __forceinline__ void gemm16_unit(Frame& F, const float* W, int ldw, int N, int n0, LAS float* lhsT, LAS float* red, const Writer& wr) {
    const int n = n0 + F.lane; const bool ok = n < N;
    float acc[16];
#pragma unroll
    for (int b = 0; b < 16; ++b) acc[b] = 0.f;
    const int kbeg = F.wave * 128;
    const float* wp = W + (size_t)kbeg * ldw + (ok ? n : 0);
    for (int k0 = 0; k0 < 128; k0 += 32) {
        float wv[32];
#pragma unroll
        for (int j = 0; j < 32; ++j) wv[j] = ok ? wp[(size_t)(k0 + j) * ldw] : 0.f;
#pragma unroll
        for (int j = 0; j < 32; ++j) { const float w = wv[j];
            const LAS f32x4* lp = (const LAS f32x4*)(lhsT + (kbeg + k0 + j) * 16);
            const f32x4 l0 = lp[0], l1 = lp[1], l2 = lp[2], l3 = lp[3];
            acc[0] += l0[0] * w; acc[1] += l0[1] * w; acc[2] += l0[2] * w; acc[3] += l0[3] * w;
            acc[4] += l1[0] * w; acc[5] += l1[1] * w; acc[6] += l1[2] * w; acc[7] += l1[3] * w;
            acc[8] += l2[0] * w; acc[9] += l2[1] * w; acc[10] += l2[2] * w; acc[11] += l2[3] * w;
            acc[12] += l3[0] * w; acc[13] += l3[1] * w; acc[14] += l3[2] * w; acc[15] += l3[3] * w;
            if ((j & 7) == 7) asm volatile("" ::: "memory"); }
    }
#pragma unroll
    for (int b = 0; b < 16; ++b) red[(F.wave * 16 + b) * 64 + F.lane] = acc[b];
    __syncthreads();
    for (int o_ = F.tid; o_ < 1024; o_ += NTHR) { int o = o_; asm volatile("" : "+v"(o)); const int b = o >> 6, nn = o & 63; float s = 0.f;
#pragma unroll
        for (int w = 0; w < 8; ++w) s += red[(w * 16 + b) * 64 + nn];
        if (n0 + nn < N) wr(b, n0 + nn, s); }
    __syncthreads();
}

__device__ __forceinline__ void transpose_item(const float* W, int ldw, int csrc, int k0, bf16* WT, int Kd, int rdst, LAS float* scr, int lane) {
    float tv[32];
#pragma unroll
    for (int i = 0; i < 32; ++i) tv[i] = W[(size_t)(k0 + 2 * i + (lane >> 5)) * ldw + csrc + (lane & 31)];
#pragma unroll
    for (int i = 0; i < 32; ++i) scr[(2 * i + (lane >> 5)) * 33 + (lane & 31)] = tv[i];
    asm volatile("s_waitcnt lgkmcnt(0)" ::: "memory");
    const int c = lane & 7;
#pragma unroll
    for (int j = 0; j < 4; ++j) { const int n = (lane >> 3) + 8 * j; const LAS float* s = scr + (8 * c) * 33 + n;
        u32x4 o; o.x = pk2(s[0 * 33], s[1 * 33]); o.y = pk2(s[2 * 33], s[3 * 33]); o.z = pk2(s[4 * 33], s[5 * 33]); o.w = pk2(s[6 * 33], s[7 * 33]);
        *(u32x4*)(WT + (size_t)(rdst + n) * Kd + k0 + 8 * c) = o; }
    asm volatile("s_waitcnt lgkmcnt(0)" ::: "memory");
}

__device__ __forceinline__ void p0a(Frame& F) {
    LAS float* lhsT = (LAS float*)F.lds; LAS float* red = (LAS float*)(F.lds + 65536);
    const float* c = GIN(I_C);
    float* mod = WSP(float, WS_MOD);
    bool filled = false;
    for (int u = F.bid; u < DEPTH * 96; u += F.G) {
        if (!filled) { for (int i = F.tid; i < 16384; i += NTHR) { const int b = i >> 10, k = i & 1023; lhsT[k * 16 + b] = silu_f(c[i]); } __syncthreads(); filled = true; }
        const int l = u / 96, n0 = (u % 96) * 64;
        const float* bm = GIN(I_BMOD) + (size_t)l * NMOD; float* mo = mod + (size_t)l * 16 * NMOD;
        gemm16_unit(F, GIN(I_WMOD) + (size_t)l * D * NMOD, NMOD, NMOD, n0, lhsT, red, [=](int b, int n, float s) { mo[(size_t)b * NMOD + n] = s + bm[n]; });
    }
    __syncthreads();
    LAS float* scr = (LAS float*)(F.lds + F.wave * 8448);
    const int gw = F.bid * NWAVES + F.wave, NGW = F.G * NWAVES;
    constexpr int IT_IN = 16 * 80, IT_OUT = 16 * 32, IT_F1 = 16 * 128, IT_F2 = 64 * 32, IT_L = IT_IN + IT_OUT + IT_F1 + IT_F2;
    for (int it = gw; it < DEPTH * IT_L; it += NGW) {
        const int l = it / IT_L; int r = it % IT_L;
        if (r < IT_IN) { const int kb = r / 80, nb = r % 80, n0 = nb * 32; transpose_item(GIN(I_WIN) + (size_t)l * D * PIN, PIN, n0 < 768 ? n0 : n0 + 8, kb * 64, WSP(bf16, WS_WIN) + (size_t)l * NP * D, D, n0, scr, F.lane); continue; }
        r -= IT_IN;
        if (r < IT_OUT) { const int kb = r / 32, nb = r % 32; transpose_item(GIN(I_WOUT) + (size_t)l * D * D, D, nb * 32, kb * 64, WSP(bf16, WS_WOUT) + (size_t)l * D * D, D, nb * 32, scr, F.lane); continue; }
        r -= IT_OUT;
        if (r < IT_F1) { const int kb = r / 128, nb = r % 128; transpose_item(GIN(I_WFF1) + (size_t)l * D * FF, FF, nb * 32, kb * 64, WSP(bf16, WS_WFF1) + (size_t)l * FF * D, D, nb * 32, scr, F.lane); continue; }
        r -= IT_F1;
        { const int kb = r / 32, nb = r % 32; transpose_item(GIN(I_WFF2) + (size_t)l * FF * D, D, nb * 32, kb * 64, WSP(bf16, WS_WFF2) + (size_t)l * D * FF, FF, nb * 32, scr, F.lane); }
    }
    { bf16* wsgb = WSP(bf16, WS_WSG); const float* wsg = GIN(I_WSG);
      for (int i = F.bid * NTHR + F.tid; i < DEPTH * 4 * 128 * 128; i += F.G * NTHR) wsgb[i] = (bf16)f2bf(wsg[i]);
      bf16* wpt = WSP(bf16, WS_WPT); const float* wp = GIN(I_WPOOL);
      for (int i = F.bid * NTHR + F.tid; i < DEPTH * 4 * 64 * 64; i += F.G * NTHR) { const int lg = i >> 12, d = (i >> 6) & 63, c = i & 63; wpt[i] = (bf16)f2bf(wp[(lg * 64 + c) * 64 + d]); } }
    bf16* wab = WSP(bf16, WS_WAB);
    for (int i = F.bid * NTHR + F.tid; i < DEPTH * 16 * D; i += F.G * NTHR) { const int l = i / (16 * D), j = (i / D) & 15, k = i % D;
        wab[i] = j < 8 ? (bf16)f2bf(GIN(I_WIN)[((size_t)l * D + k) * PIN + 768 + j]) : (bf16)0; }
}

__device__ __forceinline__ void p0b(Frame& F) {
    LAS float* lhsT = (LAS float*)F.lds; LAS float* red = (LAS float*)(F.lds + 65536);
    const float* mod = WSP(float, WS_MOD);
    for (int u = F.bid; u < DEPTH * 105; u += F.G) {
        const int l = u / 105, r = u % 105; const bool first = r < 41;
        const float* ml = mod + (size_t)l * 16 * NMOD + (first ? 0 : 3 * D);
        for (int i = F.tid; i < 16384; i += NTHR) { const int b = i >> 10, k = i & 1023; lhsT[k * 16 + b] = ml[(size_t)b * NMOD + k]; }
        __syncthreads();
        if (first) { float* sw1 = WSP(float, WS_SW1) + (size_t)l * 16 * NP; float* swab = WSP(float, WS_SWAB) + (size_t)l * 16 * 8;
            gemm16_unit(F, GIN(I_WIN) + (size_t)l * D * PIN, PIN, PIN, r * 64, lhsT, red, [=](int b, int n, float s) {
                if (n < 768) sw1[b * NP + n] = s; else if (n < 776) swab[b * 8 + (n - 768)] = s; else sw1[b * NP + n - 8] = s; }); }
        else { float* sw2 = WSP(float, WS_SW2) + (size_t)l * 16 * FF;
            gemm16_unit(F, GIN(I_WFF1) + (size_t)l * D * FF, FF, FF, (r - 41) * 64, lhsT, red, [=](int b, int n, float s) { sw2[b * FF + n] = s; }); }
    }
    { const int gw_ = F.bid * NWAVES + F.wave, NGW_ = F.G * NWAVES;
      constexpr int NR1 = DEPTH * FF, NR2 = DEPTH * NP, NR3 = DEPTH * 16, NR4 = DEPTH * D;
      for (int it = gw_; it < NR1 + NR2 + NR3 + NR4; it += NGW_) {
          bf16* wq; float* sc; int n;
          if (it >= NR1 + NR2 + NR3) { n = it - NR1 - NR2 - NR3; wq = WSP(bf16, WS_WOUT); sc = WSP(float, WS_QSBO); } else
          if (it < NR1) { n = it; wq = WSP(bf16, WS_WFF1); sc = WSP(float, WS_QSB); } else if (it < NR1 + NR2) { n = it - NR1; wq = WSP(bf16, WS_WIN); sc = WSP(float, WS_QSB1); } else { n = it - NR1 - NR2; wq = WSP(bf16, WS_WAB); sc = WSP(float, WS_QSB1) + 16384; }
          bf16* rowp = wq + (size_t)n * D + 16 * F.lane; u32x4 a = *(u32x4*)rowp, b = *(u32x4*)(rowp + 8);
          float v[16]; v[0] = bf2f(a.x & 0xffffu); v[1] = bf2f(a.x >> 16); v[2] = bf2f(a.y & 0xffffu); v[3] = bf2f(a.y >> 16); v[4] = bf2f(a.z & 0xffffu); v[5] = bf2f(a.z >> 16); v[6] = bf2f(a.w & 0xffffu); v[7] = bf2f(a.w >> 16);
          v[8] = bf2f(b.x & 0xffffu); v[9] = bf2f(b.x >> 16); v[10] = bf2f(b.y & 0xffffu); v[11] = bf2f(b.y >> 16); v[12] = bf2f(b.z & 0xffffu); v[13] = bf2f(b.z >> 16); v[14] = bf2f(b.w & 0xffffu); v[15] = bf2f(b.w >> 16);
          float mx = 0.f;
#pragma unroll
          for (int j = 0; j < 16; ++j) mx = fmaxf(mx, fabsf(v[j]));
#pragma unroll
          for (int o = 1; o < 64; o <<= 1) mx = fmaxf(mx, __shfl_xor(mx, o));
          const float sc_ = mx > 0.f ? mx * (1.0f / 127.0f) : 1.0f, is_ = 1.0f / sc_;
#pragma unroll
          for (int j = 0; j < 16; ++j) v[j] = __builtin_rintf(v[j] * is_);
          u32x4 oq;
          oq.x = ((unsigned)((int)v[0] & 255)) | ((unsigned)((int)v[1] & 255) << 8) | ((unsigned)((int)v[2] & 255) << 16) | ((unsigned)((int)v[3] & 255) << 24);
          oq.y = ((unsigned)((int)v[4] & 255)) | ((unsigned)((int)v[5] & 255) << 8) | ((unsigned)((int)v[6] & 255) << 16) | ((unsigned)((int)v[7] & 255) << 24);
          oq.z = ((unsigned)((int)v[8] & 255)) | ((unsigned)((int)v[9] & 255) << 8) | ((unsigned)((int)v[10] & 255) << 16) | ((unsigned)((int)v[11] & 255) << 24);
          oq.w = ((unsigned)((int)v[12] & 255)) | ((unsigned)((int)v[13] & 255) << 8) | ((unsigned)((int)v[14] & 255) << 16) | ((unsigned)((int)v[15] & 255) << 24);
          asm volatile("s_waitcnt vmcnt(0)" ::: "memory");
          *(u32x4*)((unsigned char*)(wq + (size_t)n * D) + 16 * F.lane) = oq; if (F.lane == 0) sc[n] = it >= NR1 + NR2 + NR3 ? sc_ * (YCLIP8 / 127.0f) : sc_; } }
    { const int gw_ = F.bid * NWAVES + F.wave, NGW_ = F.G * NWAVES; bf16* wq = WSP(bf16, WS_WFF2); float* sc2 = WSP(float, WS_QSB2); int* cs2 = WSP(int, WS_QCS2);
      for (int n = gw_; n < DEPTH * D; n += NGW_) { const u32x4* rp = (const u32x4*)(wq + (size_t)n * FF + 64 * F.lane); u32x4 in[8]; float mx = 0.f;
#pragma unroll
          for (int j = 0; j < 8; ++j) { in[j] = rp[j]; mx = fmaxf(mx, fmaxf(fmaxf(fmaxf(fabsf(bf2f(in[j].x & 0xffffu)), fabsf(bf2f(in[j].x >> 16))), fmaxf(fabsf(bf2f(in[j].y & 0xffffu)), fabsf(bf2f(in[j].y >> 16)))), fmaxf(fmaxf(fabsf(bf2f(in[j].z & 0xffffu)), fabsf(bf2f(in[j].z >> 16))), fmaxf(fabsf(bf2f(in[j].w & 0xffffu)), fabsf(bf2f(in[j].w >> 16)))))); }
#pragma unroll
          for (int o = 1; o < 64; o <<= 1) mx = fmaxf(mx, __shfl_xor(mx, o));
          const float sc_ = mx > 0.f ? mx * (1.0f / 127.0f) : 1.0f, is_ = 1.0f / sc_; int sum = 0; u32x4 oq[4];
#pragma unroll
          for (int j = 0; j < 8; ++j) { const int q0 = (int)__builtin_rintf(bf2f(in[j].x & 0xffffu) * is_), q1 = (int)__builtin_rintf(bf2f(in[j].x >> 16) * is_), q2 = (int)__builtin_rintf(bf2f(in[j].y & 0xffffu) * is_), q3 = (int)__builtin_rintf(bf2f(in[j].y >> 16) * is_);
              const int q4 = (int)__builtin_rintf(bf2f(in[j].z & 0xffffu) * is_), q5 = (int)__builtin_rintf(bf2f(in[j].z >> 16) * is_), q6 = (int)__builtin_rintf(bf2f(in[j].w & 0xffffu) * is_), q7 = (int)__builtin_rintf(bf2f(in[j].w >> 16) * is_);
              sum += ((q0 + q1) + (q2 + q3)) + ((q4 + q5) + (q6 + q7));
              const unsigned lo = (unsigned)(q0 & 255) | ((unsigned)(q1 & 255) << 8) | ((unsigned)(q2 & 255) << 16) | ((unsigned)(q3 & 255) << 24), hi = (unsigned)(q4 & 255) | ((unsigned)(q5 & 255) << 8) | ((unsigned)(q6 & 255) << 16) | ((unsigned)(q7 & 255) << 24);
              if (j & 1) { oq[j >> 1].z = lo; oq[j >> 1].w = hi; } else { oq[j >> 1].x = lo; oq[j >> 1].y = hi; } }
#pragma unroll
          for (int o = 1; o < 64; o <<= 1) sum += __shfl_xor(sum, o);
          asm volatile("s_waitcnt vmcnt(0)" ::: "memory");
          u32x4* op = (u32x4*)((unsigned char*)(wq + (size_t)n * FF) + 64 * F.lane);
#pragma unroll
          for (int j = 0; j < 4; ++j) op[j] = oq[j];
          if (F.lane == 0) { sc2[n] = sc_ * (pg8::HCLIP8 / 255.0f); cs2[n] = sum; } } }
    const int gw = F.bid * NWAVES + F.wave, NGW = F.G * NWAVES;
    const float* x = GIN(I_X); const float* gn = GIN(I_GN1); bf16* xg = WSP(bf16, WS_XG); float* ssq = WSP(float, WS_SSQ1);
    unsigned char* xq = WSP(unsigned char, WS_XG); float* qsa1 = WSP(float, WS_QSA1); bf16* xb0 = WSP(bf16, WS_XB);
    for (int r = gw; r < M; r += 2 * NGW) {
        const int r2 = r + NGW < M ? r + NGW : r;
        const f32x4* xa = (const f32x4*)(x + (size_t)r * D) + F.lane; const f32x4* xb = (const f32x4*)(x + (size_t)r2 * D) + F.lane; f32x4 va[4], vb[4];
#pragma unroll
        for (int j = 0; j < 4; ++j) { va[j] = xa[64 * j]; vb[j] = xb[64 * j]; }
        float sa = 0.f, sb = 0.f;
#pragma unroll
        for (int j = 0; j < 4; ++j) { sa += (va[j][0] * va[j][0] + va[j][1] * va[j][1]) + (va[j][2] * va[j][2] + va[j][3] * va[j][3]); sb += (vb[j][0] * vb[j][0] + vb[j][1] * vb[j][1]) + (vb[j][2] * vb[j][2] + vb[j][3] * vb[j][3]); }
        sa = wave_sum(sa); sb = wave_sum(sb);
        const float rra = __builtin_amdgcn_rsqf(sa * (1.0f / 1024.0f) + 1e-6f), rrb = __builtin_amdgcn_rsqf(sb * (1.0f / 1024.0f) + 1e-6f), isa = 127.0f * rra * (1.0f / pg8::QCLIP8), isb = 127.0f * rrb * (1.0f / pg8::QCLIP8);
        const float* sca = mod + (size_t)(r >> 11) * NMOD + D; const float* scb = mod + (size_t)(r2 >> 11) * NMOD + D;
#pragma unroll
        for (int j = 0; j < 4; ++j) { const int cc = 256 * j + 4 * F.lane; const f32x4 g = *(const f32x4*)(gn + cc), qa = *(const f32x4*)(sca + cc), qb = *(const f32x4*)(scb + cc);
            const f32x4 za = va[j] * (g * (qa + 1.0f)) * isa, zb = vb[j] * (g * (qb + 1.0f)) * isb; unsigned wa = 0u, wb = 0u;
#pragma unroll
            for (int i = 0; i < 4; ++i) { wa |= ((unsigned)((int)fminf(fmaxf(__builtin_rintf(za[i]), -127.f), 127.f) & 255)) << (8 * i); wb |= ((unsigned)((int)fminf(fmaxf(__builtin_rintf(zb[i]), -127.f), 127.f) & 255)) << (8 * i); }
            *(unsigned*)(xq + (size_t)r * D + cc) = wa; *(unsigned*)(xq + (size_t)r2 * D + cc) = wb;
            *(u32x2*)(xb0 + (size_t)r * D + cc) = (u32x2){pk2(va[j][0], va[j][1]), pk2(va[j][2], va[j][3])}; *(u32x2*)(xb0 + (size_t)r2 * D + cc) = (u32x2){pk2(vb[j][0], vb[j][1]), pk2(vb[j][2], vb[j][3])}; }
        if (F.lane < 16) { ssq[(size_t)r * 16 + F.lane] = F.lane == 0 ? sa : 0.f; ssq[(size_t)r2 * 16 + F.lane] = F.lane == 0 ? sb : 0.f; }
        if (F.lane == 0) { qsa1[r] = pg8::QCLIP8 / (127.0f * rra); qsa1[r2] = pg8::QCLIP8 / (127.0f * rrb); }
    }
}

__device__ __forceinline__ void ab_logits(Frame& F, int l) {
    typedef int i32x4_ __attribute__((ext_vector_type(4)));
    const int gw = F.bid * NWAVES + F.wave, NGW = F.G * NWAVES, n = F.lane & 15, kq = F.lane >> 4;
    const unsigned char* xq = WSP(unsigned char, WS_XG); const unsigned char* wab = (const unsigned char*)(WSP(bf16, WS_WAB) + (size_t)l * 16 * D); const float* ssq = WSP(float, WS_SSQ1);
    const float* swab = WSP(float, WS_SWAB) + (size_t)l * 16 * 8; float* ab = WSP(float, WS_ABLOG); const float* qsa1 = WSP(float, WS_QSA1); const float* qsbab = WSP(float, WS_QSB1) + 16384 + l * 16;
    for (int tile = gw; tile < M / 16; tile += NGW) { const int r0 = tile * 16;
        const unsigned char* ap = xq + (size_t)(r0 + n) * D + 16 * kq; const unsigned char* bp = wab + (size_t)n * (2 * D) + 16 * kq;
        i32x4_ acc0 = (i32x4_){0, 0, 0, 0}, acc1 = acc0;
        float rq[4];
#pragma unroll
        for (int i = 0; i < 4; ++i) { const int row = r0 + 4 * kq + i; rq[i] = pg8::row_rstd(ssq, row) * qsa1[row]; }
        i32x4_ af[16], bw[16];
#pragma unroll
        for (int ks = 0; ks < 16; ++ks) { af[ks] = *(const i32x4_*)(ap + 64 * ks); bw[ks] = *(const i32x4_*)(bp + 64 * ks); }
        asm volatile("" ::: "memory");
#pragma unroll
        for (int ks = 0; ks < 16; ks += 2) {
            acc0 = __builtin_amdgcn_mfma_i32_16x16x64_i8(af[ks], bw[ks], acc0, 0, 0, 0);
            acc1 = __builtin_amdgcn_mfma_i32_16x16x64_i8(af[ks + 1], bw[ks + 1], acc1, 0, 0, 0); }
        const i32x4_ acc = acc0 + acc1;
        if (n < 8) { const int b = r0 >> 11; const float sb_ = swab[b * 8 + n], wsc = qsbab[n];
#pragma unroll
            for (int i = 0; i < 4; ++i) { const int row = r0 + 4 * kq + i; ab[(size_t)row * 8 + n] = rq[i] * wsc * (float)acc[i] + sb_; } }
    }
}

__device__ __forceinline__ void sg_simple(Frame& F, int l, int unit) {
    const int b = unit >> 4, nblk = unit & 15; const size_t r0 = (size_t)b * SEQ + nblk * 128;
    const bf16* P = WSP(bf16, WS_P); bf16* Y = WSP(bf16, WS_Y); LAS float* vn = (LAS float*)F.lds;
    for (int pr = F.wave; pr < 512; pr += NWAVES) { const int tok = pr >> 2, h = pr & 3;
        const float v = bf2f(P[(r0 + tok) * NP + PC_VB + h * 64 + F.lane]);
        const float mu = wave_sum(v) * (1.0f / 64.0f), xc = v - mu, var = wave_sum(xc * xc) * (1.0f / 64.0f);
        vn[tok * 256 + h * 64 + F.lane] = xc * __builtin_amdgcn_rsqf(var + EPS) * GIN(I_GLNB)[l * 256 + h * 64 + F.lane]; }
    __syncthreads();
    const int c = F.tid & 255, h = __builtin_amdgcn_readfirstlane(c >> 6), half = __builtin_amdgcn_readfirstlane(F.tid >> 8);
    const float* wsg = GIN(I_WSG) + ((size_t)l * 4 + h) * 128 * 128; const float* bsg = GIN(I_BSG) + ((size_t)l * 4 + h) * 128;
    for (int t4 = 0; t4 < 16; ++t4) { const int t0 = half * 64 + t4 * 4; const int smax = half ? 128 : 64;
        float a0 = bsg[t0], a1 = bsg[t0 + 1], a2 = bsg[t0 + 2], a3 = bsg[t0 + 3];
        const float* w0 = wsg + (size_t)t0 * 128;
        for (int s = 0; s < smax; ++s) { const float v = vn[s * 256 + c]; a0 += w0[s] * v; a1 += w0[128 + s] * v; a2 += w0[256 + s] * v; a3 += w0[384 + s] * v; }
        const float av[4] = {a0, a1, a2, a3};
#pragma unroll
        for (int i = 0; i < 4; ++i) { const size_t r = r0 + t0 + i; Y[r * D + YC_B + c] = (bf16)f2bf(bf2f(P[r * NP + PC_UB + c]) * av[i]); } }
    __syncthreads();
}
__device__ __forceinline__ void pool_simple(Frame& F, int l, int unit) {
    const int b = unit >> 5, t0 = (unit & 31) * 64; const size_t r0 = (size_t)b * SEQ + t0;
    const bf16* P = WSP(bf16, WS_P); bf16* Y = WSP(bf16, WS_Y); LAS float* pl = (LAS float*)F.lds;
    const int c = F.tid & 255, g = __builtin_amdgcn_readfirstlane(c >> 6), half = __builtin_amdgcn_readfirstlane(F.tid >> 8);
    const int W = 2 << g;
    for (int tl = half * 32; tl < half * 32 + 32; ++tl) { const int t = t0 + tl; const int lo = (t + 1 - W) > 0 ? (t + 1 - W) : 0; float s = 0.f;
        for (int q = lo; q <= t; ++q) s += bf2f(P[((size_t)b * SEQ + q) * NP + PC_XC + c]);
        pl[tl * 256 + c] = s / (float)(t + 1 - lo) - bf2f(P[(r0 + tl) * NP + PC_XC + c]); }
    __syncthreads();
    const int d = c & 63; const float* wp = GIN(I_WPOOL) + ((size_t)l * 4 + g) * 64 * 64; const float sp = GIN(I_SPOOL)[l * 256 + c];
    float acc[32];
#pragma unroll
    for (int i = 0; i < 32; ++i) acc[i] = 0.f;
    for (int cc = 0; cc < 64; ++cc) { const float w = wp[cc * 64 + d];
#pragma unroll
        for (int i = 0; i < 32; ++i) acc[i] += pl[(half * 32 + i) * 256 + g * 64 + cc] * w; }
#pragma unroll
    for (int i = 0; i < 32; ++i) Y[(r0 + half * 32 + i) * D + YC_C + c] = (bf16)f2bf(acc[i] * sp);
    __syncthreads();
}
typedef short bf16x8 __attribute__((ext_vector_type(8)));
typedef short s16x4 __attribute__((ext_vector_type(4)));
typedef float f32x16 __attribute__((ext_vector_type(16)));
typedef float f32x2_t __attribute__((ext_vector_type(2))); typedef __bf16 bf16x2_t __attribute__((ext_vector_type(2)));
__device__ __forceinline__ unsigned cvtpk(float lo, float hi) { f32x2_t v = {lo, hi}; bf16x2_t b = __builtin_convertvector(v, bf16x2_t); return __builtin_bit_cast(unsigned, b); }
#define MFMA32(a, b, c) __builtin_amdgcn_mfma_f32_32x32x16_bf16((a), (b), (c), 0, 0, 0)
__device__ __forceinline__ void y_tile_store(LAS unsigned char* ys, const unsigned (&w)[2][4], unsigned char* ydst, int lane) {
    const int r = lane & 31, hf = lane >> 5;
#pragma unroll
    for (int dt = 0; dt < 2; ++dt)
#pragma unroll
        for (int g4 = 0; g4 < 4; ++g4) *(LAS unsigned*)(ys + r * 80 + 32 * dt + 8 * g4 + 4 * hf) = w[dt][g4];
    asm volatile("s_waitcnt lgkmcnt(0)" ::: "memory");
#pragma unroll
    for (int k = 0; k < 2; ++k) { const int row = (lane >> 2) + 16 * k, piece = lane & 3; const u32x4 v = *(const LAS u32x4*)(ys + row * 80 + piece * 16); *(u32x4*)(ydst + (size_t)row * 1024 + piece * 16) = v; }
    asm volatile("" ::: "memory");
}
__device__ __forceinline__ void sb_tile(Frame& F, int l, int b, int h, int qt, LAS unsigned char* wl) {
    int lane_ = F.lane; asm volatile("" : "+v"(lane_));
    const int lane = lane_, r = lane & 31, hf = lane >> 5;
    const bf16* P = WSP(bf16, WS_P); unsigned char* Y = WSP(unsigned char, WS_Y);
    const size_t rowq = (size_t)b * SEQ + qt * 32 + r;
    bf16x8 qf[4];
#pragma unroll
    for (int s = 0; s < 4; ++s) qf[s] = *(const bf16x8*)(P + rowq * NP + PC_QD + h * 64 + 16 * s + 8 * hf);
    f32x16 o0, o1;
#pragma unroll
    for (int i = 0; i < 16; ++i) { o0[i] = 0.f; o1[i] = 0.f; }
    float carry = 0.f;
#define SB_LOADK(KR, KT) do { const size_t rowk_ = (size_t)b * SEQ + (KT) * 32; \
        _Pragma("unroll") for (int i_ = 0; i_ < 4; ++i_) KR[i_] = *(const u32x4*)(P + (rowk_ + 8 * i_ + (lane >> 3)) * NP + PC_KD + h * 64 + (lane & 7) * 8); } while (0)
#define SB_PUTK(KR) do { _Pragma("unroll") for (int i_ = 0; i_ < 4; ++i_) *(LAS u32x4*)(wl + 10240 + (8 * i_ + (lane >> 3)) * 144 + (lane & 7) * 16) = KR[i_]; } while (0)
#define SB_GETK(KF) do { _Pragma("unroll") for (int s_ = 0; s_ < 4; ++s_) KF[s_] = *(const LAS bf16x8*)(wl + 10240 + r * 144 + (16 * s_ + 8 * hf) * 2); } while (0)
#define SB_LOADV(VR, KT) do { const size_t rowk_ = (size_t)b * SEQ + (KT) * 32; \
        _Pragma("unroll") for (int i_ = 0; i_ < 4; ++i_) VR[i_] = *(const u32x4*)(P + (rowk_ + 8 * i_ + (lane >> 3)) * NP + PC_VD + h * 64 + (lane & 7) * 8); } while (0)
#define SB_PUTV(VR, BUF) do { _Pragma("unroll") for (int i_ = 0; i_ < 4; ++i_) *(LAS u32x4*)(wl + (BUF) * 5120 + (8 * i_ + (lane >> 3)) * 160 + (lane & 7) * 16) = VR[i_]; } while (0)
#define SB_GETV(VF, BUF) do { const unsigned a_ = (unsigned)(size_t)(wl + (BUF) * 5120) + (unsigned)((4 * hf + ((lane & 15) >> 2)) * 160 + (16 * ((lane >> 4) & 1) + 4 * (lane & 3)) * 2); \
        s16x4 t0_, t1_, t2_, t3_, t4_, t5_, t6_, t7_; \
        asm volatile("ds_read_b64_tr_b16 %0, %8\n\tds_read_b64_tr_b16 %1, %8 offset:1280\n\tds_read_b64_tr_b16 %2, %8 offset:2560\n\tds_read_b64_tr_b16 %3, %8 offset:3840\n\t" \
                     "ds_read_b64_tr_b16 %4, %8 offset:64\n\tds_read_b64_tr_b16 %5, %8 offset:1344\n\tds_read_b64_tr_b16 %6, %8 offset:2624\n\tds_read_b64_tr_b16 %7, %8 offset:3904\n\ts_waitcnt lgkmcnt(0)" \
                     : "=&v"(t0_), "=&v"(t1_), "=&v"(t2_), "=&v"(t3_), "=&v"(t4_), "=&v"(t5_), "=&v"(t6_), "=&v"(t7_) : "v"(a_) : "memory"); \
        VF[0][0] = (bf16x8){t0_[0], t0_[1], t0_[2], t0_[3], t1_[0], t1_[1], t1_[2], t1_[3]}; VF[0][1] = (bf16x8){t2_[0], t2_[1], t2_[2], t2_[3], t3_[0], t3_[1], t3_[2], t3_[3]}; \
        VF[1][0] = (bf16x8){t4_[0], t4_[1], t4_[2], t4_[3], t5_[0], t5_[1], t5_[2], t5_[3]}; VF[1][1] = (bf16x8){t6_[0], t6_[1], t6_[2], t6_[3], t7_[0], t7_[1], t7_[2], t7_[3]}; } while (0)
    bf16x8 kf[4]; int cur = 0;
    { u32x4 vr[4], kr[4]; SB_LOADK(kr, qt); SB_LOADV(vr, qt); SB_PUTK(kr); SB_PUTV(vr, 0); asm volatile("" ::: "memory"); SB_GETK(kf); }
    for (int kt = qt; kt >= 0; --kt) {
        bf16x8 vf[2][2]; u32x4 vrn[4], krn[4];
        SB_GETV(vf, cur);
        { const int ktn = kt > 0 ? kt - 1 : 0; SB_LOADK(krn, ktn); SB_LOADV(vrn, ktn); }
        f32x16 sa;
#pragma unroll
        for (int i = 0; i < 16; ++i) sa[i] = 0.f;
#pragma unroll
        for (int s = 0; s < 4; ++s) sa = MFMA32(kf[s], qf[s], sa);
        const bool diag = (kt == qt);
        float lf[16], ls[16];
#pragma unroll
        for (int i = 0; i < 16; ++i) { const int kk = (i & 3) + 8 * (i >> 2) + 4 * hf; const float z = sa[i] * 0.125f; const float sp = softplus_f(z);
            const bool past = !diag || (kk < r); lf[i] = past ? -sp : 0.f; ls[i] = past ? (z - sp) : -1e30f; }
        float Gs[4], Gp[4];
#pragma unroll
        for (int j = 0; j < 4; ++j) { Gs[j] = (lf[4 * j] + lf[4 * j + 1]) + (lf[4 * j + 2] + lf[4 * j + 3]); Gp[j] = __shfl_xor(Gs[j], 32); }
        float a[16]; float above = 0.f;
#pragma unroll
        for (int j = 3; j >= 0; --j) {
            const float T = carry + above + (hf == 0 ? Gp[j] : 0.f);
            const float e2 = lf[4 * j + 3], e1 = e2 + lf[4 * j + 2], e0 = e1 + lf[4 * j + 1];
            a[4 * j + 3] = __expf(ls[4 * j + 3] + T); a[4 * j + 2] = __expf(ls[4 * j + 2] + T + e2); a[4 * j + 1] = __expf(ls[4 * j + 1] + T + e1); a[4 * j] = __expf(ls[4 * j] + T + e0);
            above += Gs[j] + Gp[j];
        }
        carry += above;
#pragma unroll
        for (int s2 = 0; s2 < 2; ++s2) { u32x4 pw; pw.x = cvtpk(a[8 * s2], a[8 * s2 + 1]); pw.y = cvtpk(a[8 * s2 + 2], a[8 * s2 + 3]); pw.z = cvtpk(a[8 * s2 + 4], a[8 * s2 + 5]); pw.w = cvtpk(a[8 * s2 + 6], a[8 * s2 + 7]);
            const bf16x8 pf = __builtin_bit_cast(bf16x8, pw);
            o0 = MFMA32(vf[0][s2], pf, o0); o1 = MFMA32(vf[1][s2], pf, o1); }
        if (__all(carry < -24.0f)) break;
        cur ^= 1; SB_PUTV(vrn, cur); SB_PUTK(krn); asm volatile("" ::: "memory"); SB_GETK(kf);
    }
#undef SB_PUTK
#undef SB_GETK
#undef SB_LOADK
#undef SB_LOADV
#undef SB_PUTV
#undef SB_GETV
    float ss = 0.f;
#pragma unroll
    for (int i = 0; i < 16; ++i) ss += o0[i] * o0[i] + o1[i] * o1[i];
    ss += __shfl_xor(ss, 32);
    const float rs = __builtin_amdgcn_rsqf(ss * (1.0f / 64.0f) + EPS);
    const float* go = GIN(I_GOD) + l * 256 + h * 64;
    unsigned yw[2][4];
#pragma unroll
    for (int dt = 0; dt < 2; ++dt)
#pragma unroll
        for (int g4 = 0; g4 < 4; ++g4) { const int d0 = 32 * dt + 8 * g4 + 4 * hf; const f32x4 gg = *(const f32x4*)(go + d0);
            float v0, v1, v2, v3;
            if (dt == 0) { v0 = o0[4 * g4]; v1 = o0[4 * g4 + 1]; v2 = o0[4 * g4 + 2]; v3 = o0[4 * g4 + 3]; } else { v0 = o1[4 * g4]; v1 = o1[4 * g4 + 1]; v2 = o1[4 * g4 + 2]; v3 = o1[4 * g4 + 3]; }
            yw[dt][g4] = q8x4(v0 * rs * gg[0], v1 * rs * gg[1], v2 * rs * gg[2], v3 * rs * gg[3]); }
    y_tile_store(wl + 14848, yw, Y + ((size_t)b * SEQ + qt * 32) * D + YC_D + h * 64, lane);
}
constexpr int CH_UT = 0;
constexpr int CH_WN = 8192;
constexpr int CH_KDT = 16384;
constexpr int CH_QD = 24576;
constexpr int CH_QKF = 32768;
constexpr int CH_EGL = CH_QKF + 2048;
constexpr int CH_STRIDE = 40960;
__device__ __forceinline__ size_t ch_off(int unit) { return unit < 1024 ? WS_CHA + (size_t)unit * CH_STRIDE : WS_CHB + (size_t)(unit - 1024) * CH_STRIDE; }
constexpr int DN_WLDS = 18432;
__device__ __forceinline__ int crow(int reg, int hf) { return (reg & 3) + 8 * (reg >> 2) + 4 * hf; }
__device__ __forceinline__ bf16x8 pack8(float a0, float a1, float a2, float a3, float a4, float a5, float a6, float a7) {
    u32x4 p; p.x = cvtpk(a0, a1); p.y = cvtpk(a2, a3); p.z = cvtpk(a4, a5); p.w = cvtpk(a6, a7); return __builtin_bit_cast(bf16x8, p); }
__device__ __forceinline__ bf16x8 pack_regs(const f32x16& x, int s) { return pack8(x[8 * s], x[8 * s + 1], x[8 * s + 2], x[8 * s + 3], x[8 * s + 4], x[8 * s + 5], x[8 * s + 6], x[8 * s + 7]); }
#define WAVE_LDS_SYNC() asm volatile("s_waitcnt lgkmcnt(0)" ::: "memory")

__device__ __forceinline__ void dn_prep(Frame& F, int l, int unit, LAS unsigned char* wl) {
    int lane = F.lane, r, hf;
#define RELANE() do { asm volatile("" : "+v"(lane)); r = lane & 31; hf = lane >> 5; } while (0)
    RELANE();
    const int bh = unit >> 5, c = unit & 31, b = bh >> 2, h = bh & 3, t0 = c * 64;
    const size_t r0 = (size_t)b * SEQ + t0;
    const bf16* P = WSP(bf16, WS_P); const float* cw = GIN(I_CONV) + (size_t)l * 4 * 768; const float* ab = WSP(float, WS_ABLOG);
    unsigned char* cb = F.ws + ch_off(unit);
    LAS float* Lm = (LAS float*)wl; LAS float* Gt = (LAS float*)(wl + 16896); LAS float* Bt = Gt + 64; LAS float* Rk = Bt + 64; LAS float* Rq = Rk + 64;
    float G63;
    { const float a = ab[(r0 + lane) * 8 + h], bb = ab[(r0 + lane) * 8 + 4 + h];
      float g = -__expf(GIN(I_ALOG)[l * 4 + h]) * softplus_f(a + GIN(I_DTB)[l * 4 + h]);
#pragma unroll
      for (int o = 1; o < 64; o <<= 1) { const float v = __shfl_up(g, o); if (lane >= o) g += v; }
      Gt[lane] = g; Bt[lane] = sigmoid_f(bb); G63 = rdlane(g, 63); }
#define DN_STAGE(colbase, halfoff) do { const bf16* base_ = P + r0 * NP + (colbase) + (lane & 7) * 8; u32x4 w_[8], hw_ = (u32x4){0u, 0u, 0u, 0u}; \
        _Pragma("unroll") for (int k_ = 0; k_ < 8; ++k_) w_[k_] = *(const u32x4*)(base_ + (size_t)(8 * k_ + (lane >> 3)) * NP); \
        if (t0 > 0) { if (lane < 24) hw_ = *(const u32x4*)(base_ + ((long)(lane >> 3) - 3) * NP); } \
        _Pragma("unroll") for (int k_ = 0; k_ < 8; ++k_) { LAS unsigned char* d_ = wl + (8 * k_ + (lane >> 3)) * 264 + (halfoff) + (lane & 7) * 16; *(LAS u32x2*)d_ = (u32x2){w_[k_].x, w_[k_].y}; *(LAS u32x2*)(d_ + 8) = (u32x2){w_[k_].z, w_[k_].w}; } \
        if (lane < 24) *(LAS u32x4*)(wl + 17920 + (lane >> 3) * 128 + (lane & 7) * 16) = hw_; \
        WAVE_LDS_SYNC(); asm volatile("" ::: "memory"); } while (0)
#define DN_RAWCOL(raw, halfoff) do { _Pragma("unroll") for (int i_ = 0; i_ < 3; ++i_) raw[i_] = *(const LAS bf16*)(wl + 17920 + i_ * 128 + lane * 2); \
        _Pragma("unroll") for (int i_ = 0; i_ < 64; ++i_) raw[3 + i_] = *(const LAS bf16*)(wl + i_ * 264 + (halfoff) + lane * 2); } while (0)
    unsigned vpk[32];
    {   const int chv = 512 + h * 64 + lane; const float w0 = cw[chv], w1 = cw[768 + chv], w2 = cw[1536 + chv], w3 = cw[2304 + chv];
        DN_STAGE(512 + h * 64, 0);
        unsigned raw[67]; DN_RAWCOL(raw, 0);
#pragma unroll
        for (int i = 0; i < 64; i += 2) vpk[i >> 1] = cvtpk(silu_f(w0 * bf2f(raw[i]) + w1 * bf2f(raw[i + 1]) + w2 * bf2f(raw[i + 2]) + w3 * bf2f(raw[i + 3])), silu_f(w0 * bf2f(raw[i + 1]) + w1 * bf2f(raw[i + 2]) + w2 * bf2f(raw[i + 3]) + w3 * bf2f(raw[i + 4])));
        WAVE_LDS_SYNC(); asm volatile("" ::: "memory"); }
    {   LAS bf16* T = (LAS bf16*)wl;
#pragma unroll
        for (int which = 0; which < 2; ++which) { const int chn = which * 256 + h * 64 + lane;
            const float w0 = cw[chn], w1 = cw[768 + chn], w2 = cw[1536 + chn], w3 = cw[2304 + chn];
            DN_STAGE(which * 256 + h * 64, which * 128);
            unsigned raw[67]; DN_RAWCOL(raw, which * 128); unsigned kq_[4] = {0u, 0u, 0u, 0u};
            WAVE_LDS_SYNC(); asm volatile("" ::: "memory");
#pragma unroll
            for (int i = 0; i < 64; i += 2) { const unsigned pk_ = cvtpk(silu_f(w0 * bf2f(raw[i]) + w1 * bf2f(raw[i + 1]) + w2 * bf2f(raw[i + 2]) + w3 * bf2f(raw[i + 3])), silu_f(w0 * bf2f(raw[i + 1]) + w1 * bf2f(raw[i + 2]) + w2 * bf2f(raw[i + 3]) + w3 * bf2f(raw[i + 4])));
                T[i * 132 + which * 64 + lane] = (bf16)(pk_ & 0xffffu); T[(i + 1) * 132 + which * 64 + lane] = (bf16)(pk_ >> 16); if (which == 1) { kq_[(i >> 1) & 3] = pk_; if ((i & 6) == 6) *(u32x4*)(cb + CH_WN + lane * 128 + (i >> 3) * 16) = (u32x4){kq_[0], kq_[1], kq_[2], kq_[3]}; } }
            asm volatile("" ::: "memory"); }
    }
    WAVE_LDS_SYNC();
    RELANE();
    bf16x8 qf[2][4], kf[2][4]; float sq[2] = {0.f, 0.f}, sk[2] = {0.f, 0.f};
#pragma unroll
    for (int which = 0; which < 2; ++which)
#pragma unroll
        for (int it = 0; it < 2; ++it)
#pragma unroll
            for (int s = 0; s < 4; ++s) { const LAS unsigned char* tp = wl + (32 * it + r) * 264 + (which * 64 + 16 * s + 4 * hf) * 2;
                const u32x2 lo = *(const LAS u32x2*)tp, hi = *(const LAS u32x2*)(tp + 16); const u32x4 fv = (u32x4){lo.x, lo.y, hi.x, hi.y};
                const float e0 = bf2f(fv.x & 0xffffu), e1 = bf2f(fv.x >> 16), e2 = bf2f(fv.y & 0xffffu), e3 = bf2f(fv.y >> 16), e4 = bf2f(fv.z & 0xffffu), e5 = bf2f(fv.z >> 16), e6 = bf2f(fv.w & 0xffffu), e7 = bf2f(fv.w >> 16);
                const float ss = ((e0 * e0 + e1 * e1) + (e2 * e2 + e3 * e3)) + ((e4 * e4 + e5 * e5) + (e6 * e6 + e7 * e7));
                if (which == 0) { qf[it][s] = __builtin_bit_cast(bf16x8, fv); sq[it] += ss; } else { kf[it][s] = __builtin_bit_cast(bf16x8, fv); sk[it] += ss; } }
#pragma unroll
    for (int it = 0; it < 2; ++it) { sq[it] += __shfl_xor(sq[it], 32); sk[it] += __shfl_xor(sk[it], 32);
        if (hf == 0) { Rq[32 * it + r] = __builtin_amdgcn_rsqf(sq[it] + EPS); Rk[32 * it + r] = __builtin_amdgcn_rsqf(sk[it] + EPS); } }
    WAVE_LDS_SYNC();
#ifndef NO_S3
    RELANE();
#pragma unroll
    for (int tl = 0; tl < 3; ++tl) { const int jt = tl == 2 ? 1 : 0, it = tl == 0 ? 0 : 1;
        RELANE();
        f32x16 acc;
#pragma unroll
        for (int i = 0; i < 16; ++i) acc[i] = 0.f;
#pragma unroll
        for (int s = 0; s < 4; ++s) acc = MFMA32(kf[jt][s], kf[it][s], acc);
        const int i = 32 * it + r; const float ci = Bt[i] * Rk[i], gi = Gt[i];
#pragma unroll
        for (int j16 = 0; j16 < 16; ++j16) { const int j = 32 * jt + crow(j16, hf);
            Lm[j * 64 + i] = (i > j) ? acc[j16] * ci * Rk[j] * __expf(gi - Gt[j]) : 0.f; } }
#endif
#ifndef NO_S4
    RELANE();
#pragma unroll
    for (int tl = 0; tl < 3; ++tl) { const int tt = tl == 0 ? 0 : 1, jt = tl == 2 ? 1 : 0;
        RELANE();
        f32x16 acc;
#pragma unroll
        for (int i = 0; i < 16; ++i) acc[i] = 0.f;
#pragma unroll
        for (int s = 0; s < 4; ++s) acc = MFMA32(kf[jt][s], qf[tt][s], acc);
        const int i = 32 * tt + r; const float ci = Rq[i] * 0.125f, gi = Gt[i];
#pragma unroll
        for (int j16 = 0; j16 < 16; ++j16) { const int j = 32 * jt + crow(j16, hf); acc[j16] = (i >= j) ? acc[j16] * Rk[j] * ci * __expf(gi - Gt[j]) : 0.f; }
#pragma unroll
        for (int s2 = 0; s2 < 2; ++s2) *(bf16x8*)(cb + CH_QKF + (((tt * 2 + jt) * 2 + s2) * 64 + lane) * 16) = pack_regs(acc, s2); }
#pragma unroll
    for (int it = 0; it < 2; ++it) { const int i = 32 * it + r; const float sc = Rq[i] * 0.125f * __expf(Gt[i]);
#pragma unroll
        for (int s = 0; s < 4; ++s) { const u32x4 q = __builtin_bit_cast(u32x4, qf[it][s]);
            *(bf16x8*)(cb + CH_QD + ((it * 4 + s) * 64 + lane) * 16) = pack8(bf2f(q.x & 0xffffu) * sc, bf2f(q.x >> 16) * sc, bf2f(q.y & 0xffffu) * sc, bf2f(q.y >> 16) * sc, bf2f(q.z & 0xffffu) * sc, bf2f(q.z >> 16) * sc, bf2f(q.w & 0xffffu) * sc, bf2f(q.w >> 16) * sc); } }
    WAVE_LDS_SYNC();
#endif
#ifndef NO_S5
    RELANE();
#define DN_SOLVE(X2) do { _Pragma("unroll") for (int j = 0; j < 63; ++j) { const float xj_ = (j & 1) ? X2[j >> 1][1] : X2[j >> 1][0]; const f32x2_t nx_ = (f32x2_t){-xj_, -xj_}; \
        _Pragma("unroll") for (int i4 = (j + 1) / 4; i4 < 16; ++i4) { const f32x4 lv = *(const LAS f32x4*)(Lm + j * 64 + 4 * i4); \
            if (4 * i4 > j) X2[2 * i4] = __builtin_elementwise_fma((f32x2_t){lv[0], lv[1]}, nx_, X2[2 * i4]); \
            else if (4 * i4 + 1 > j) X2[2 * i4][1] = __builtin_fmaf(lv[1], -xj_, X2[2 * i4][1]); \
            if (4 * i4 + 2 > j) X2[2 * i4 + 1] = __builtin_elementwise_fma((f32x2_t){lv[2], lv[3]}, nx_, X2[2 * i4 + 1]); \
            else if (4 * i4 + 3 > j) X2[2 * i4 + 1][1] = __builtin_fmaf(lv[3], -xj_, X2[2 * i4 + 1][1]); } \
        asm volatile("" ::: "memory"); __builtin_amdgcn_sched_barrier(0); } } while (0)
    u32x4 kpk[8];
#pragma unroll
    for (int i8 = 0; i8 < 8; ++i8) kpk[i8] = *(const u32x4*)(cb + CH_WN + lane * 128 + i8 * 16);
    {
#pragma clang fp contract(off)
        f32x2_t X2[32];
        {
#pragma unroll
          for (int i = 0; i < 64; ++i) { X2[i >> 1][i & 1] = ((i & 1) ? bf2f(vpk[i >> 1] >> 16) : bf2f(vpk[i >> 1] & 0xffffu)) * Bt[i];
              if ((i & 7) == 7) { asm volatile("" ::: "memory"); __builtin_amdgcn_sched_barrier(0); } } }
        __builtin_amdgcn_sched_barrier(0);
        DN_SOLVE(X2);
#pragma unroll
        for (int i8 = 0; i8 < 8; ++i8) *(bf16x8*)(cb + CH_UT + (lane * 64 + 8 * i8) * 2) = pack8(X2[4 * i8][0], X2[4 * i8][1], X2[4 * i8 + 1][0], X2[4 * i8 + 1][1], X2[4 * i8 + 2][0], X2[4 * i8 + 2][1], X2[4 * i8 + 3][0], X2[4 * i8 + 3][1]);
    }
    RELANE();
    {
#pragma clang fp contract(off)
        f32x2_t X2[32];
        {
          float kd[8];
#pragma unroll
          for (int i = 0; i < 64; ++i) { const unsigned kw_ = kpk[i >> 3][(i >> 1) & 3]; const float kc = ((i & 1) ? bf2f(kw_ >> 16) : bf2f(kw_ & 0xffffu)) * Rk[i], gi = Gt[i];
              X2[i >> 1][i & 1] = kc * Bt[i] * __expf(gi); kd[i & 7] = kc * __expf(G63 - gi);
              if ((i & 7) == 7) { *(bf16x8*)(cb + CH_KDT + (lane * 64 + i - 7) * 2) = pack8(kd[0], kd[1], kd[2], kd[3], kd[4], kd[5], kd[6], kd[7]); asm volatile("" ::: "memory"); __builtin_amdgcn_sched_barrier(0); } } }
        __builtin_amdgcn_sched_barrier(0);
        DN_SOLVE(X2);
        WAVE_LDS_SYNC(); asm volatile("" ::: "memory");
#pragma unroll
        for (int i = 0; i < 64; ++i) *(LAS bf16*)(wl + i * 264 + lane * 2) = (bf16)f2bf(-X2[i >> 1][i & 1]);
        WAVE_LDS_SYNC(); asm volatile("" ::: "memory");
#pragma unroll
        for (int k = 0; k < 8; ++k) { const LAS unsigned char* sp = wl + (8 * k + (lane >> 3)) * 264 + (lane & 7) * 16; const u32x2 lo = *(const LAS u32x2*)sp, hi = *(const LAS u32x2*)(sp + 8);
            *(u32x4*)(cb + CH_WN + (8 * k + (lane >> 3)) * 128 + (lane & 7) * 16) = (u32x4){lo.x, lo.y, hi.x, hi.y}; }
    }
#undef DN_SOLVE
#undef DN_STAGE
#undef DN_RAWCOL
#endif
#undef RELANE
    if (lane == 0) *(float*)(cb + CH_EGL) = __expf(G63);
    WAVE_LDS_SYNC();
}

constexpr int SCAN_LDS0 = 8192, SCAN_BUF = 49152, SC_GATE = 40960, SCAN_NDMA = 47;
__device__ __forceinline__ void dn_scan_fetch(const unsigned char* cb, const bf16* gate0, LAS unsigned char* buf, int lane) {
    asm volatile("" : "+v"(lane));
    const unsigned rW = lane >> 3, pW = lane & 7;
#pragma unroll
    for (int n = 0; n < 8; ++n) { const unsigned row = 8 * n + rW; const unsigned so = (row * 8 + (pW ^ (row & 7))) * 16;
        __builtin_amdgcn_global_load_lds((const unsigned*)(cb + CH_UT + so), (LAS unsigned*)(buf + CH_UT + n * 1024), 16, 0, 0);
        __builtin_amdgcn_global_load_lds((const unsigned*)(cb + CH_WN + so), (LAS unsigned*)(buf + CH_WN + n * 1024), 16, 0, 0);
        __builtin_amdgcn_global_load_lds((const unsigned*)(cb + CH_KDT + so), (LAS unsigned*)(buf + CH_KDT + n * 1024), 16, 0, 0);
        __builtin_amdgcn_global_load_lds((const unsigned*)(cb + CH_QD + n * 1024 + lane * 16), (LAS unsigned*)(buf + CH_QD + n * 1024), 16, 0, 0);
        if (n != 3) __builtin_amdgcn_global_load_lds((const unsigned*)(cb + CH_QKF + n * 1024 + lane * 16), (LAS unsigned*)(buf + CH_QKF + n * 1024), 16, 0, 0);
        __builtin_amdgcn_global_load_lds((const unsigned*)(gate0 + (size_t)row * NP + 8 * (pW ^ (row & 7))), (LAS unsigned*)(buf + SC_GATE + n * 1024), 16, 0, 0); }
}
__device__ __forceinline__ void dn_scan(Frame& F, int l, int bh) {
    const int lane = F.lane, r = lane & 31, hf = lane >> 5, b = bh >> 2, h = bh & 3;
    const bf16* P = WSP(bf16, WS_P); unsigned char* Y = WSP(unsigned char, WS_Y);
    const unsigned char* cb0 = F.ws + ch_off(bh * 32);
    const bf16* gate00 = P + (size_t)b * SEQ * NP + PC_GATE + h * 64;
    f32x16 S[2][2];
#pragma unroll
    for (int dt = 0; dt < 2; ++dt)
#pragma unroll
        for (int jt = 0; jt < 2; ++jt)
#pragma unroll
            for (int i = 0; i < 16; ++i) S[dt][jt][i] = 0.f;
    dn_scan_fetch(cb0, gate00, F.lds + SCAN_LDS0, lane);
    dn_scan_fetch(cb0 + CH_STRIDE, gate00 + (size_t)64 * NP, F.lds + SCAN_LDS0 + SCAN_BUF, lane);
    asm volatile("s_waitcnt vmcnt(47)" ::: "memory");
    int bi = 0;
    for (int c = 0; c < 32; ++c) {
        asm volatile("s_waitcnt lgkmcnt(0)" ::: "memory");
        { const int cf = (c + 2 < 32) ? c + 2 : 31; const int bf_ = bi == 0 ? 2 : bi - 1;
          dn_scan_fetch(cb0 + (size_t)cf * CH_STRIDE, gate00 + (size_t)cf * 64 * NP, F.lds + SCAN_LDS0 + bf_ * SCAN_BUF, lane); }
        const LAS unsigned char* lb = F.lds + SCAN_LDS0 + bi * SCAN_BUF;
        bi = bi == 2 ? 0 : bi + 1;
        const size_t r0 = (size_t)b * SEQ + c * 64;
        const float egl = *(const LAS float*)(lb + CH_EGL);
        bf16x8 Sp[2][2][2];
#pragma unroll
        for (int dt = 0; dt < 2; ++dt)
#pragma unroll
            for (int jt = 0; jt < 2; ++jt) { Sp[dt][jt][0] = pack_regs(S[dt][jt], 0); Sp[dt][jt][1] = pack_regs(S[dt][jt], 1); }
        f32x16 vn[2][2];
#pragma unroll
        for (int it = 0; it < 2; ++it)
#pragma unroll
            for (int jt = 0; jt < 2; ++jt)
#pragma unroll
                for (int g4 = 0; g4 < 4; ++g4) { const unsigned row = 32 * jt + r; const u32x2 u = *(const LAS u32x2*)(lb + CH_UT + row * 128 + (((4 * it + g4) ^ (row & 7)) * 16) + 8 * hf);
                    vn[it][jt][4 * g4] = bf2f(u.x & 0xffffu); vn[it][jt][4 * g4 + 1] = bf2f(u.x >> 16); vn[it][jt][4 * g4 + 2] = bf2f(u.y & 0xffffu); vn[it][jt][4 * g4 + 3] = bf2f(u.y >> 16); }
#pragma unroll
        for (int it = 0; it < 2; ++it) { bf16x8 wf[4];
#pragma unroll
            for (int s = 0; s < 4; ++s) { const unsigned row = 32 * it + r; const LAS unsigned char* wp = lb + CH_WN + row * 128 + 8 * hf; const unsigned sw = row & 7;
                const u32x2 lo = *(const LAS u32x2*)(wp + (((2 * s) ^ sw) * 16)), hi = *(const LAS u32x2*)(wp + (((2 * s + 1) ^ sw) * 16)); wf[s] = __builtin_bit_cast(bf16x8, (u32x4){lo.x, lo.y, hi.x, hi.y}); }
            asm volatile("" ::: "memory");
#pragma unroll
            for (int s = 0; s < 4; ++s) { vn[it][0] = MFMA32(wf[s], Sp[s >> 1][0][s & 1], vn[it][0]); vn[it][1] = MFMA32(wf[s], Sp[s >> 1][1][s & 1], vn[it][1]); } }
        bf16x8 Vp[2][2][2];
#pragma unroll
        for (int it = 0; it < 2; ++it)
#pragma unroll
            for (int jt = 0; jt < 2; ++jt) { Vp[it][jt][0] = pack_regs(vn[it][jt], 0); Vp[it][jt][1] = pack_regs(vn[it][jt], 1); }
#pragma unroll
        for (int dt = 0; dt < 2; ++dt)
#pragma unroll
            for (int jt = 0; jt < 2; ++jt)
#pragma unroll
                for (int i = 0; i < 16; ++i) S[dt][jt][i] *= egl;
#pragma unroll
        for (int dt = 0; dt < 2; ++dt) { bf16x8 kfr[4];
#pragma unroll
            for (int q = 0; q < 4; ++q) { const unsigned row = 32 * dt + r; const LAS unsigned char* kp = lb + CH_KDT + row * 128 + 8 * hf; const unsigned sw = row & 7, c0 = 2 * q;
                const u32x2 lo = *(const LAS u32x2*)(kp + ((c0 ^ sw) * 16)), hi = *(const LAS u32x2*)(kp + (((c0 + 1) ^ sw) * 16)); kfr[q] = __builtin_bit_cast(bf16x8, (u32x4){lo.x, lo.y, hi.x, hi.y}); }
            asm volatile("" ::: "memory");
#pragma unroll
            for (int q = 0; q < 4; ++q) { S[dt][0] = MFMA32(kfr[q], Vp[q >> 1][0][q & 1], S[dt][0]); S[dt][1] = MFMA32(kfr[q], Vp[q >> 1][1][q & 1], S[dt][1]); } }
#pragma unroll
        for (int tt = 0; tt < 2; ++tt) {
            f32x16 o[2];
#pragma unroll
            for (int jt = 0; jt < 2; ++jt)
#pragma unroll
                for (int i = 0; i < 16; ++i) o[jt][i] = 0.f;
            bf16x8 qd[4], qk[4];
#pragma unroll
            for (int s = 0; s < 4; ++s) qd[s] = *(const LAS bf16x8*)(lb + CH_QD + ((tt * 4 + s) * 64 + lane) * 16);
#pragma unroll
            for (int q = 0; q < 2 * (tt + 1); ++q) qk[q] = *(const LAS bf16x8*)(lb + CH_QKF + ((tt * 4 + q) * 64 + lane) * 16);
            asm volatile("" ::: "memory");
#pragma unroll
            for (int s = 0; s < 4; ++s) { o[0] = MFMA32(Sp[s >> 1][0][s & 1], qd[s], o[0]); o[1] = MFMA32(Sp[s >> 1][1][s & 1], qd[s], o[1]); }
#pragma unroll
            for (int q = 0; q < 2 * (tt + 1); ++q) { o[0] = MFMA32(Vp[q >> 1][0][q & 1], qk[q], o[0]); o[1] = MFMA32(Vp[q >> 1][1][q & 1], qk[q], o[1]); }
            float ss = 0.f;
#pragma unroll
            for (int i = 0; i < 16; ++i) ss += o[0][i] * o[0][i] + o[1][i] * o[1][i];
            ss += __shfl_xor(ss, 32);
            const float rs = __builtin_amdgcn_rsqf(ss * (1.0f / 64.0f) + EPS);
            const size_t row = r0 + 32 * tt + r;
            if (tt == 0) asm volatile("s_waitcnt vmcnt(47)" ::: "memory");
#pragma unroll
            for (int jt = 0; jt < 2; ++jt)
#pragma unroll
                for (int g4 = 0; g4 < 4; ++g4) { const int d0 = 32 * jt + 8 * g4 + 4 * hf;
                    const unsigned trow = 32 * tt + r; const u32x2 gv = *(const LAS u32x2*)(lb + SC_GATE + trow * 128 + (((4 * jt + g4) ^ (trow & 7)) * 16) + 8 * hf);
                    const float y0 = o[jt][4 * g4] * rs * bf2f(gv.x & 0xffffu), y1 = o[jt][4 * g4 + 1] * rs * bf2f(gv.x >> 16);
                    const float y2 = o[jt][4 * g4 + 2] * rs * bf2f(gv.y & 0xffffu), y3 = o[jt][4 * g4 + 3] * rs * bf2f(gv.y >> 16);
                    *(unsigned*)(Y + row * D + YC_A + h * 64 + d0) = q8x4(y0, y1, y2, y3); }
        }
    }
    asm volatile("s_waitcnt vmcnt(0) lgkmcnt(0)" ::: "memory");
}
constexpr int SL_RING = 8192, SL_BUF = 24576, SL_HO = 81920, SL_HOSLOT = 16384, SL_GATE = 131072, SL_FLAGS = 163072;
__device__ __forceinline__ void dn_lead_fetch(const unsigned char* cb, LAS unsigned char* buf, int lane) {
    asm volatile("" : "+v"(lane));
    const unsigned rW = lane >> 3, pW = lane & 7;
#pragma unroll
    for (int n = 0; n < 8; ++n) { const unsigned row = 8 * n + rW; const unsigned so = (row * 8 + (pW ^ (row & 7))) * 16;
        __builtin_amdgcn_global_load_lds((const unsigned*)(cb + CH_UT + so), (LAS unsigned*)(buf + n * 1024), 16, 0, 0);
        __builtin_amdgcn_global_load_lds((const unsigned*)(cb + CH_WN + so), (LAS unsigned*)(buf + 8192 + n * 1024), 16, 0, 0);
        __builtin_amdgcn_global_load_lds((const unsigned*)(cb + CH_KDT + so), (LAS unsigned*)(buf + 16384 + n * 1024), 16, 0, 0); }
}
__device__ __forceinline__ void dn_scan_lead(Frame& F, int l, int bh) {
    int lane = F.lane; asm volatile("" : "+v"(lane)); const int r = lane & 31, hf = lane >> 5;
    const unsigned char* cb0 = F.ws + ch_off(bh * 32);
    volatile LAS unsigned* fl = (volatile LAS unsigned*)(F.lds + SL_FLAGS); volatile LAS unsigned* hand = fl + 1; volatile LAS unsigned* done = fl + 33;
    const unsigned tag = (unsigned)(l + 1);
    const float eglv = *(const float*)(cb0 + (size_t)(lane & 31) * CH_STRIDE + CH_EGL);
    f32x16 S[2][2];
#pragma unroll
    for (int dt = 0; dt < 2; ++dt)
#pragma unroll
        for (int jt = 0; jt < 2; ++jt)
#pragma unroll
            for (int i = 0; i < 16; ++i) S[dt][jt][i] = 0.f;
    asm volatile("s_waitcnt vmcnt(0)" ::: "memory");
    dn_lead_fetch(cb0, F.lds + SL_RING, lane);
    dn_lead_fetch(cb0 + CH_STRIDE, F.lds + SL_RING + SL_BUF, lane);
    asm volatile("s_waitcnt vmcnt(24)" ::: "memory");
    int bi = 0;
    for (int c = 0; c < 32; ++c) {
        asm volatile("s_waitcnt lgkmcnt(0)" ::: "memory");
        { const int cf = (c + 2 < 32) ? c + 2 : 31; const int bf_ = bi == 0 ? 2 : bi - 1;
          dn_lead_fetch(cb0 + (size_t)cf * CH_STRIDE, F.lds + SL_RING + bf_ * SL_BUF, lane); }
        const LAS unsigned char* lb = F.lds + SL_RING + bi * SL_BUF;
        LAS unsigned char* ho = F.lds + SL_HO + bi * SL_HOSLOT;
        bi = bi == 2 ? 0 : bi + 1;
        const float egl = rdlane(eglv, c);
        bf16x8 Sp[2][2][2];
#pragma unroll
        for (int dt = 0; dt < 2; ++dt)
#pragma unroll
            for (int jt = 0; jt < 2; ++jt) { Sp[dt][jt][0] = pack_regs(S[dt][jt], 0); Sp[dt][jt][1] = pack_regs(S[dt][jt], 1); }
        f32x16 vn[2][2];
#pragma unroll
        for (int it = 0; it < 2; ++it)
#pragma unroll
            for (int jt = 0; jt < 2; ++jt)
#pragma unroll
                for (int g4 = 0; g4 < 4; ++g4) { const unsigned row = 32 * jt + r; const u32x2 u = *(const LAS u32x2*)(lb + row * 128 + (((4 * it + g4) ^ (row & 7)) * 16) + 8 * hf);
                    vn[it][jt][4 * g4] = bf2f(u.x & 0xffffu); vn[it][jt][4 * g4 + 1] = bf2f(u.x >> 16); vn[it][jt][4 * g4 + 2] = bf2f(u.y & 0xffffu); vn[it][jt][4 * g4 + 3] = bf2f(u.y >> 16); }
#pragma unroll
        for (int it = 0; it < 2; ++it) { bf16x8 wf[4];
#pragma unroll
            for (int s = 0; s < 4; ++s) { const unsigned row = 32 * it + r; const LAS unsigned char* wp = lb + 8192 + row * 128 + 8 * hf; const unsigned sw = row & 7;
                const u32x2 lo = *(const LAS u32x2*)(wp + (((2 * s) ^ sw) * 16)), hi = *(const LAS u32x2*)(wp + (((2 * s + 1) ^ sw) * 16)); wf[s] = __builtin_bit_cast(bf16x8, (u32x4){lo.x, lo.y, hi.x, hi.y}); }
            asm volatile("" ::: "memory");
#pragma unroll
            for (int s = 0; s < 4; ++s) { vn[it][0] = MFMA32(wf[s], Sp[s >> 1][0][s & 1], vn[it][0]); vn[it][1] = MFMA32(wf[s], Sp[s >> 1][1][s & 1], vn[it][1]); } }
        bf16x8 Vp[2][2][2];
#pragma unroll
        for (int it = 0; it < 2; ++it)
#pragma unroll
            for (int jt = 0; jt < 2; ++jt) { Vp[it][jt][0] = pack_regs(vn[it][jt], 0); Vp[it][jt][1] = pack_regs(vn[it][jt], 1); }
        if (c >= 3) { unsigned spins = 0; while ((unsigned)__builtin_amdgcn_readfirstlane(done[c - 3]) < tag) { if (++spins > (1u << 22)) break; } }
        asm volatile("" ::: "memory");
#pragma unroll
        for (int a = 0; a < 2; ++a)
#pragma unroll
            for (int jt = 0; jt < 2; ++jt)
#pragma unroll
                for (int s2 = 0; s2 < 2; ++s2) { *(LAS bf16x8*)(ho + (((a * 2 + jt) * 2 + s2) * 64 + lane) * 16) = Sp[a][jt][s2]; *(LAS bf16x8*)(ho + 8192 + (((a * 2 + jt) * 2 + s2) * 64 + lane) * 16) = Vp[a][jt][s2]; }
        asm volatile("s_waitcnt lgkmcnt(0)" ::: "memory");
        if (lane == 0) hand[c] = tag;
#pragma unroll
        for (int dt = 0; dt < 2; ++dt)
#pragma unroll
            for (int jt = 0; jt < 2; ++jt)
#pragma unroll
                for (int i = 0; i < 16; ++i) S[dt][jt][i] *= egl;
#pragma unroll
        for (int dt = 0; dt < 2; ++dt) { bf16x8 kfr[4];
#pragma unroll
            for (int q = 0; q < 4; ++q) { const unsigned row = 32 * dt + r; const LAS unsigned char* kp = lb + 16384 + row * 128 + 8 * hf; const unsigned sw = row & 7, c0 = 2 * q;
                const u32x2 lo = *(const LAS u32x2*)(kp + ((c0 ^ sw) * 16)), hi = *(const LAS u32x2*)(kp + (((c0 + 1) ^ sw) * 16)); kfr[q] = __builtin_bit_cast(bf16x8, (u32x4){lo.x, lo.y, hi.x, hi.y}); }
            asm volatile("" ::: "memory");
#pragma unroll
            for (int q = 0; q < 4; ++q) { S[dt][0] = MFMA32(kfr[q], Vp[q >> 1][0][q & 1], S[dt][0]); S[dt][1] = MFMA32(kfr[q], Vp[q >> 1][1][q & 1], S[dt][1]); } }
        asm volatile("s_waitcnt vmcnt(24)" ::: "memory");
    }
    asm volatile("s_waitcnt vmcnt(0) lgkmcnt(0)" ::: "memory");
}
__device__ __forceinline__ void dn_scan_help(Frame& F, int l, int bh, int hidx) {
    int lane = F.lane; asm volatile("" : "+v"(lane)); const int r = lane & 31, hf = lane >> 5, b = bh >> 2, h = bh & 3;
    const bf16* P = WSP(bf16, WS_P); unsigned char* Y = WSP(unsigned char, WS_Y);
    const unsigned char* cb0 = F.ws + ch_off(bh * 32);
    const bf16* gate00 = P + (size_t)b * SEQ * NP + PC_GATE + h * 64;
    volatile LAS unsigned* fl = (volatile LAS unsigned*)(F.lds + SL_FLAGS); volatile LAS unsigned* hand = fl + 1; volatile LAS unsigned* done = fl + 33;
    const unsigned tag = (unsigned)(l + 1);
    LAS unsigned char* gb = F.lds + SL_GATE + hidx * 8192;
    { unsigned spins = 0; while ((unsigned)__builtin_amdgcn_readfirstlane(fl[0]) < tag) { __builtin_amdgcn_s_sleep(2); if (++spins > (1u << 22)) break; } }
    const unsigned rW = lane >> 3, pW = lane & 7;
    for (int c = hidx; c < 32; c += 2) {
        const unsigned char* cb = cb0 + (size_t)c * CH_STRIDE; const size_t r0 = (size_t)b * SEQ + c * 64; const bf16* gate0 = gate00 + (size_t)c * 64 * NP;
        asm volatile("s_waitcnt lgkmcnt(0)" ::: "memory");
#pragma unroll
        for (int n = 0; n < 8; ++n) { const unsigned row = 8 * n + rW;
            __builtin_amdgcn_global_load_lds((const unsigned*)(gate0 + (size_t)row * NP + 8 * (pW ^ (row & 7))), (LAS unsigned*)(gb + n * 1024), 16, 0, 0); }
        bf16x8 qd[8], qk[6];
#pragma unroll
        for (int i = 0; i < 8; ++i) qd[i] = *(const bf16x8*)(cb + CH_QD + (i * 64 + lane) * 16);
#pragma unroll
        for (int i = 0; i < 6; ++i) qk[i] = *(const bf16x8*)(cb + CH_QKF + (((i < 2 ? i : i + 2)) * 64 + lane) * 16);
        { unsigned spins = 0; while ((unsigned)__builtin_amdgcn_readfirstlane(hand[c]) < tag) { if (++spins > (1u << 22)) break; } }
        asm volatile("" ::: "memory");
        const LAS unsigned char* ho = F.lds + SL_HO + (c % 3) * SL_HOSLOT;
        bf16x8 Sp[2][2][2], Vp[2][2][2];
#pragma unroll
        for (int a = 0; a < 2; ++a)
#pragma unroll
            for (int jt = 0; jt < 2; ++jt)
#pragma unroll
                for (int s2 = 0; s2 < 2; ++s2) { Sp[a][jt][s2] = *(const LAS bf16x8*)(ho + (((a * 2 + jt) * 2 + s2) * 64 + lane) * 16); Vp[a][jt][s2] = *(const LAS bf16x8*)(ho + 8192 + (((a * 2 + jt) * 2 + s2) * 64 + lane) * 16); }
        asm volatile("s_waitcnt lgkmcnt(0)" ::: "memory");
        if (lane == 0) done[c] = tag;
        asm volatile("s_waitcnt vmcnt(0)" ::: "memory");
#pragma unroll
        for (int tt = 0; tt < 2; ++tt) {
            f32x16 o[2];
#pragma unroll
            for (int jt = 0; jt < 2; ++jt)
#pragma unroll
                for (int i = 0; i < 16; ++i) o[jt][i] = 0.f;
#pragma unroll
            for (int s = 0; s < 4; ++s) { o[0] = MFMA32(Sp[s >> 1][0][s & 1], qd[tt * 4 + s], o[0]); o[1] = MFMA32(Sp[s >> 1][1][s & 1], qd[tt * 4 + s], o[1]); }
#pragma unroll
            for (int q = 0; q < 2 * (tt + 1); ++q) { o[0] = MFMA32(Vp[q >> 1][0][q & 1], qk[2 * tt + q], o[0]); o[1] = MFMA32(Vp[q >> 1][1][q & 1], qk[2 * tt + q], o[1]); }
            float ss = 0.f;
#pragma unroll
            for (int i = 0; i < 16; ++i) ss += o[0][i] * o[0][i] + o[1][i] * o[1][i];
            ss += __shfl_xor(ss, 32);
            const float rs = __builtin_amdgcn_rsqf(ss * (1.0f / 64.0f) + EPS);
            const size_t row = r0 + 32 * tt + r;
            unsigned yw[2][4];
#pragma unroll
            for (int jt = 0; jt < 2; ++jt)
#pragma unroll
                for (int g4 = 0; g4 < 4; ++g4) {
                    const unsigned trow = 32 * tt + r; const u32x2 gv = *(const LAS u32x2*)(gb + trow * 128 + (((4 * jt + g4) ^ (trow & 7)) * 16) + 8 * hf);
                    const float y0 = o[jt][4 * g4] * rs * bf2f(gv.x & 0xffffu), y1 = o[jt][4 * g4 + 1] * rs * bf2f(gv.x >> 16);
                    const float y2 = o[jt][4 * g4 + 2] * rs * bf2f(gv.y & 0xffffu), y3 = o[jt][4 * g4 + 3] * rs * bf2f(gv.y >> 16);
                    yw[jt][g4] = q8x4(y0, y1, y2, y3); }
            y_tile_store(F.lds + 147456 + hidx * 2560, yw, Y + (r0 + 32 * tt) * D + YC_A + h * 64, lane);
        }
    }
    asm volatile("s_waitcnt vmcnt(0) lgkmcnt(0)" ::: "memory");
}
__device__ __forceinline__ void sg_tile(Frame& F, int l, int unit, LAS unsigned char* wl) {
    int lane = F.lane; asm volatile("" : "+v"(lane)); const int r = lane & 31, hf = lane >> 5;
    const int h = unit & 3, bn = unit >> 2; const size_t r0 = (size_t)(bn >> 4) * SEQ + (bn & 15) * 128;
    const bf16* P = WSP(bf16, WS_P); unsigned char* Y = WSP(unsigned char, WS_Y); const bf16* wsg = WSP(bf16, WS_WSG) + (size_t)(l * 4 + h) * 128 * 128;
    LAS float* MU = (LAS float*)wl; LAS float* RS = MU + 128;
    LAS unsigned char* vt = wl + 1024;
    { u32x4 w_[16];
#pragma unroll
      for (int i = 0; i < 16; ++i) w_[i] = *(const u32x4*)(P + (r0 + 8 * i + (lane >> 3)) * NP + PC_VB + h * 64 + (lane & 7) * 8);
#pragma unroll
      for (int i = 0; i < 16; ++i) { LAS unsigned char* d_ = vt + (8 * i + (lane >> 3)) * 136 + (lane & 7) * 16; *(LAS u32x2*)d_ = (u32x2){w_[i].x, w_[i].y}; *(LAS u32x2*)(d_ + 8) = (u32x2){w_[i].z, w_[i].w}; } }
    WAVE_LDS_SYNC(); asm volatile("" ::: "memory");
#pragma unroll
    for (int tk = 0; tk < 2; ++tk) { const int s = lane + 64 * tk; const LAS u32x2* vp = (const LAS u32x2*)(vt + s * 136);
        float x[64];
#pragma unroll
        for (int c4 = 0; c4 < 16; ++c4) { const u32x2 v = vp[c4]; x[4 * c4] = bf2f(v.x & 0xffffu); x[4 * c4 + 1] = bf2f(v.x >> 16); x[4 * c4 + 2] = bf2f(v.y & 0xffffu); x[4 * c4 + 3] = bf2f(v.y >> 16); }
        float sm = 0.f;
#pragma unroll
        for (int i = 0; i < 64; ++i) sm += x[i];
        const float mu = sm * (1.0f / 64.0f); float vr = 0.f;
#pragma unroll
        for (int i = 0; i < 64; ++i) { const float dx = x[i] - mu; vr += dx * dx; }
        MU[s] = mu; RS[s] = __builtin_amdgcn_rsqf(vr * (1.0f / 64.0f) + EPS); }
    WAVE_LDS_SYNC();
    bf16x8 af[2][8];
    { const float g0 = GIN(I_GLNB)[l * 256 + h * 64 + r], g1 = GIN(I_GLNB)[l * 256 + h * 64 + 32 + r];
      const LAS bf16* vcol = (const LAS bf16*)(vt + r * 2);
#pragma unroll
      for (int ks = 0; ks < 8; ++ks) { float a0[8], a1[8];
#pragma unroll
          for (int j = 0; j < 8; ++j) { const int s = 16 * ks + 8 * hf + j; const float mu = MU[s], rs = RS[s];
              a0[j] = (bf2f(vcol[s * 68]) - mu) * rs * g0; a1[j] = (bf2f(vcol[s * 68 + 32]) - mu) * rs * g1; }
          af[0][ks] = pack8(a0[0], a0[1], a0[2], a0[3], a0[4], a0[5], a0[6], a0[7]); af[1][ks] = pack8(a1[0], a1[1], a1[2], a1[3], a1[4], a1[5], a1[6], a1[7]);
          if (ks & 1) asm volatile("" ::: "memory"); } }
#pragma unroll
    for (int tt = 0; tt < 4; ++tt) {
        f32x16 acc[2];
#pragma unroll
        for (int i = 0; i < 16; ++i) { acc[0][i] = 0.f; acc[1][i] = 0.f; }
        const bf16* wrow = wsg + (size_t)(32 * tt + r) * 128 + 8 * hf;
        bf16x8 bw[8];
#pragma unroll
        for (int ks = 0; ks < (tt < 2 ? 4 : 8); ++ks) bw[ks] = *(const bf16x8*)(wrow + 16 * ks);
        asm volatile("" ::: "memory");
#pragma unroll
        for (int ks = 0; ks < (tt < 2 ? 4 : 8); ++ks) { acc[0] = MFMA32(af[0][ks], bw[ks], acc[0]); acc[1] = MFMA32(af[1][ks], bw[ks], acc[1]); }
        const int t = 32 * tt + r; const float bias = GIN(I_BSG)[(l * 4 + h) * 128 + t]; const size_t row = r0 + t; unsigned yw[2][4];
#pragma unroll
        for (int dt = 0; dt < 2; ++dt)
#pragma unroll
            for (int g4 = 0; g4 < 4; ++g4) { const int d0 = 32 * dt + 8 * g4 + 4 * hf; const u32x2 uv = *(const u32x2*)(P + row * NP + PC_UB + h * 64 + d0);
                yw[dt][g4] = q8x4(bf2f(uv.x & 0xffffu) * (acc[dt][4 * g4] + bias), bf2f(uv.x >> 16) * (acc[dt][4 * g4 + 1] + bias), bf2f(uv.y & 0xffffu) * (acc[dt][4 * g4 + 2] + bias), bf2f(uv.y >> 16) * (acc[dt][4 * g4 + 3] + bias)); }
        y_tile_store(wl + 1024, yw, Y + (r0 + 32 * tt) * D + YC_B + h * 64, lane);
    }
    WAVE_LDS_SYNC();
}
template <int W> __device__ __forceinline__ void pool_tile_w(Frame& F, int l, int g, int tile, LAS unsigned char* wl) {
    int lane = F.lane; asm volatile("" : "+v"(lane)); const int r = lane & 31, hf = lane >> 5;
    const size_t row0 = (size_t)tile * 32, row = row0 + r; const int t = (int)(row & (SEQ - 1));
    const bf16* P = WSP(bf16, WS_P); unsigned char* Y = WSP(unsigned char, WS_Y); const bf16* wpt = WSP(bf16, WS_WPT) + (size_t)(l * 4 + g) * 64 * 64;
    const int cnt = (t + 1 < W) ? (t + 1) : W; const float icnt = 1.0f / (float)cnt;
    constexpr int NR = 32 + W - 1, NL = (NR + 7) / 8;
    { const long first = (long)row0 - (W - 1), seq0 = (long)(row0 & ~(size_t)(SEQ - 1));
      u32x4 wv[NL];
#pragma unroll
      for (int k = 0; k < NL; ++k) { const int rr = 8 * k + (lane >> 3); long gr = first + (rr < NR ? rr : NR - 1); gr = gr < seq0 ? seq0 : gr;
          wv[k] = *(const u32x4*)(P + (size_t)gr * NP + PC_XC + g * 64 + (lane & 7) * 8); }
      asm volatile("s_waitcnt lgkmcnt(0)" ::: "memory");
#pragma unroll
      for (int k = 0; k < NL; ++k) { const int rr = 8 * k + (lane >> 3); if (rr < NR) *(LAS u32x4*)(wl + rr * 144 + (lane & 7) * 16) = wv[k]; }
      asm volatile("s_waitcnt lgkmcnt(0)" ::: "memory"); }
    f32x16 acc[2];
#pragma unroll
    for (int i = 0; i < 16; ++i) { acc[0][i] = 0.f; acc[1][i] = 0.f; }
#pragma unroll
    for (int ks = 0; ks < 4; ++ks) { const LAS unsigned char* xp = wl + (W - 1 + r) * 144 + (16 * ks + 8 * hf) * 2;
        u32x4 v[W];
#pragma unroll
        for (int q = 0; q < W; ++q) v[q] = *(const LAS u32x4*)(xp - q * 144);
        float sm[8];
#pragma unroll
        for (int j = 0; j < 8; ++j) sm[j] = 0.f;
#pragma unroll
        for (int q = 0; q < W; ++q) { const float m = (q < cnt) ? 1.0f : 0.0f;
            sm[0] += m * bf2f(v[q].x & 0xffffu); sm[1] += m * bf2f(v[q].x >> 16); sm[2] += m * bf2f(v[q].y & 0xffffu); sm[3] += m * bf2f(v[q].y >> 16);
            sm[4] += m * bf2f(v[q].z & 0xffffu); sm[5] += m * bf2f(v[q].z >> 16); sm[6] += m * bf2f(v[q].w & 0xffffu); sm[7] += m * bf2f(v[q].w >> 16); }
        const bf16x8 bfr = pack8(sm[0] * icnt - bf2f(v[0].x & 0xffffu), sm[1] * icnt - bf2f(v[0].x >> 16), sm[2] * icnt - bf2f(v[0].y & 0xffffu), sm[3] * icnt - bf2f(v[0].y >> 16),
                                 sm[4] * icnt - bf2f(v[0].z & 0xffffu), sm[5] * icnt - bf2f(v[0].z >> 16), sm[6] * icnt - bf2f(v[0].w & 0xffffu), sm[7] * icnt - bf2f(v[0].w >> 16));
        const bf16x8 a0 = *(const bf16x8*)(wpt + (size_t)r * 64 + 16 * ks + 8 * hf), a1 = *(const bf16x8*)(wpt + (size_t)(32 + r) * 64 + 16 * ks + 8 * hf);
        acc[0] = MFMA32(a0, bfr, acc[0]); acc[1] = MFMA32(a1, bfr, acc[1]);
        if (W == 16) asm volatile("" ::: "memory"); }
    const float* sp = GIN(I_SPOOL) + l * 256 + g * 64;
    unsigned yw[2][4];
#pragma unroll
    for (int dt = 0; dt < 2; ++dt)
#pragma unroll
        for (int g4 = 0; g4 < 4; ++g4) { const int d0 = 32 * dt + 8 * g4 + 4 * hf; const f32x4 sv = *(const f32x4*)(sp + d0);
            yw[dt][g4] = q8x4(acc[dt][4 * g4] * sv[0], acc[dt][4 * g4 + 1] * sv[1], acc[dt][4 * g4 + 2] * sv[2], acc[dt][4 * g4 + 3] * sv[3]); }
    y_tile_store(wl + 8192, yw, Y + row0 * D + YC_C + g * 64, lane);
}
__device__ __forceinline__ void pool_tile(Frame& F, int l, int unit, LAS unsigned char* wl) {
    const int g = 3 - (unit >> 10), tile = unit & 1023;
    if (g == 3) pool_tile_w<16>(F, l, 3, tile, wl); else if (g == 2) pool_tile_w<8>(F, l, 2, tile, wl); else if (g == 1) pool_tile_w<4>(F, l, 1, tile, wl); else pool_tile_w<2>(F, l, 0, tile, wl);
}
__device__ __forceinline__ void mix(Frame& F, int l) {
    constexpr int NSC = 64;
    const int gw = F.bid * NWAVES + F.wave, NGW = F.G * NWAVES;
    unsigned* cnt = (unsigned*)(F.ws + WS_CTL) + CW_DNCNT;
    LAS unsigned char* wl = F.lds + F.wave * DN_WLDS;
    for (int u0 = F.bid * NWAVES; u0 < 2048; u0 += NGW) {
        if (u0 + F.wave < 2048) dn_prep(F, l, u0 + F.wave, wl);
        asm volatile("s_waitcnt vmcnt(0)" ::: "memory");
        __syncthreads();
        if (F.tid == 0) { __builtin_amdgcn_fence(__ATOMIC_RELEASE, "agent");
            asm volatile("s_waitcnt vmcnt(0)" ::: "memory");
            const int nch = 2048 - u0 < NWAVES ? 2048 - u0 : NWAVES;
            __hip_atomic_fetch_add(cnt + 64 * (u0 >> 5), (unsigned)nch, __ATOMIC_RELAXED, __HIP_MEMORY_SCOPE_AGENT); }
    }
    if (F.bid < NSC) {
        if (F.wave == 0) {
            const unsigned want = 32u * (unsigned)(l + 1); unsigned spins = 0;
            while ((unsigned)__builtin_amdgcn_readfirstlane(__hip_atomic_load(cnt + 64 * F.bid, __ATOMIC_RELAXED, __HIP_MEMORY_SCOPE_AGENT)) < want) {
                __builtin_amdgcn_s_sleep(2); if (++spins > (1u << 22)) break; }
            __builtin_amdgcn_fence(__ATOMIC_ACQUIRE, "agent");
            asm volatile("s_waitcnt vmcnt(0)" ::: "memory");
            if (F.lane == 0) ((volatile LAS unsigned*)(F.lds + SL_FLAGS))[0] = (unsigned)(l + 1);
            dn_scan_lead(F, l, F.bid);
            return; }
        if (F.wave <= 2) dn_scan_help(F, l, F.bid, F.wave - 1);
        return; }
    const int wi = (F.bid - NSC) * NWAVES + F.wave, NWI = (F.G - NSC) * NWAVES;
    for (int idx = wi; idx < 9216; idx += NWI) {
        if (idx < 1024) sg_tile(F, l, idx, wl);
        else if (idx < 2048) pool_tile(F, l, idx - 1024, wl);
        else if (idx >= 6144) pool_tile(F, l, idx - 6144 + 1024, wl);
        else { const int j = idx - 2048; const int qt = 63 - (j >> 6), bh = j & 63; sb_tile(F, l, bh >> 2, bh & 3, qt, wl); }
    }
}

__device__ __forceinline__ void fin(Frame& F) {
    const int gw = F.bid * NWAVES + F.wave, NGW = F.G * NWAVES; const float* ssq = WSP(float, WS_SSQ1); const float* gf = GIN(I_GFIN); const bf16* xb = WSP(bf16, WS_XB);
    for (int r = gw; r < M; r += 2 * NGW) { const int r2 = r + NGW < M ? r + NGW : r;
        const float rsa = pg8::row_rstd(ssq, r), rsb = pg8::row_rstd(ssq, r2);
        u32x4 va[2], vb[2];
#pragma unroll
        for (int j = 0; j < 2; ++j) { va[j] = *(const u32x4*)(xb + (size_t)r * D + 512 * j + 8 * F.lane); vb[j] = *(const u32x4*)(xb + (size_t)r2 * D + 512 * j + 8 * F.lane); }
#pragma unroll
        for (int j = 0; j < 2; ++j) { const int cc = 512 * j + 8 * F.lane; const f32x4 g0 = *(const f32x4*)(gf + cc), g1 = *(const f32x4*)(gf + cc + 4);
            const f32x4 a0 = (f32x4){bf2f(va[j].x & 0xffffu), bf2f(va[j].x >> 16), bf2f(va[j].y & 0xffffu), bf2f(va[j].y >> 16)}, a1 = (f32x4){bf2f(va[j].z & 0xffffu), bf2f(va[j].z >> 16), bf2f(va[j].w & 0xffffu), bf2f(va[j].w >> 16)};
            const f32x4 b0 = (f32x4){bf2f(vb[j].x & 0xffffu), bf2f(vb[j].x >> 16), bf2f(vb[j].y & 0xffffu), bf2f(vb[j].y >> 16)}, b1 = (f32x4){bf2f(vb[j].z & 0xffffu), bf2f(vb[j].z >> 16), bf2f(vb[j].w & 0xffffu), bf2f(vb[j].w >> 16)};
            *(f32x4*)(as_global(F.out) + (size_t)r * D + cc) = a0 * rsa * g0; *(f32x4*)(as_global(F.out) + (size_t)r * D + cc + 4) = a1 * rsa * g1;
            if (r2 != r) { *(f32x4*)(as_global(F.out) + (size_t)r2 * D + cc) = b0 * rsb * g0; *(f32x4*)(as_global(F.out) + (size_t)r2 * D + cc + 4) = b1 * rsb * g1; } } }
}
#ifndef MK_PER_PHASE
#define MK_PER_PHASE 0
#endif
constexpr int N_PHASES = 2 + 6 * DEPTH + 1;
struct Args { const float* in[N_IN]; float* out; unsigned char* ws; int ph_lo, ph_hi; };
__global__ void __launch_bounds__(NTHR, 2) fwd(Args args) {
    extern __shared__ __attribute__((aligned(16))) unsigned char lds_raw[];
    Frame F;
    F.lds = (LAS unsigned char*)lds_raw;
    F.tid = threadIdx.x; F.lane = F.tid & 63; F.wave = __builtin_amdgcn_readfirstlane(F.tid >> 6);
    F.G = gridDim.x; F.bid = blockIdx.x; F.ws = args.ws; F.out = args.out;
    F.in = args.in;
    volatile LAS unsigned* MISC = (volatile LAS unsigned*)(F.lds + MISC_OFF);
    if (F.tid < 32) MISC[F.tid] = 0u;
    if (F.tid < 128) ((volatile LAS unsigned*)(F.lds + 163072))[F.tid] = 0u;
    __syncthreads();
    XcdBarrier bar; bar.bar = (unsigned*)(F.ws + WS_CTL) + CW_BAR; bar.x = 0; bar.st = nullptr;
    if (F.tid == 0) { const unsigned xcc = xb_xcc_id(); MISC[12] = xcc; MISC[13] = __hip_atomic_fetch_add((unsigned*)(F.ws + WS_CTL) + CW_XRANK + 64 * (xcc & 15), 1u, __ATOMIC_RELAXED, __HIP_MEMORY_SCOPE_AGENT); }
    int vc = F.bid;
    if (!MK_PER_PHASE) bar = xcd_barrier_post((unsigned*)(F.ws + WS_CTL) + CW_BAR, MISC + 8);
    const int lo = args.ph_lo, hi = args.ph_hi;
#define IN(k) (lo <= (k) && (k) < hi)
#define SEAMX() do { XcdBarrier b2_ = bar; unsigned* p_ = b2_.bar; unsigned x_ = b2_.x; asm volatile("" : "+s"(p_), "+s"(x_)); b2_.bar = p_; b2_.x = x_; xcd_barrier(b2_); } while (0)
#define FILL_TABLES(ssqp, swp, swld, goap, qsap, qsbp) do { const float* q_ = (ssqp); const float* s_ = (swp); const float* g_ = (goap); const float* qa_ = (qsap); const float* qb_ = (qsbp); \
    LAS float* tr_ = (LAS float*)(F.lds + RING_BYTES); LAS float* ts_ = tr_ + 2048; LAS float* tg_ = ts_ + 2048; LAS int* ul_ = (LAS int*)(tg_ + 256); LAS float* tq_ = tg_ + 512; \
      \
    if (F.tid == 0) { for (int i_ = 0; i_ < 8; ++i_) { pg8::Unit u_; const bool k_ = S.next(i_, u_); ul_[2 * i_] = k_ ? u_.pm : -1; ul_[2 * i_ + 1] = k_ ? u_.pn : 0; } } \
    asm volatile("s_waitcnt lgkmcnt(0)" ::: "memory"); __builtin_amdgcn_s_barrier(); \
    if (F.tid < 256) { float t_[8], a_s[8]; \
        _Pragma("unroll") for (int i_ = 0; i_ < 8; ++i_) { const int pm_ = ul_[2 * i_]; t_[i_] = 0.f; a_s[i_] = 1.f; if (pm_ >= 0) { const pg8::f32x4* p_ = (const pg8::f32x4*)(q_ + (size_t)(pm_ * 256 + F.tid) * 16); const pg8::f32x4 a_ = p_[0], b_ = p_[1], c_ = p_[2], d_ = p_[3]; \
            t_[i_] = ((a_[0] + a_[1]) + (a_[2] + a_[3])) + ((b_[0] + b_[1]) + (b_[2] + b_[3])) + ((c_[0] + c_[1]) + (c_[2] + c_[3])) + ((d_[0] + d_[1]) + (d_[2] + d_[3])); if (qa_) a_s[i_] = qa_[pm_ * 256 + F.tid]; } } \
        _Pragma("unroll") for (int i_ = 0; i_ < 8; ++i_) tr_[i_ * 256 + F.tid] = __builtin_amdgcn_rsqf(t_[i_] * (1.0f / 1024.0f) + 1e-6f) * a_s[i_]; \
        if (g_) tg_[F.tid] = g_[F.tid]; } \
    else { float v_[8], w_[8]; \
        _Pragma("unroll") for (int i_ = 0; i_ < 8; ++i_) { const int pm_ = ul_[2 * i_], pn_ = ul_[2 * i_ + 1]; v_[i_] = pm_ >= 0 ? s_[(size_t)(pm_ >> 3) * (swld) + pn_ * 256 + F.tid - 256] : 0.f; w_[i_] = (pm_ >= 0 && qb_) ? qb_[pn_ * 256 + F.tid - 256] : 1.f; } \
        _Pragma("unroll") for (int i_ = 0; i_ < 8; ++i_) { ts_[i_ * 256 + F.tid - 256] = v_[i_]; tq_[i_ * 256 + F.tid - 256] = w_[i_]; } } \
    asm volatile("s_waitcnt lgkmcnt(0)" ::: "memory"); __builtin_amdgcn_s_barrier(); } while (0)
#define FILL_RTAB(gatep, gnp, scp, qrefp, qsap, hsp, hcp) do { const float* ga_ = (gatep); const float* gn_ = (gnp); const float* sc_ = (scp); const float* qr_ = (qrefp); float* qa_ = (qsap); const float* hs_ = (hsp); const int* hc_ = (hcp); \
    LAS float* tis_ = (LAS float*)(F.lds + RING_BYTES); LAS float* tgs_ = tis_ + 1024; LAS float* tG_ = tgs_ + 1024; LAS int* thc_ = (LAS int*)(tG_ + 1024); LAS int* ul_ = thc_ + 1024; \
    if (F.tid == 0) { for (int i_ = 0; i_ < 4; ++i_) { pg8::Unit u_; const bool k_ = S.next(i_, u_); ul_[2 * i_] = k_ ? u_.pm : -1; ul_[2 * i_ + 1] = k_ ? u_.pn : 0; } } \
    asm volatile("s_waitcnt lgkmcnt(0)" ::: "memory"); __builtin_amdgcn_s_barrier(); \
    if (F.tid < 256) { float t_[4]; \
        _Pragma("unroll") for (int i_ = 0; i_ < 4; ++i_) { const int pm_ = ul_[2 * i_]; t_[i_] = 0.f; if (pm_ >= 0 && qr_) { const pg8::f32x4* p_ = (const pg8::f32x4*)(qr_ + (size_t)(pm_ * 256 + F.tid) * 16); const pg8::f32x4 a_ = p_[0], b_ = p_[1], c_ = p_[2], d_ = p_[3]; \
            t_[i_] = ((a_[0] + a_[1]) + (a_[2] + a_[3])) + ((b_[0] + b_[1]) + (b_[2] + b_[3])) + ((c_[0] + c_[1]) + (c_[2] + c_[3])) + ((d_[0] + d_[1]) + (d_[2] + d_[3])); } } \
        _Pragma("unroll") for (int i_ = 0; i_ < 4; ++i_) { const int pm_ = ul_[2 * i_], pn_ = ul_[2 * i_ + 1]; float v_ = 0.f; if (pm_ >= 0 && qr_) { const float rr_ = __builtin_amdgcn_rsqf(t_[i_] * (1.0f / 1024.0f) + 1e-6f); v_ = 127.0f * rr_ * (1.0f / pg8::QCLIP8); if (pn_ == 0) qa_[pm_ * 256 + F.tid] = pg8::QCLIP8 / (127.0f * rr_); } \
            tis_[i_ * 256 + F.tid] = v_; } } \
    else { const int c_ = F.tid - 256; float g_[4], G_[4]; int h_[4]; \
        _Pragma("unroll") for (int i_ = 0; i_ < 4; ++i_) { const int pm_ = ul_[2 * i_], col_ = ul_[2 * i_ + 1] * 256 + c_; g_[i_] = 0.f; G_[i_] = 0.f; h_[i_] = 0; \
            if (pm_ >= 0) { g_[i_] = ga_[(size_t)(pm_ >> 3) * 6144 + col_]; if (hs_) { g_[i_] *= hs_[col_]; if (hc_) h_[i_] = __builtin_bit_cast(int, g_[i_] * (float)(hc_[col_] * 128)); } if (gn_) G_[i_] = gn_[col_] * (sc_[(size_t)(pm_ >> 3) * 6144 + col_] + 1.0f); } } \
        _Pragma("unroll") for (int i_ = 0; i_ < 4; ++i_) { tgs_[i_ * 256 + c_] = g_[i_]; tG_[i_ * 256 + c_] = G_[i_]; thc_[i_ * 256 + c_] = h_[i_]; } } \
    asm volatile("s_waitcnt lgkmcnt(0)" ::: "memory"); __builtin_amdgcn_s_barrier(); } while (0)
#define RTABS (const LAS float*)(F.lds + RING_BYTES), (const LAS float*)(F.lds + RING_BYTES + 4096), (const LAS float*)(F.lds + RING_BYTES + 8192), (const LAS int*)(F.lds + RING_BYTES + 12288)
#define FRESH() do { int t_ = threadIdx.x; asm volatile("" : "+v"(t_)); F.tid = t_; F.lane = t_ & 63; F.wave = __builtin_amdgcn_readfirstlane(t_ >> 6); unsigned long long z_ = 0ull; asm volatile("" : "+s"(z_)); F.ws = args.ws + z_; } while (0)
#define SEAM(k) do { if (!MK_PER_PHASE && IN(k) && IN((k) + 1)) { XcdBarrier b2_ = bar; unsigned* p_ = b2_.bar; unsigned x_ = b2_.x; asm volatile("" : "+s"(p_), "+s"(x_)); b2_.bar = p_; b2_.x = x_; xcd_barrier(b2_); } } while (0)

    #ifndef SKIP_P0
    if (IN(0)) { FRESH(); p0a(F); }
#endif
    SEAM(0);
    if (!MK_PER_PHASE) { bool even = (F.G % 8 == 0); for (int j = 0; j < 16; ++j) { const unsigned n_ = __hip_atomic_load((unsigned*)(F.ws + WS_CTL) + CW_XRANK + 64 * j, __ATOMIC_RELAXED, __HIP_MEMORY_SCOPE_AGENT); even = even && ((unsigned)__builtin_amdgcn_readfirstlane((int)n_) == (j < 8 ? (unsigned)F.G / 8u : 0u)); }
        if (even) vc = __builtin_amdgcn_readfirstlane((int)(MISC[13] * 8u + MISC[12])); }
    #ifndef SKIP_P0
    if (IN(1)) { FRESH(); p0b(F); }
#if defined(PROBE_REP) && PROBE_REP == 9
    SEAMX(); if (IN(0)) { FRESH(); p0a(F); } SEAMX(); if (IN(1)) { FRESH(); p0b(F); }
#endif
#endif
    SEAM(1);
    for (int l = 0; l < DEPTH; ++l) {
        const int pb = 2 + 6 * l;
#define modl (WSP(float, WS_MOD) + (size_t)l * 16 * NMOD)
#ifndef SKIP_G1
        if (IN(pb)) {
            FRESH();
            pg8::Gemm g{WSP(bf16, WS_XG), WSP(bf16, WS_WIN) + (size_t)l * NP * D, M, NP, D / 2, D / 2, D};     pg8::StaticOrder S; S.init(M, NP, F.G, vc);
            pg8::EpiNormed<0, true> E{WSP(bf16, WS_P), NP, (const LAS float*)(F.lds + RING_BYTES), (const LAS float*)(F.lds + RING_BYTES + 8192), (const LAS float*)(F.lds + RING_BYTES + 16384), (const LAS float*)(F.lds + RING_BYTES + 16384 + 2048)};
            { auto pre = [&]() { FILL_TABLES(WSP(float, WS_SSQ1), WSP(float, WS_SW1) + (size_t)l * 16 * NP, NP, GIN(I_GOA) + l * 256, WSP(float, WS_QSA1), WSP(float, WS_QSB1) + (size_t)l * NP); }; pg8::gemm_phase<pg8::EpiNormed<0, true>, pg8::StaticOrder, true, true>(F.lds, g, S, E, pre); }
#if defined(PROBE_REP) && PROBE_REP == 6
            SEAMX(); FRESH(); pg8::gemm_phase<pg8::EpiNormed<0, true>, pg8::StaticOrder, true, true>(F.lds, g, S, E);
#endif
#ifndef SKIP_AB
            FRESH(); ab_logits(F, l);
#if defined(PROBE_REP) && PROBE_REP == 11
            SEAMX(); FRESH(); ab_logits(F, l);
#endif
#endif
        }
#endif
        SEAM(pb);
        if (IN(pb + 1)) { FRESH(); mix(F, l); }
        SEAM(pb + 2);
#ifndef SKIP_G2
        if (IN(pb + 3)) {
            FRESH();
            pg8::Gemm g{WSP(bf16, WS_Y), WSP(bf16, WS_WOUT) + (size_t)l * D * D, M, D, D / 2, D / 2, D};     pg8::StaticOrder S; S.init(M, D, F.G, vc);
            { pg8::EpiResid<false, false, true, true> E{WSP(bf16, WS_XB), WSP(bf16, WS_XB), WSP(bf16, WS_XQ), WSP(float, WS_SSQ2), RTABS};
                auto pre = [&]() { FILL_RTAB(modl + 2 * D, GIN(I_GN2) + (size_t)l * D, modl + 4 * D, WSP(float, WS_SSQ1), WSP(float, WS_QSA), WSP(float, WS_QSBO) + l * D, (const int*)nullptr); }; pg8::gemm_phase<pg8::EpiResid<false, false, true, true>, pg8::StaticOrder, true, true>(F.lds, g, S, E, pre); }
        }
#endif
        SEAM(pb + 3);
#ifndef SKIP_G3
        if (IN(pb + 4)) {
            FRESH();
            pg8::Gemm g{WSP(bf16, WS_XQ), WSP(bf16, WS_WFF1) + (size_t)l * FF * D, M, FF, D / 2, D / 2, D};     pg8::StaticOrder S; S.init(M, FF, F.G, vc);
            pg8::EpiNormed<1, true, true> E{WSP(bf16, WS_HID), FF, (const LAS float*)(F.lds + RING_BYTES), (const LAS float*)(F.lds + RING_BYTES + 8192), (const LAS float*)nullptr, (const LAS float*)(F.lds + RING_BYTES + 16384 + 2048)};
            { auto pre = [&]() { FILL_TABLES(WSP(float, WS_SSQ2), WSP(float, WS_SW2) + (size_t)l * 16 * FF, FF, (const float*)nullptr, WSP(float, WS_QSA), WSP(float, WS_QSB) + (size_t)l * FF); }; pg8::gemm_phase<pg8::EpiNormed<1, true, true>, pg8::StaticOrder, true, true>(F.lds, g, S, E, pre); }
#if defined(PROBE_REP) && PROBE_REP == 8
            { SEAMX(); FRESH(); pg8::EpiNull EN{WSP(float, WS_BETA)}; pg8::gemm_phase<pg8::EpiNull, pg8::StaticOrder, true, true>(F.lds, g, S, EN); }
#endif
#if defined(PROBE_REP) && PROBE_REP == 12
            { SEAMX(); FRESH(); pg8::EpiNormed<1, true, true> E2 = E; E2.nost = (args.ph_hi != 12345); pg8::gemm_phase<pg8::EpiNormed<1, true, true>, pg8::StaticOrder, true, true>(F.lds, g, S, E2); }
#endif
#if defined(PROBE_REP) && PROBE_REP == 7
            SEAMX(); FRESH(); pg8::gemm_phase<pg8::EpiNormed<1, true, true>, pg8::StaticOrder, true, true>(F.lds, g, S, E);
#endif
        }
#endif
        SEAM(pb + 4);
#ifndef SKIP_G4
        if (IN(pb + 5)) {
            FRESH();
            pg8::Gemm g{WSP(bf16, WS_HID), WSP(bf16, WS_WFF2) + (size_t)l * D * FF, M, D, FF / 2, FF / 2, FF};     pg8::StaticOrder S; S.init(M, D, F.G, vc);
            const bool more = l + 1 < DEPTH;
            if (more) {
                pg8::EpiResid<false, false, true, true> E{WSP(bf16, WS_XB), WSP(bf16, WS_XB), WSP(bf16, WS_XG), WSP(float, WS_SSQ1), RTABS};
                auto pre = [&]() { FILL_RTAB(modl + 5 * D, GIN(I_GN1) + (size_t)(l + 1) * D, modl + 16 * NMOD + D, WSP(float, WS_SSQ2), WSP(float, WS_QSA1), WSP(float, WS_QSB2) + l * D, WSP(int, WS_QCS2) + l * D); }; pg8::gemm_phase<pg8::EpiResid<false, false, true, true>, pg8::StaticOrder, true, true>(F.lds, g, S, E, pre); }
            else {
                pg8::EpiResid<false, false, false, true> E{WSP(bf16, WS_XB), WSP(bf16, WS_XB), (bf16*)nullptr, WSP(float, WS_SSQ1), RTABS};
                auto pre = [&]() { FILL_RTAB(modl + 5 * D, (const float*)nullptr, (const float*)nullptr, (const float*)nullptr, (float*)nullptr, WSP(float, WS_QSB2) + l * D, WSP(int, WS_QCS2) + l * D); }; pg8::gemm_phase<pg8::EpiResid<false, false, false, true>, pg8::StaticOrder, true, true>(F.lds, g, S, E, pre); }
        }
#endif
        SEAM(pb + 5);
    }
#ifndef SKIP_FIN
    if (IN(N_PHASES - 1)) { FRESH(); fin(F); }
#endif
#undef modl
#undef IN
#undef SEAM
}

extern "C" void kernel_launch(void* const* d_in, const int* in_sizes, int n_in, void* d_out, int out_size, void* d_ws, size_t ws_size, hipStream_t stream) {
    static int grid = 0;
    if (grid == 0) {
        if (n_in != N_IN || in_sizes[0] != M * D || out_size != M * D || ws_size < WS_END) { fprintf(stderr, "kernel_launch: unexpected shapes (n_in %d, in0 %d, out %d, ws %zu); nothing launched\n", n_in, n_in > 0 ? in_sizes[0] : -1, out_size, ws_size); grid = -1; return; }
        int dev = 0, cus = 0, per_cu = 0;
        if (hipGetDevice(&dev) != hipSuccess || hipDeviceGetAttribute(&cus, hipDeviceAttributeMultiprocessorCount, dev) != hipSuccess) { fprintf(stderr, "kernel_launch: device query failed\n"); grid = -1; return; }
        if (hipFuncSetAttribute((const void*)fwd, hipFuncAttributeMaxDynamicSharedMemorySize, LDS_BYTES) != hipSuccess) { fprintf(stderr, "kernel_launch: hipFuncSetAttribute failed\n"); grid = -1; return; }
        if (hipOccupancyMaxActiveBlocksPerMultiprocessor(&per_cu, (const void*)fwd, NTHR, LDS_BYTES) != hipSuccess || per_cu < 1) fprintf(stderr, "kernel_launch: note: occupancy query reports %d workgroups per CU\n", per_cu);
        (void)hipGetLastError();
        grid = cus;
    }
    if (grid < 0) return;
    if (hipMemsetAsync((char*)d_ws + WS_CTL, 0, CTL_ZERO_BYTES, stream) != hipSuccess) { fprintf(stderr, "kernel_launch: memset failed\n"); return; }
    Args a{};
    for (int i = 0; i < N_IN; ++i) a.in[i] = (const float*)d_in[i];
    a.out = (float*)d_out; a.ws = (unsigned char*)d_ws;
#if MK_PER_PHASE
    for (int ph = 0; ph < N_PHASES; ++ph) { a.ph_lo = ph; a.ph_hi = ph + 1; hipLaunchKernelGGL(fwd, dim3(grid), dim3(NTHR), LDS_BYTES, stream, a); }
#else
    a.ph_lo = 0; a.ph_hi = N_PHASES; hipLaunchKernelGGL(fwd, dim3(grid), dim3(NTHR), LDS_BYTES, stream, a);
#endif
    const hipError_t le = hipPeekAtLastError();
    if (le != hipSuccess) fprintf(stderr, "kernel_launch: launch failed: %s\n", hipGetErrorName(le));
}
```

```cpp
#include <hip/hip_runtime.h>
#include <cstdio>
#include <cstdint>
#define MK_PER_PHASE 0
namespace pg8 {
#define PG8_LAS __attribute__((address_space(3)))
typedef unsigned short bf16_t;
typedef short bf16x8 __attribute__((ext_vector_type(8)));
typedef float f32x4 __attribute__((ext_vector_type(4)));
typedef unsigned u32x4 __attribute__((ext_vector_type(4)));
constexpr int BM = 256, BK = 64, HALF = 128, HTB = HALF * BK * 2  , STAGE_BYTES = 8 * HTB, NXCD = 8, WGM = 8;

__host__ __device__ __forceinline__ int lds_byte(int r, int c) { const int st = (r >> 4) * 2 + (c >> 5), rr = r & 15, cc = c & 31, ob = rr * 64 + cc * 2; return st * 1024 + (ob ^ (((ob >> 9) & 1) << 5)); }
__host__ __device__ __forceinline__ void stage_rc(int b, int& R, int& C) { const int st = b / 1024, sb = b % 1024, swz = sb ^ (((sb >> 9) & 1) << 5); R = (st >> 1) * 16 + swz / 64; C = (st & 1) * 32 + (swz % 64) / 2; }
__host__ __device__ __forceinline__ int perm32(int rho) { const int n = rho >> 4, i = rho & 15; return 8 * (i >> 2) + 4 * n + (i & 3); }

struct Unit { int pm, pn, slot; };
struct Gemm { const bf16_t* A; const bf16_t* Bt; int M, N, K, lda, ldb; };
typedef int i32x4 __attribute__((ext_vector_type(4)));

struct StaticOrder {
    int nM, nN, nwg, G, c;
    __host__ __device__ __forceinline__ void init(int M, int N, int G_, int c_) { nM = M / BM; nN = N / BM; nwg = nM * nN; G = G_; c = c_; }
    __host__ __device__ __forceinline__ bool next(int i, Unit& u) const {
        const int L = i * G + c; if (L >= nwg) return false;
        int wgid = L; { const int q = nwg / NXCD, r = nwg % NXCD, xcd = wgid % NXCD, off = wgid / NXCD; wgid = (xcd < r ? xcd * (q + 1) : r * (q + 1) + (xcd - r) * q) + off; }
        const int nig = WGM * nN, gid = wgid / nig, fm = gid * WGM, gsz = (nM - fm) < WGM ? (nM - fm) : WGM;
        u.pm = fm + ((wgid % nig) % gsz); u.pn = (wgid % nig) / gsz; u.slot = i; return true;
    }
    __device__ __forceinline__ void a_ready(const Unit&) const {}
    __device__ __forceinline__ void done(const Unit&) const {}
};
__device__ __forceinline__ unsigned cvt_pk_bf16(float lo, float hi) { unsigned r; asm volatile("v_cvt_pk_bf16_f32 %0, %1, %2" : "=v"(r) : "v"(lo), "v"(hi)); return r; }
typedef float f32x2 __attribute__((ext_vector_type(2))); typedef unsigned u32x2_t __attribute__((ext_vector_type(2)));
constexpr float QCLIP8 = 8.0f;
constexpr float HCLIP8 = 40.0f;
__device__ __forceinline__ float row_rstd(const float* ssq, int row) {
    const f32x4* p = (const f32x4*)(ssq + (size_t)row * 16);
    const f32x4 a = p[0], b = p[1], c = p[2], d = p[3];
    const float s = ((a[0] + a[1]) + (a[2] + a[3])) + ((b[0] + b[1]) + (b[2] + b[3])) + ((c[0] + c[1]) + (c[2] + c[3])) + ((d[0] + d[1]) + (d[2] + d[3]));
    return __builtin_amdgcn_rsqf(s * (1.0f / 1024.0f) + 1e-6f);
}
template <int ACT, bool I8_ = false, bool OUT8 = false> struct EpiNormed {
    static constexpr bool PERM = true, AFTER_DRAIN = false, I8 = I8_, P16 = OUT8;
    bf16_t* O; int ldc; const PG8_LAS float* rtab; const PG8_LAS float* stab; const PG8_LAS float* gtab; const PG8_LAS float* qtab; int nost = 0;
    __device__ __forceinline__ void operator()(const f32x4 (&acc)[2][2][4][2], const Unit& u, int wr, int wc, int fr, int fq) const {
        const int lc0 = P16 ? wc * 64 + 16 * fq : wc * 32 + 8 * fq;
        constexpr int BJS = P16 ? 8 : HALF;
        const int row0 = u.pm * BM + wr * 64 + fr, col0 = u.pn * BM + lc0;
        f32x4 bv[2][2];
#pragma unroll
        for (int bj = 0; bj < 2; ++bj)
#pragma unroll
            for (int n = 0; n < 2; ++n) { bv[bj][n] = *(const PG8_LAS f32x4*)(stab + u.slot * BM + lc0 + bj * BJS + 4 * n); if (OUT8) bv[bj][n] = bv[bj][n] * __builtin_sqrtf(255.0f / HCLIP8); }
        const bool gsel = (ACT == 0) && gtab != nullptr && u.pn == 3;
        f32x4 gv[2][2];
#pragma unroll
        for (int bj = 0; bj < 2; ++bj)
#pragma unroll
            for (int n = 0; n < 2; ++n) gv[bj][n] = I8 ? *(const PG8_LAS f32x4*)(qtab + u.slot * BM + lc0 + bj * BJS + 4 * n) : (f32x4){1.f, 1.f, 1.f, 1.f};
#pragma unroll
        for (int ai = 0; ai < 2; ++ai)
#pragma unroll
            for (int m = 0; m < 4; ++m) { const int row = row0 + ai * HALF + m * 16; float rs = rtab[u.slot * BM + wr * 64 + fr + ai * HALF + m * 16]; if (OUT8) rs *= __builtin_sqrtf(255.0f / HCLIP8);
                bf16_t* rowp = O + (size_t)row * ldc + col0; u32x2_t wlo = {0u, 0u};
#pragma unroll
                for (int bj = 0; bj < 2; ++bj) { f32x4 a0 = acc[ai][bj][m][0], a1 = acc[ai][bj][m][1];
                    if (I8) { a0 = __builtin_convertvector(__builtin_bit_cast(i32x4, a0), f32x4); a1 = __builtin_convertvector(__builtin_bit_cast(i32x4, a1), f32x4); }
                    f32x4 v0, v1;
                    {
                        const f32x2 rs2 = {rs, rs};
                        f32x2 p0 = {a0[0], a0[1]}, p1 = {a0[2], a0[3]}, p2 = {a1[0], a1[1]}, p3 = {a1[2], a1[3]};
                        if (I8) { p0 = p0 * (f32x2){gv[bj][0][0], gv[bj][0][1]}; p1 = p1 * (f32x2){gv[bj][0][2], gv[bj][0][3]}; p2 = p2 * (f32x2){gv[bj][1][0], gv[bj][1][1]}; p3 = p3 * (f32x2){gv[bj][1][2], gv[bj][1][3]}; }
                        p0 = __builtin_elementwise_fma(p0, rs2, (f32x2){bv[bj][0][0], bv[bj][0][1]}); p1 = __builtin_elementwise_fma(p1, rs2, (f32x2){bv[bj][0][2], bv[bj][0][3]});
                        p2 = __builtin_elementwise_fma(p2, rs2, (f32x2){bv[bj][1][0], bv[bj][1][1]}); p3 = __builtin_elementwise_fma(p3, rs2, (f32x2){bv[bj][1][2], bv[bj][1][3]});
                        v0 = (f32x4){p0[0], p0[1], p1[0], p1[1]}; v1 = (f32x4){p2[0], p2[1], p3[0], p3[1]}; }
                    if (gsel) { const f32x4 gg0 = *(const PG8_LAS f32x4*)(gtab + lc0 + bj * BJS), gg1 = *(const PG8_LAS f32x4*)(gtab + lc0 + bj * BJS + 4);
#pragma unroll
                        for (int j = 0; j < 4; ++j) { v0[j] = v0[j] * __builtin_amdgcn_rcpf(1.0f + __expf(-v0[j])) * gg0[j]; v1[j] = v1[j] * __builtin_amdgcn_rcpf(1.0f + __expf(-v1[j])) * gg1[j]; } }
                    if (ACT == 1 && !OUT8) {
#pragma unroll
                        for (int j = 0; j < 4; ++j) { const float a = fmaxf(v0[j], 0.f), b = fmaxf(v1[j], 0.f); v0[j] = a * a; v1[j] = b * b; } }
                    if (OUT8) {
                        unsigned w0 = 0u, w1 = 0u;
#pragma unroll
                        for (int j = 0; j < 4; ++j) { w0 = __builtin_amdgcn_cvt_pk_u8_f32(v0[j] * __builtin_fabsf(v0[j]), j, w0); w1 = __builtin_amdgcn_cvt_pk_u8_f32(v1[j] * __builtin_fabsf(v1[j]), j, w1); }
                        if (bj == 0) { wlo.x = w0 ^ 0x80808080u; wlo.y = w1 ^ 0x80808080u; }
                        else { u32x4 w; w.x = wlo.x; w.y = wlo.y; w.z = w0 ^ 0x80808080u; w.w = w1 ^ 0x80808080u;
#ifdef PROBE_REP
                            if (nost) { asm volatile("" :: "v"(w.x), "v"(w.y), "v"(w.z), "v"(w.w)); } else
#endif
                            *(u32x4*)((unsigned char*)O + (size_t)row * ldc + col0) = w; } }
                    else { u32x4 w; w.x = cvt_pk_bf16(v0[0], v0[1]); w.y = cvt_pk_bf16(v0[2], v0[3]); w.z = cvt_pk_bf16(v1[0], v1[1]); w.w = cvt_pk_bf16(v1[2], v1[3]);
                        *(u32x4*)(rowp + bj * BJS) = w; } } }
    }
};
template <bool XI32, bool XO32, bool XQ8 = false, bool I8_ = false> struct EpiResid {
    static constexpr bool PERM = true, AFTER_DRAIN = false, I8 = I8_, P16 = false;
    const void* xi; void* xo; bf16_t* xg; float* ssq; const PG8_LAS float* tis; const PG8_LAS float* tgs; const PG8_LAS float* tG; const PG8_LAS int* thc;
    __device__ __forceinline__ void operator()(const f32x4 (&acc)[2][2][4][2], const Unit& u, int wr, int wc, int fr, int fq) const {
        const int row0 = u.pm * BM + wr * 64 + fr, col0 = u.pn * BM + wc * 32 + 8 * fq, lc0 = u.slot * BM + wc * 32 + 8 * fq;
        f32x2 sq[2][4]; float isq[2][4];
#pragma unroll
        for (int ai = 0; ai < 2; ++ai)
#pragma unroll
            for (int m = 0; m < 4; ++m) { sq[ai][m] = (f32x2){0.f, 0.f}; isq[ai][m] = XQ8 ? tis[u.slot * BM + wr * 64 + fr + ai * HALF + m * 16] : 0.f; }
#pragma unroll
        for (int bj = 0; bj < 2; ++bj) {
            const int col = col0 + bj * HALF, lc = lc0 + bj * HALF;
            const f32x4 g0 = *(const PG8_LAS f32x4*)(tgs + lc), g1 = *(const PG8_LAS f32x4*)(tgs + lc + 4);
            f32x4 G0 = (f32x4){0.f, 0.f, 0.f, 0.f}, G1 = G0, hc0 = G0, hc1 = G0;
            if (I8) { hc0 = *(const PG8_LAS f32x4*)((const PG8_LAS float*)thc + lc); hc1 = *(const PG8_LAS f32x4*)((const PG8_LAS float*)thc + lc + 4); }
            if (xg) { G0 = *(const PG8_LAS f32x4*)(tG + lc); G1 = *(const PG8_LAS f32x4*)(tG + lc + 4); }
#pragma unroll
            for (int ai = 0; ai < 2; ++ai)
#pragma unroll
                for (int m = 0; m < 4; ++m) { const int row = row0 + ai * HALF + m * 16; const size_t off = (size_t)row * 1024 + col;
                    f32x4 x0, x1;
                    if (XI32) { x0 = *(const f32x4*)((const float*)xi + off); x1 = *(const f32x4*)((const float*)xi + off + 4); }
                    else { const u32x4 xv = *(const u32x4*)((const bf16_t*)xi + off);
                        x0 = (f32x4){__uint_as_float(xv.x << 16), __uint_as_float(xv.x & 0xffff0000u), __uint_as_float(xv.y << 16), __uint_as_float(xv.y & 0xffff0000u)};
                        x1 = (f32x4){__uint_as_float(xv.z << 16), __uint_as_float(xv.z & 0xffff0000u), __uint_as_float(xv.w << 16), __uint_as_float(xv.w & 0xffff0000u)}; }
                    f32x4 a0 = acc[ai][bj][m][0], a1 = acc[ai][bj][m][1];
                    if (I8) { a0 = __builtin_convertvector(__builtin_bit_cast(i32x4, a0), f32x4); a1 = __builtin_convertvector(__builtin_bit_cast(i32x4, a1), f32x4); x0 = x0 + hc0; x1 = x1 + hc1; }
                    const f32x4 y0 = x0 + g0 * a0, y1 = x1 + g1 * a1;
                    if (XO32) { *(f32x4*)((float*)xo + off) = y0; *(f32x4*)((float*)xo + off + 4) = y1; }
                    else { u32x4 w; w.x = cvt_pk_bf16(y0[0], y0[1]); w.y = cvt_pk_bf16(y0[2], y0[3]); w.z = cvt_pk_bf16(y1[0], y1[1]); w.w = cvt_pk_bf16(y1[2], y1[3]); *(u32x4*)((bf16_t*)xo + off) = w; }
                    { const f32x2 ya = {y0[0], y0[1]}, yb = {y0[2], y0[3]}, yc = {y1[0], y1[1]}, yd = {y1[2], y1[3]}; sq[ai][m] = __builtin_elementwise_fma(ya, ya, sq[ai][m]); sq[ai][m] = __builtin_elementwise_fma(yb, yb, sq[ai][m]); sq[ai][m] = __builtin_elementwise_fma(yc, yc, sq[ai][m]); sq[ai][m] = __builtin_elementwise_fma(yd, yd, sq[ai][m]); }
                    if (xg) { f32x4 z0 = y0 * G0, z1 = y1 * G1;
                        if (XQ8) { const f32x2 is2 = {isq[ai][m], isq[ai][m]}, c128 = {128.0f, 128.0f};
                            { const f32x2 q0 = __builtin_elementwise_fma((f32x2){z0[0], z0[1]}, is2, c128), q1 = __builtin_elementwise_fma((f32x2){z0[2], z0[3]}, is2, c128), q2 = __builtin_elementwise_fma((f32x2){z1[0], z1[1]}, is2, c128), q3 = __builtin_elementwise_fma((f32x2){z1[2], z1[3]}, is2, c128);
                              z0 = (f32x4){q0[0], q0[1], q1[0], q1[1]}; z1 = (f32x4){q2[0], q2[1], q3[0], q3[1]}; }
                            unsigned w0 = 0u, w1 = 0u;
#pragma unroll
                            for (int j = 0; j < 4; ++j) { w0 = __builtin_amdgcn_cvt_pk_u8_f32(z0[j], j, w0); w1 = __builtin_amdgcn_cvt_pk_u8_f32(z1[j], j, w1); }
                            u32x2_t w; w.x = w0 ^ 0x80808080u; w.y = w1 ^ 0x80808080u;
                            *(u32x2_t*)((unsigned char*)xg + off) = w; }
                        else { u32x4 w; w.x = cvt_pk_bf16(z0[0], z0[1]); w.y = cvt_pk_bf16(z0[2], z0[3]); w.z = cvt_pk_bf16(z1[0], z1[1]); w.w = cvt_pk_bf16(z1[2], z1[3]);
                            *(u32x4*)(xg + off) = w; } } }
        }
        float s8[2][4];
#pragma unroll
        for (int ai = 0; ai < 2; ++ai)
#pragma unroll
            for (int m = 0; m < 4; ++m) { float s = sq[ai][m][0] + sq[ai][m][1]; s += __shfl_xor(s, 16); s += __shfl_xor(s, 32); s8[ai][m] = s; }
#pragma unroll
        for (int ai = 0; ai < 2; ++ai) { const float v = fq == 0 ? s8[ai][0] : fq == 1 ? s8[ai][1] : fq == 2 ? s8[ai][2] : s8[ai][3];
            ssq[(size_t)(row0 + ai * HALF + fq * 16) * 16 + u.pn * 4 + wc] = v; }
    }
};
struct EpiNull {
    static constexpr bool PERM = true, AFTER_DRAIN = false, I8 = false, P16 = false;
    float* sink;
    __device__ __forceinline__ void operator()(const f32x4 (&acc)[2][2][4][2], const Unit& u, int wr, int wc, int fr, int fq) const {
        float s = 0.f;
#pragma unroll
        for (int ai = 0; ai < 2; ++ai)
#pragma unroll
            for (int bj = 0; bj < 2; ++bj)
#pragma unroll
                for (int m = 0; m < 4; ++m)
#pragma unroll
                    for (int n = 0; n < 2; ++n) s += acc[ai][bj][m][n][0] + acc[ai][bj][m][n][1] + acc[ai][bj][m][n][2] + acc[ai][bj][m][n][3];
        if (s == 123.456f) sink[0] = s;
    }
};
struct NoPre { __device__ __forceinline__ void operator()() const {} };
template <class Epi, class Sched, bool ALIGN_EPI = false, bool SP2 = false, class Pre = NoPre>
__device__ __forceinline__ void gemm_phase(PG8_LAS unsigned char* lds, const Gemm g, const Sched& S, const Epi& E, const Pre& pre = Pre()) {
    int tid_ = threadIdx.x; asm volatile("" : "+v"(tid_));
    const int tid = tid_, wid = __builtin_amdgcn_readfirstlane(tid >> 6), lane = tid & 63, wr = wid >> 2, wc = wid & 3, fr = lane & 15, fq = lane >> 4;
    const int K = g.K, nt = K / BK;
    unsigned voffA[2], voffB[2];
#pragma unroll
    for (int i = 0; i < 2; ++i) { int R, C; stage_rc(tid * 16 + i * 8192, R, C); const int Rb = Epi::P16 ? ((R >> 5) * 64 + 16 * ((R >> 2) & 3) + 4 * ((R >> 4) & 1) + (R & 3)) : Epi::PERM ? ((R & ~31) + perm32(R & 31)) : R;
        voffA[i] = (unsigned)(R * g.lda + C) * 2u; voffB[i] = (unsigned)(Rb * g.ldb + C) * 2u; }
    const size_t kstep = (size_t)(BK * 2);
    const size_t hstepA = (size_t)HALF * g.lda * 2, tstepA = 2 * hstepA;
    const size_t tstepB = (size_t)2 * HALF * g.ldb * 2, hstepB = Epi::P16 ? (size_t)8 * g.ldb * 2 : (size_t)HALF * g.ldb * 2;
    const unsigned ldsw = (unsigned)wid * 1024u;
    const int aoff = lds_byte(wr * 64 + fr, fq * 8), boff = lds_byte(wc * 32 + fr, fq * 8);
#define PG8_SA(b, h) (((b) * 2 + (h)) * HTB)
#define PG8_SB(b, h) ((4 + (b) * 2 + (h)) * HTB)
#define PG8_STAGE(bufoff, gbase, voff) do { _Pragma("unroll") for (int _i = 0; _i < 2; ++_i) \
        __builtin_amdgcn_global_load_lds((const unsigned*)((const char*)(gbase) + (voff)[_i]), (PG8_LAS unsigned*)(lds + (bufoff) + ldsw + _i * 8192), 16, 0, 0); } while (0)
#define PG8_LDA(dst, b, h) do { _Pragma("unroll") for (int m = 0; m < 4; ++m) _Pragma("unroll") for (int k = 0; k < 2; ++k) dst[m][k] = *(const PG8_LAS bf16x8*)(lds + PG8_SA(b, h) + aoff + m * 2048 + k * 1024); } while (0)
#define PG8_LDB(dst, b, h) do { _Pragma("unroll") for (int n = 0; n < 2; ++n) _Pragma("unroll") for (int k = 0; k < 2; ++k) dst[n][k] = *(const PG8_LAS bf16x8*)(lds + PG8_SB(b, h) + boff + n * 2048 + k * 1024); } while (0)
#define PG8_MMA(ai, bj, At, Bt) do { __builtin_amdgcn_s_setprio(1); _Pragma("unroll") for (int m = 0; m < 4; ++m) _Pragma("unroll") for (int n = 0; n < 2; ++n) _Pragma("unroll") for (int k = 0; k < 2; ++k) \
        { if constexpr (Epi::I8) acc[ai][bj][m][n] = __builtin_bit_cast(f32x4, __builtin_amdgcn_mfma_i32_16x16x64_i8(__builtin_bit_cast(i32x4, Bt[n][k]), __builtin_bit_cast(i32x4, At[m][k]), __builtin_bit_cast(i32x4, acc[ai][bj][m][n]), 0, 0, 0)); \
          else acc[ai][bj][m][n] = __builtin_amdgcn_mfma_f32_16x16x32_bf16(Bt[n][k], At[m][k], acc[ai][bj][m][n], 0, 0, 0); } __builtin_amdgcn_s_setprio(0); } while (0)
#define PG8_WAIT_V(n) asm volatile("s_waitcnt vmcnt(" #n ")" ::: "memory")
#define PG8_WAIT_L(n) asm volatile("s_waitcnt lgkmcnt(" #n ")" ::: "memory")
#define PG8_BAR __builtin_amdgcn_s_barrier()
#define PG8_SCHED __builtin_amdgcn_sched_barrier(0)
    Unit cur, nxt; int ui = 0;
    if (!S.next(0, cur)) return;
    f32x4 acc[2][2][4][2];
#pragma unroll
    for (int a = 0; a < 2; ++a)
#pragma unroll
        for (int b = 0; b < 2; ++b)
#pragma unroll
            for (int m = 0; m < 4; ++m)
#pragma unroll
                for (int n = 0; n < 2; ++n) acc[a][b][m][n] = (f32x4){0.f, 0.f, 0.f, 0.f};
    bf16x8 At[4][2], B0[2][2], B1[2][2];
    const char* cA = (const char*)g.A + (size_t)cur.pm * tstepA; const char* cB = (const char*)g.Bt + (size_t)cur.pn * tstepB;
    S.a_ready(cur);
    if constexpr (SP2) {
        PG8_STAGE(PG8_SB(0, 0), cB, voffB); PG8_STAGE(PG8_SB(0, 1), cB + hstepB, voffB); PG8_STAGE(PG8_SA(0, 0), cA, voffA); PG8_STAGE(PG8_SA(0, 1), cA + hstepA, voffA);
        pre();
        if (wr == 1) PG8_BAR;
        PG8_WAIT_V(2); PG8_BAR;
        PG8_STAGE(PG8_SB(1, 0), cB + kstep, voffB); PG8_STAGE(PG8_SA(1, 0), cA + kstep, voffA); PG8_STAGE(PG8_SB(1, 1), cB + hstepB + kstep, voffB);
        PG8_WAIT_V(6); PG8_BAR;
    } else {
        PG8_STAGE(PG8_SB(0, 0), cB, voffB); PG8_STAGE(PG8_SA(0, 0), cA, voffA); PG8_STAGE(PG8_SB(0, 1), cB + hstepB, voffB); PG8_STAGE(PG8_SA(0, 1), cA + hstepA, voffA);
        if (wr == 1) PG8_BAR;
        PG8_WAIT_V(4); PG8_BAR;
        PG8_STAGE(PG8_SB(1, 0), cB + kstep, voffB); PG8_STAGE(PG8_SA(1, 0), cA + kstep, voffA); PG8_STAGE(PG8_SB(1, 1), cB + hstepB + kstep, voffB);
        PG8_WAIT_V(6); PG8_BAR;
    }
    for (;;) {
        const bool has_next = S.next(ui + 1, nxt);
        const char* nA = has_next ? (const char*)g.A + (size_t)nxt.pm * tstepA : cA; const char* nB = has_next ? (const char*)g.Bt + (size_t)nxt.pn * tstepB : cB;
        for (int t = 0; t < nt; t += 2) {
            const bool last = (t == nt - 2);
            const char* a1 = cA + (size_t)(t + 1) * kstep;
            const char* a2 = last ? nA : cA + (size_t)(t + 2) * kstep; const char* b2 = last ? nB : cB + (size_t)(t + 2) * kstep;
            const char* a3 = a2 + kstep; const char* b3 = b2 + kstep;
            if (last && has_next) S.a_ready(nxt);
            if constexpr (SP2) {
            PG8_LDB(B0, 0, 0); PG8_LDB(B1, 0, 1); PG8_SCHED; PG8_LDA(At, 0, 0); PG8_STAGE(PG8_SA(1, 1), a1 + hstepA, voffA);
            PG8_WAIT_V(8); PG8_WAIT_L(0); PG8_BAR; PG8_MMA(0, 0, At, B0); PG8_MMA(0, 1, At, B1); PG8_BAR; PG8_SCHED;
            PG8_LDA(At, 0, 1); PG8_STAGE(PG8_SB(0, 0), b2, voffB); PG8_STAGE(PG8_SB(0, 1), b2 + hstepB, voffB); PG8_STAGE(PG8_SA(0, 0), a2, voffA);
            PG8_WAIT_V(8); PG8_WAIT_L(0); PG8_BAR; PG8_MMA(1, 0, At, B0); PG8_MMA(1, 1, At, B1); PG8_BAR; PG8_SCHED;
            PG8_LDB(B0, 1, 0); PG8_LDB(B1, 1, 1); PG8_SCHED; PG8_LDA(At, 1, 0); PG8_STAGE(PG8_SA(0, 1), a2 + hstepA, voffA);
            PG8_WAIT_V(8); PG8_WAIT_L(0); PG8_BAR; PG8_MMA(0, 0, At, B0); PG8_MMA(0, 1, At, B1); PG8_BAR; PG8_SCHED;
            PG8_LDA(At, 1, 1); PG8_STAGE(PG8_SB(1, 0), b3, voffB); PG8_STAGE(PG8_SB(1, 1), b3 + hstepB, voffB); PG8_STAGE(PG8_SA(1, 0), a3, voffA);
            PG8_WAIT_V(8); PG8_WAIT_L(0); PG8_BAR; PG8_MMA(1, 0, At, B0); PG8_MMA(1, 1, At, B1); PG8_BAR; PG8_SCHED;
            } else {
            PG8_LDB(B0, 0, 0); PG8_SCHED; PG8_LDA(At, 0, 0); PG8_STAGE(PG8_SA(1, 1), a1 + hstepA, voffA);
            PG8_WAIT_L(8); PG8_BAR; PG8_WAIT_L(0); PG8_MMA(0, 0, At, B0); PG8_BAR; PG8_SCHED;
            PG8_LDB(B1, 0, 1); PG8_STAGE(PG8_SB(0, 0), b2, voffB);
            PG8_BAR; PG8_WAIT_L(0); PG8_MMA(0, 1, At, B1); PG8_BAR;
            PG8_LDA(At, 0, 1); PG8_STAGE(PG8_SA(0, 0), a2, voffA);
            PG8_BAR; PG8_WAIT_L(0); PG8_MMA(1, 0, At, B0); PG8_BAR; PG8_SCHED;
            PG8_STAGE(PG8_SB(0, 1), b2 + hstepB, voffB);
            PG8_WAIT_V(6); PG8_BAR; PG8_MMA(1, 1, At, B1); PG8_BAR;
            PG8_LDB(B0, 1, 0); PG8_SCHED; PG8_LDA(At, 1, 0); PG8_STAGE(PG8_SA(0, 1), a2 + hstepA, voffA);
            PG8_WAIT_L(8); PG8_BAR; PG8_WAIT_L(0); PG8_MMA(0, 0, At, B0); PG8_BAR; PG8_SCHED;
            PG8_LDB(B1, 1, 1); PG8_STAGE(PG8_SB(1, 0), b3, voffB);
            PG8_BAR; PG8_WAIT_L(0); PG8_MMA(0, 1, At, B1); PG8_BAR;
            PG8_LDA(At, 1, 1); PG8_STAGE(PG8_SA(1, 0), a3, voffA);
            PG8_BAR; PG8_WAIT_L(0); PG8_MMA(1, 0, At, B0); PG8_BAR; PG8_SCHED;
            PG8_STAGE(PG8_SB(1, 1), b3 + hstepB, voffB);
            PG8_WAIT_V(6); PG8_BAR; PG8_MMA(1, 1, At, B1); PG8_BAR;
            }
        }
        if constexpr (ALIGN_EPI) { if (wr == 0) PG8_BAR; }
        if constexpr (!Epi::AFTER_DRAIN) { E(acc, cur, wr, wc, fr, fq); S.done(cur); }
        if (!has_next) break;
#pragma unroll
        for (int a = 0; a < 2; ++a)
#pragma unroll
            for (int b = 0; b < 2; ++b)
#pragma unroll
                for (int m = 0; m < 4; ++m)
#pragma unroll
                    for (int n = 0; n < 2; ++n) acc[a][b][m][n] = (f32x4){0.f, 0.f, 0.f, 0.f};
        cur = nxt; cA = nA; cB = nB; ++ui;
        if constexpr (ALIGN_EPI) { if (wr == 1) PG8_BAR; }
    }
    PG8_WAIT_V(0);
    if constexpr (!ALIGN_EPI) { if (wr == 0) PG8_BAR; }
    PG8_BAR;
    if constexpr (Epi::AFTER_DRAIN) { E.fused(acc, cur, wr, wc, fr, fq, lds, wid, lane); S.done(cur); }
#undef PG8_SA
#undef PG8_SB
#undef PG8_STAGE
#undef PG8_LDA
#undef PG8_LDB
#undef PG8_MMA
#undef PG8_WAIT_V
#undef PG8_WAIT_L
#undef PG8_BAR
#undef PG8_SCHED
}
}
constexpr int NB = 16, SEQ = 2048, D = 1024, DEPTH = 4, M = NB * SEQ, PIN = 2568, NP = 2560, FF = 4096, NMOD = 6144;
constexpr int NWAVES = 8, NTHR = 512;
constexpr float EPS = 1e-6f;
constexpr int PC_QA = 0, PC_KA = 256, PC_VA = 512, PC_GATE = 768, PC_UB = 1024, PC_VB = 1280, PC_XC = 1536, PC_QD = 1792, PC_KD = 2048, PC_VD = 2304;
constexpr int YC_A = 0, YC_B = 256, YC_C = 512, YC_D = 768;
enum { I_X = 0, I_C, I_WMOD, I_BMOD, I_GN1, I_GN2, I_WIN, I_CONV, I_ALOG, I_DTB, I_GOA, I_GLNB, I_WSG, I_BSG, I_WPOOL, I_SPOOL, I_GOD, I_WOUT, I_WFF1, I_WFF2, I_GFIN, N_IN };

constexpr size_t MiB = 1u << 20;
constexpr size_t WS_CTL = 0, CTL_ZERO_BYTES = 1 * MiB;
constexpr size_t WS_MOD = 1 * MiB;
constexpr size_t WS_SW1 = 3 * MiB;
constexpr size_t WS_SWAB = 3 * MiB + 768 * 1024;
constexpr size_t WS_SW2 = 4 * MiB;
constexpr size_t WS_WAB = 5 * MiB;
constexpr size_t WS_WSG = 5 * MiB + 256 * 1024;
constexpr size_t WS_WPT = 5 * MiB + 768 * 1024;
constexpr size_t WS_QSA = 7 * MiB + 256 * 1024;
constexpr size_t WS_QSA1 = 7 * MiB + 512 * 1024;
constexpr size_t WS_QSB1 = 7 * MiB + 768 * 1024;
constexpr size_t WS_QSB2 = 7 * MiB + 896 * 1024;
constexpr size_t WS_QCS2 = 7 * MiB + 928 * 1024;
constexpr size_t WS_QSBO = 7 * MiB + 960 * 1024;
constexpr size_t WS_ZERO = 512 * 1024;
constexpr size_t WS_QSB = 7 * MiB;
constexpr size_t WS_ABLOG = 6 * MiB;
constexpr size_t WS_SSQ1 = 8 * MiB, WS_SSQ2 = 10 * MiB;
constexpr size_t WS_BETA = 12 * MiB, WS_GLOG = 13 * MiB;
constexpr size_t WS_WIN = 16 * MiB;
constexpr size_t WS_WOUT = 36 * MiB;
constexpr size_t WS_WFF1 = 44 * MiB;
constexpr size_t WS_WFF2 = 76 * MiB;
constexpr size_t WS_XQ = 144 * MiB;
constexpr size_t WS_XG = 112 * MiB;
constexpr size_t WS_HID = 176 * MiB;
constexpr size_t WS_P = 176 * MiB;
constexpr size_t WS_Y = 336 * MiB;
constexpr size_t WS_CHA = 112 * MiB, WS_CHB = 400 * MiB;
constexpr size_t WS_XB = 448 * MiB;
constexpr size_t WS_END = 512 * MiB;
constexpr int CW_BAR = 4096;
constexpr int CW_XRANK = 24576;
constexpr int CW_DNCNT = 16384;

constexpr int RING_BYTES = 131072, LDS_BYTES = 163840, MISC_OFF = LDS_BYTES - 256;

#define LAS __attribute__((address_space(3)))
typedef unsigned short bf16;
typedef float f32x4 __attribute__((ext_vector_type(4)));
typedef unsigned u32x4 __attribute__((ext_vector_type(4)));
typedef unsigned u32x2 __attribute__((ext_vector_type(2)));
__device__ __forceinline__ float bf2f(unsigned v) { return __uint_as_float(v << 16); }
__device__ __forceinline__ unsigned f2bf(float f) { unsigned u = __float_as_uint(f); return (u + 0x7fffu + ((u >> 16) & 1u)) >> 16; }
__device__ __forceinline__ unsigned pk2(float lo, float hi) { return f2bf(lo) | (f2bf(hi) << 16); }
__device__ __forceinline__ float wave_sum(float v) {
#pragma unroll
    for (int o = 1; o < 64; o <<= 1) v += __shfl_xor(v, o);
    return v;
}
__device__ __forceinline__ float rdlane(float v, int l) { return __builtin_bit_cast(float, __builtin_amdgcn_readlane(__builtin_bit_cast(int, v), l)); }
__device__ __forceinline__ float silu_f(float x) { return x * __builtin_amdgcn_rcpf(1.0f + __expf(-x)); }
__device__ __forceinline__ float sigmoid_f(float x) { return __builtin_amdgcn_rcpf(1.0f + __expf(-x)); }
__device__ __forceinline__ float softplus_f(float x) { return fmaxf(x, 0.f) + __logf(1.0f + __expf(-fabsf(x))); }
#define GAS __attribute__((address_space(1)))
template <class T> __device__ __forceinline__ T* as_global(T* p) { return p; }
constexpr float YCLIP8 = 8.0f;
__device__ __forceinline__ unsigned q8x4(float a, float b, float c, float d) {
    constexpr float k = 127.0f / YCLIP8; unsigned w = 0u;
    w = __builtin_amdgcn_cvt_pk_u8_f32(__builtin_fmaf(a, k, 128.0f), 0, w); w = __builtin_amdgcn_cvt_pk_u8_f32(__builtin_fmaf(b, k, 128.0f), 1, w);
    w = __builtin_amdgcn_cvt_pk_u8_f32(__builtin_fmaf(c, k, 128.0f), 2, w); w = __builtin_amdgcn_cvt_pk_u8_f32(__builtin_fmaf(d, k, 128.0f), 3, w);
    return w ^ 0x80808080u; }
template <class T> __device__ __forceinline__ T* uni_ptr(T* p) { const unsigned long long v = (unsigned long long)p; const unsigned lo = __builtin_amdgcn_readfirstlane((unsigned)v), hi = __builtin_amdgcn_readfirstlane((unsigned)(v >> 32)); return as_global((T*)(((unsigned long long)hi << 32) | lo)); }
#define XB_TMO      128
#define XB_XCNT(j)  (256  + 64 * (j))
#define XB_XSUB(j)  (1280 + 64 * (j))
#define XB_XGEN(j)  (2304 + 64 * (j))
#define XB_TOP      3328
#define XB_TOPGEN   3392
#define XCD_BAR_WORDS 3456
#define XB_SPIN_CAP (1u << 18)

__device__ __forceinline__ unsigned xb_ld(unsigned* p)              { return __hip_atomic_load(p, __ATOMIC_RELAXED, __HIP_MEMORY_SCOPE_AGENT); }
__device__ __forceinline__ unsigned xb_add(unsigned* p, unsigned v) { return __hip_atomic_fetch_add(p, v, __ATOMIC_RELAXED, __HIP_MEMORY_SCOPE_AGENT); }
__device__ __forceinline__ unsigned xb_xcc_id() { return (unsigned)__builtin_amdgcn_s_getreg((3 << 11) | 20) & 0xFu; }
#define XB_SPIN(cond, bar) do { unsigned _sp = 0; while (cond) { __builtin_amdgcn_s_sleep(1); \
    if ((++_sp & 255u) == 0u) { if (xb_ld(&(bar)[XB_TMO])) break; if (_sp > XB_SPIN_CAP) { atomicAdd(&(bar)[XB_TMO], 1u); break; } } } } while (0)

struct XcdBarrier {
    unsigned* bar; unsigned x;
    volatile LAS unsigned* st;
};

__device__ __forceinline__ XcdBarrier xcd_barrier_post(unsigned* bar, volatile LAS unsigned* st) {
    XcdBarrier b; b.bar = bar; b.x = xb_xcc_id(); b.st = st;
    if (threadIdx.x == 0) (void)xb_add(&bar[XB_XCNT(b.x)], 1u);
    return b;
}
__device__ __forceinline__ void xcd_barrier_complete(unsigned* bar, unsigned x, unsigned& nloc, unsigned& nx) {
    const unsigned G = gridDim.x * gridDim.y * gridDim.z;
    unsigned sum, cnt, mine, sp = 0u;
    for (;;) {
        sum = 0u; cnt = 0u; mine = 0u;
#pragma unroll
        for (unsigned j = 0; j < 16; ++j) { const unsigned c = xb_ld(&bar[XB_XCNT(j)]); sum += c; cnt += (c > 0u) ? 1u : 0u; mine = (j == x) ? c : mine; }
        if (sum == G) break;
        __builtin_amdgcn_s_sleep(1);
        if ((++sp & 255u) == 0u) { if (xb_ld(&bar[XB_TMO])) break; if (sp > XB_SPIN_CAP) { atomicAdd(&bar[XB_TMO], 1u); break; } }
    }
    nloc = mine > 0u ? mine : 1u; nx = cnt > 0u ? cnt : 1u;
}

__device__ __forceinline__ void xcd_barrier(const XcdBarrier& b) {
    asm volatile("s_waitcnt vmcnt(0)" ::: "memory");
    __syncthreads();
    if (threadIdx.x == 0) {
        unsigned* bar = b.bar;
        __builtin_amdgcn_s_waitcnt(0);
        unsigned nloc = b.st[0], nx = b.st[1];
        if (nloc == 0u) { xcd_barrier_complete(bar, b.x, nloc, nx); b.st[0] = nloc; b.st[1] = nx; }
        const unsigned old = xb_add(&bar[XB_XSUB(b.x)], 1u);
        const unsigned gen = old / nloc;
        if (old + 1u == (gen + 1u) * nloc) {
            __builtin_amdgcn_fence(__ATOMIC_RELEASE, "agent");
            asm volatile("s_waitcnt vmcnt(0)" ::: "memory");
            const unsigned og = xb_add(&bar[XB_TOP], 1u);
            const unsigned tg = og / nx;
            if (og + 1u == (tg + 1u) * nx) xb_add(&bar[XB_TOPGEN], 1u);
            else XB_SPIN(xb_ld(&bar[XB_TOPGEN]) == tg, bar);
            __builtin_amdgcn_fence(__ATOMIC_ACQUIRE, "agent");
            xb_add(&bar[XB_XGEN(b.x)], 1u);
            asm volatile("s_waitcnt vmcnt(0)" ::: "memory");
        } else {
            XB_SPIN(xb_ld(&bar[XB_XGEN(b.x)]) == gen, bar);
            __builtin_amdgcn_fence(__ATOMIC_ACQUIRE, "agent");
            asm volatile("s_waitcnt vmcnt(0)" ::: "memory");
        }
    }
    __syncthreads();
}
struct Frame {
    LAS unsigned char* lds;
    int tid, lane, wave, G, bid;
    unsigned char* ws;
    const float* const* in;
    float* out;
};
#define WSP(T, off) (as_global((T*)(F.ws + (off))))
#define GIN(i) (as_global(F.in[i]))

template <class Writer>
__device__ __forceinline__ void gemm16_unit(Frame& F, const float* W, int ldw, int N, int n0, LAS float* lhsT, LAS float* red, const Writer& wr) {
    const int n = n0 + F.lane; const bool ok = n < N;
    float acc[16];
#pragma unroll
    for (int b = 0; b < 16; ++b) acc[b] = 0.f;
    const int kbeg = F.wave * 128;
    const float* wp = W + (size_t)kbeg * ldw + (ok ? n : 0);
    for (int k0 = 0; k0 < 128; k0 += 32) {
        float wv[32];
#pragma unroll
        for (int j = 0; j < 32; ++j) wv[j] = ok ? wp[(size_t)(k0 + j) * ldw] : 0.f;
#pragma unroll
        for (int j = 0; j < 32; ++j) { const float w = wv[j];
            const LAS f32x4* lp = (const LAS f32x4*)(lhsT + (kbeg + k0 + j) * 16);
            const f32x4 l0 = lp[0], l1 = lp[1], l2 = lp[2], l3 = lp[3];
            acc[0] += l0[0] * w; acc[1] += l0[1] * w; acc[2] += l0[2] * w; acc[3] += l0[3] * w;
            acc[4] += l1[0] * w; acc[5] += l1[1] * w; acc[6] += l1[2] * w; acc[7] += l1[3] * w;
            acc[8] += l2[0] * w; acc[9] += l2[1] * w; acc[10] += l2[2] * w; acc[11] += l2[3] * w;
            acc[12] += l3[0] * w; acc[13] += l3[1] * w; acc[14] += l3[2] * w; acc[15] += l3[3] * w;
            if ((j & 7) == 7) asm volatile("" ::: "memory"); }
    }
#pragma unroll
    for (int b = 0; b < 16; ++b) red[(F.wave * 16 + b) * 64 + F.lane] = acc[b];
    __syncthreads();
    for (int o_ = F.tid; o_ < 1024; o_ += NTHR) { int o = o_; asm volatile("" : "+v"(o)); const int b = o >> 6, nn = o & 63; float s = 0.f;
#pragma unroll
        for (int w = 0; w < 8; ++w) s += red[(w * 16 + b) * 64 + nn];
        if (n0 + nn < N) wr(b, n0 + nn, s); }
    __syncthreads();
}

__device__ __forceinline__ void transpose_item(const float* W, int ldw, int csrc, int k0, bf16* WT, int Kd, int rdst, LAS float* scr, int lane) {
    float tv[32];
#pragma unroll
    for (int i = 0; i < 32; ++i) tv[i] = W[(size_t)(k0 + 2 * i + (lane >> 5)) * ldw + csrc + (lane & 31)];
#pragma unroll
    for (int i = 0; i < 32; ++i) scr[(2 * i + (lane >> 5)) * 33 + (lane & 31)] = tv[i];
    asm volatile("s_waitcnt lgkmcnt(0)" ::: "memory");
    const int c = lane & 7;
#pragma unroll
    for (int j = 0; j < 4; ++j) { const int n = (lane >> 3) + 8 * j; const LAS float* s = scr + (8 * c) * 33 + n;
        u32x4 o; o.x = pk2(s[0 * 33], s[1 * 33]); o.y = pk2(s[2 * 33], s[3 * 33]); o.z = pk2(s[4 * 33], s[5 * 33]); o.w = pk2(s[6 * 33], s[7 * 33]);
        *(u32x4*)(WT + (size_t)(rdst + n) * Kd + k0 + 8 * c) = o; }
    asm volatile("s_waitcnt lgkmcnt(0)" ::: "memory");
}

__device__ __forceinline__ void p0a(Frame& F) {
    LAS float* lhsT = (LAS float*)F.lds; LAS float* red = (LAS float*)(F.lds + 65536);
    const float* c = GIN(I_C);
    float* mod = WSP(float, WS_MOD);
    bool filled = false;
    for (int u = F.bid; u < DEPTH * 96; u += F.G) {
        if (!filled) { for (int i = F.tid; i < 16384; i += NTHR) { const int b = i >> 10, k = i & 1023; lhsT[k * 16 + b] = silu_f(c[i]); } __syncthreads(); filled = true; }
        const int l = u / 96, n0 = (u % 96) * 64;
        const float* bm = GIN(I_BMOD) + (size_t)l * NMOD; float* mo = mod + (size_t)l * 16 * NMOD;
        gemm16_unit(F, GIN(I_WMOD) + (size_t)l * D * NMOD, NMOD, NMOD, n0, lhsT, red, [=](int b, int n, float s) { mo[(size_t)b * NMOD + n] = s + bm[n]; });
    }
    __syncthreads();
    LAS float* scr = (LAS float*)(F.lds + F.wave * 8448);
    const int gw = F.bid * NWAVES + F.wave, NGW = F.G * NWAVES;
    constexpr int IT_IN = 16 * 80, IT_OUT = 16 * 32, IT_F1 = 16 * 128, IT_F2 = 64 * 32, IT_L = IT_IN + IT_OUT + IT_F1 + IT_F2;
    for (int it = gw; it < DEPTH * IT_L; it += NGW) {
        const int l = it / IT_L; int r = it % IT_L;
        if (r < IT_IN) { const int kb = r / 80, nb = r % 80, n0 = nb * 32; transpose_item(GIN(I_WIN) + (size_t)l * D * PIN, PIN, n0 < 768 ? n0 : n0 + 8, kb * 64, WSP(bf16, WS_WIN) + (size_t)l * NP * D, D, n0, scr, F.lane); continue; }
        r -= IT_IN;
        if (r < IT_OUT) { const int kb = r / 32, nb = r % 32; transpose_item(GIN(I_WOUT) + (size_t)l * D * D, D, nb * 32, kb * 64, WSP(bf16, WS_WOUT) + (size_t)l * D * D, D, nb * 32, scr, F.lane); continue; }
        r -= IT_OUT;
        if (r < IT_F1) { const int kb = r / 128, nb = r % 128; transpose_item(GIN(I_WFF1) + (size_t)l * D * FF, FF, nb * 32, kb * 64, WSP(bf16, WS_WFF1) + (size_t)l * FF * D, D, nb * 32, scr, F.lane); continue; }
        r -= IT_F1;
        { const int kb = r / 32, nb = r % 32; transpose_item(GIN(I_WFF2) + (size_t)l * FF * D, D, nb * 32, kb * 64, WSP(bf16, WS_WFF2) + (size_t)l * D * FF, FF, nb * 32, scr, F.lane); }
    }
    { bf16* wsgb = WSP(bf16, WS_WSG); const float* wsg = GIN(I_WSG);
      for (int i = F.bid * NTHR + F.tid; i < DEPTH * 4 * 128 * 128; i += F.G * NTHR) { const int lh = i >> 14, j = i & 7, ln = (i >> 3) & 63, ks = (i >> 9) & 7, tt = (i >> 12) & 3;
          wsgb[i] = (bf16)f2bf(wsg[(size_t)lh * 16384 + (32 * tt + (ln & 31)) * 128 + 16 * ks + 8 * (ln >> 5) + j]); }
      bf16* wpt = WSP(bf16, WS_WPT); const float* wp = GIN(I_WPOOL);
      for (int i = F.bid * NTHR + F.tid; i < DEPTH * 4 * 64 * 64; i += F.G * NTHR) { const int lg = i >> 12, j = i & 7, ln = (i >> 3) & 63, ks = (i >> 9) & 3, dt = (i >> 11) & 1, c = 16 * ks + 8 * (ln >> 5) + j, d = 32 * dt + (ln & 31); wpt[i] = (bf16)f2bf(wp[(lg * 64 + c) * 64 + d]); } }
    bf16* wab = WSP(bf16, WS_WAB);
    for (int i = F.bid * NTHR + F.tid; i < DEPTH * 16 * D; i += F.G * NTHR) { const int l = i / (16 * D), j = (i / D) & 15, k = i % D;
        wab[i] = j < 8 ? (bf16)f2bf(GIN(I_WIN)[((size_t)l * D + k) * PIN + 768 + j]) : (bf16)0; }
}

__device__ __forceinline__ void p0b(Frame& F) {
    LAS float* lhsT = (LAS float*)F.lds; LAS float* red = (LAS float*)(F.lds + 65536);
    const float* mod = WSP(float, WS_MOD);
    for (int u = F.bid; u < DEPTH * 105; u += F.G) {
        const int l = u / 105, r = u % 105; const bool first = r < 41;
        const float* ml = mod + (size_t)l * 16 * NMOD + (first ? 0 : 3 * D);
        for (int i = F.tid; i < 16384; i += NTHR) { const int b = i >> 10, k = i & 1023; lhsT[k * 16 + b] = ml[(size_t)b * NMOD + k]; }
        __syncthreads();
        if (first) { float* sw1 = WSP(float, WS_SW1) + (size_t)l * 16 * NP; float* swab = WSP(float, WS_SWAB) + (size_t)l * 16 * 8;
            gemm16_unit(F, GIN(I_WIN) + (size_t)l * D * PIN, PIN, PIN, r * 64, lhsT, red, [=](int b, int n, float s) {
                if (n < 768) sw1[b * NP + n] = s; else if (n < 776) swab[b * 8 + (n - 768)] = s; else sw1[b * NP + n - 8] = s; }); }
        else { float* sw2 = WSP(float, WS_SW2) + (size_t)l * 16 * FF;
            gemm16_unit(F, GIN(I_WFF1) + (size_t)l * D * FF, FF, FF, (r - 41) * 64, lhsT, red, [=](int b, int n, float s) { sw2[b * FF + n] = s; }); }
    }
    { const int gw_ = F.bid * NWAVES + F.wave, NGW_ = F.G * NWAVES;
      constexpr int NR1 = DEPTH * FF, NR2 = DEPTH * NP, NR3 = DEPTH * 16, NR4 = DEPTH * D;
      for (int it = gw_; it < NR1 + NR2 + NR3 + NR4; it += NGW_) {
          bf16* wq; float* sc; int n;
          if (it >= NR1 + NR2 + NR3) { n = it - NR1 - NR2 - NR3; wq = WSP(bf16, WS_WOUT); sc = WSP(float, WS_QSBO); } else
          if (it < NR1) { n = it; wq = WSP(bf16, WS_WFF1); sc = WSP(float, WS_QSB); } else if (it < NR1 + NR2) { n = it - NR1; wq = WSP(bf16, WS_WIN); sc = WSP(float, WS_QSB1); } else { n = it - NR1 - NR2; wq = WSP(bf16, WS_WAB); sc = WSP(float, WS_QSB1) + 16384; }
          bf16* rowp = wq + (size_t)n * D + 16 * F.lane; u32x4 a = *(u32x4*)rowp, b = *(u32x4*)(rowp + 8);
          float v[16]; v[0] = bf2f(a.x & 0xffffu); v[1] = bf2f(a.x >> 16); v[2] = bf2f(a.y & 0xffffu); v[3] = bf2f(a.y >> 16); v[4] = bf2f(a.z & 0xffffu); v[5] = bf2f(a.z >> 16); v[6] = bf2f(a.w & 0xffffu); v[7] = bf2f(a.w >> 16);
          v[8] = bf2f(b.x & 0xffffu); v[9] = bf2f(b.x >> 16); v[10] = bf2f(b.y & 0xffffu); v[11] = bf2f(b.y >> 16); v[12] = bf2f(b.z & 0xffffu); v[13] = bf2f(b.z >> 16); v[14] = bf2f(b.w & 0xffffu); v[15] = bf2f(b.w >> 16);
          float mx = 0.f;
#pragma unroll
          for (int j = 0; j < 16; ++j) mx = fmaxf(mx, fabsf(v[j]));
#pragma unroll
          for (int o = 1; o < 64; o <<= 1) mx = fmaxf(mx, __shfl_xor(mx, o));
          const float sc_ = mx > 0.f ? mx * (1.0f / 127.0f) : 1.0f, is_ = 1.0f / sc_;
#pragma unroll
          for (int j = 0; j < 16; ++j) v[j] = __builtin_rintf(v[j] * is_);
          u32x4 oq;
          oq.x = ((unsigned)((int)v[0] & 255)) | ((unsigned)((int)v[1] & 255) << 8) | ((unsigned)((int)v[2] & 255) << 16) | ((unsigned)((int)v[3] & 255) << 24);
          oq.y = ((unsigned)((int)v[4] & 255)) | ((unsigned)((int)v[5] & 255) << 8) | ((unsigned)((int)v[6] & 255) << 16) | ((unsigned)((int)v[7] & 255) << 24);
          oq.z = ((unsigned)((int)v[8] & 255)) | ((unsigned)((int)v[9] & 255) << 8) | ((unsigned)((int)v[10] & 255) << 16) | ((unsigned)((int)v[11] & 255) << 24);
          oq.w = ((unsigned)((int)v[12] & 255)) | ((unsigned)((int)v[13] & 255) << 8) | ((unsigned)((int)v[14] & 255) << 16) | ((unsigned)((int)v[15] & 255) << 24);
          asm volatile("s_waitcnt vmcnt(0)" ::: "memory");
          *(u32x4*)((unsigned char*)(wq + (size_t)n * D) + 16 * F.lane) = oq; if (F.lane == 0) sc[n] = it >= NR1 + NR2 + NR3 ? sc_ * (YCLIP8 / 127.0f) : sc_; } }
    { const int gw_ = F.bid * NWAVES + F.wave, NGW_ = F.G * NWAVES; bf16* wq = WSP(bf16, WS_WFF2); float* sc2 = WSP(float, WS_QSB2); int* cs2 = WSP(int, WS_QCS2);
      for (int n = gw_; n < DEPTH * D; n += NGW_) { const u32x4* rp = (const u32x4*)(wq + (size_t)n * FF + 64 * F.lane); u32x4 in[8]; float mx = 0.f;
#pragma unroll
          for (int j = 0; j < 8; ++j) { in[j] = rp[j]; mx = fmaxf(mx, fmaxf(fmaxf(fmaxf(fabsf(bf2f(in[j].x & 0xffffu)), fabsf(bf2f(in[j].x >> 16))), fmaxf(fabsf(bf2f(in[j].y & 0xffffu)), fabsf(bf2f(in[j].y >> 16)))), fmaxf(fmaxf(fabsf(bf2f(in[j].z & 0xffffu)), fabsf(bf2f(in[j].z >> 16))), fmaxf(fabsf(bf2f(in[j].w & 0xffffu)), fabsf(bf2f(in[j].w >> 16)))))); }
#pragma unroll
          for (int o = 1; o < 64; o <<= 1) mx = fmaxf(mx, __shfl_xor(mx, o));
          const float sc_ = mx > 0.f ? mx * (1.0f / 127.0f) : 1.0f, is_ = 1.0f / sc_; int sum = 0; u32x4 oq[4];
#pragma unroll
          for (int j = 0; j < 8; ++j) { const int q0 = (int)__builtin_rintf(bf2f(in[j].x & 0xffffu) * is_), q1 = (int)__builtin_rintf(bf2f(in[j].x >> 16) * is_), q2 = (int)__builtin_rintf(bf2f(in[j].y & 0xffffu) * is_), q3 = (int)__builtin_rintf(bf2f(in[j].y >> 16) * is_);
              const int q4 = (int)__builtin_rintf(bf2f(in[j].z & 0xffffu) * is_), q5 = (int)__builtin_rintf(bf2f(in[j].z >> 16) * is_), q6 = (int)__builtin_rintf(bf2f(in[j].w & 0xffffu) * is_), q7 = (int)__builtin_rintf(bf2f(in[j].w >> 16) * is_);
              sum += ((q0 + q1) + (q2 + q3)) + ((q4 + q5) + (q6 + q7));
              const unsigned lo = (unsigned)(q0 & 255) | ((unsigned)(q1 & 255) << 8) | ((unsigned)(q2 & 255) << 16) | ((unsigned)(q3 & 255) << 24), hi = (unsigned)(q4 & 255) | ((unsigned)(q5 & 255) << 8) | ((unsigned)(q6 & 255) << 16) | ((unsigned)(q7 & 255) << 24);
              if (j & 1) { oq[j >> 1].z = lo; oq[j >> 1].w = hi; } else { oq[j >> 1].x = lo; oq[j >> 1].y = hi; } }
#pragma unroll
          for (int o = 1; o < 64; o <<= 1) sum += __shfl_xor(sum, o);
          asm volatile("s_waitcnt vmcnt(0)" ::: "memory");
          u32x4* op = (u32x4*)((unsigned char*)(wq + (size_t)n * FF) + 64 * F.lane);
#pragma unroll
          for (int j = 0; j < 4; ++j) op[j] = oq[j];
          if (F.lane == 0) { sc2[n] = sc_ * (pg8::HCLIP8 / 255.0f); cs2[n] = sum; } } }
    const int gw = F.bid * NWAVES + F.wave, NGW = F.G * NWAVES;
    const float* x = GIN(I_X); const float* gn = GIN(I_GN1); bf16* xg = WSP(bf16, WS_XG); float* ssq = WSP(float, WS_SSQ1);
    unsigned char* xq = WSP(unsigned char, WS_XG); float* qsa1 = WSP(float, WS_QSA1); bf16* xb0 = WSP(bf16, WS_XB);
    for (int r = gw; r < M; r += 2 * NGW) {
        const int r2 = r + NGW < M ? r + NGW : r;
        const f32x4* xa = (const f32x4*)(x + (size_t)r * D) + F.lane; const f32x4* xb = (const f32x4*)(x + (size_t)r2 * D) + F.lane; f32x4 va[4], vb[4];
#pragma unroll
        for (int j = 0; j < 4; ++j) { va[j] = xa[64 * j]; vb[j] = xb[64 * j]; }
        float sa = 0.f, sb = 0.f;
#pragma unroll
        for (int j = 0; j < 4; ++j) { sa += (va[j][0] * va[j][0] + va[j][1] * va[j][1]) + (va[j][2] * va[j][2] + va[j][3] * va[j][3]); sb += (vb[j][0] * vb[j][0] + vb[j][1] * vb[j][1]) + (vb[j][2] * vb[j][2] + vb[j][3] * vb[j][3]); }
        sa = wave_sum(sa); sb = wave_sum(sb);
        const float rra = __builtin_amdgcn_rsqf(sa * (1.0f / 1024.0f) + 1e-6f), rrb = __builtin_amdgcn_rsqf(sb * (1.0f / 1024.0f) + 1e-6f), isa = 127.0f * rra * (1.0f / pg8::QCLIP8), isb = 127.0f * rrb * (1.0f / pg8::QCLIP8);
        const float* sca = mod + (size_t)(r >> 11) * NMOD + D; const float* scb = mod + (size_t)(r2 >> 11) * NMOD + D;
#pragma unroll
        for (int j = 0; j < 4; ++j) { const int cc = 256 * j + 4 * F.lane; const f32x4 g = *(const f32x4*)(gn + cc), qa = *(const f32x4*)(sca + cc), qb = *(const f32x4*)(scb + cc);
            const f32x4 za = va[j] * (g * (qa + 1.0f)) * isa, zb = vb[j] * (g * (qb + 1.0f)) * isb; unsigned wa = 0u, wb = 0u;
#pragma unroll
            for (int i = 0; i < 4; ++i) { wa |= ((unsigned)((int)fminf(fmaxf(__builtin_rintf(za[i]), -127.f), 127.f) & 255)) << (8 * i); wb |= ((unsigned)((int)fminf(fmaxf(__builtin_rintf(zb[i]), -127.f), 127.f) & 255)) << (8 * i); }
            *(unsigned*)(xq + (size_t)r * D + cc) = wa; *(unsigned*)(xq + (size_t)r2 * D + cc) = wb;
            *(u32x2*)(xb0 + (size_t)r * D + cc) = (u32x2){pk2(va[j][0], va[j][1]), pk2(va[j][2], va[j][3])}; *(u32x2*)(xb0 + (size_t)r2 * D + cc) = (u32x2){pk2(vb[j][0], vb[j][1]), pk2(vb[j][2], vb[j][3])}; }
        if (F.lane < 16) { ssq[(size_t)r * 16 + F.lane] = F.lane == 0 ? sa : 0.f; ssq[(size_t)r2 * 16 + F.lane] = F.lane == 0 ? sb : 0.f; }
        if (F.lane == 0) { qsa1[r] = pg8::QCLIP8 / (127.0f * rra); qsa1[r2] = pg8::QCLIP8 / (127.0f * rrb); }
    }
}

__device__ __forceinline__ void ab_logits(Frame& F, int l) {
    typedef int i32x4_ __attribute__((ext_vector_type(4)));
    const int gw = F.bid * NWAVES + F.wave, NGW = F.G * NWAVES, n = F.lane & 15, kq = F.lane >> 4;
    const unsigned char* xq = WSP(unsigned char, WS_XG); const unsigned char* wab = (const unsigned char*)(WSP(bf16, WS_WAB) + (size_t)l * 16 * D); const float* ssq = WSP(float, WS_SSQ1);
    const float* swab = WSP(float, WS_SWAB) + (size_t)l * 16 * 8; float* ab = WSP(float, WS_ABLOG); const float* qsa1 = WSP(float, WS_QSA1); const float* qsbab = WSP(float, WS_QSB1) + 16384 + l * 16;
    for (int tile = gw; tile < M / 16; tile += NGW) { const int r0 = tile * 16;
        const unsigned char* ap = xq + (size_t)(r0 + n) * D + 16 * kq; const unsigned char* bp = wab + (size_t)n * (2 * D) + 16 * kq;
        i32x4_ acc0 = (i32x4_){0, 0, 0, 0}, acc1 = acc0;
        float rq[4];
#pragma unroll
        for (int i = 0; i < 4; ++i) { const int row = r0 + 4 * kq + i; rq[i] = pg8::row_rstd(ssq, row) * qsa1[row]; }
        i32x4_ af[16], bw[16];
#pragma unroll
        for (int ks = 0; ks < 16; ++ks) { af[ks] = *(const i32x4_*)(ap + 64 * ks); bw[ks] = *(const i32x4_*)(bp + 64 * ks); }
        asm volatile("" ::: "memory");
#pragma unroll
        for (int ks = 0; ks < 16; ks += 2) {
            acc0 = __builtin_amdgcn_mfma_i32_16x16x64_i8(af[ks], bw[ks], acc0, 0, 0, 0);
            acc1 = __builtin_amdgcn_mfma_i32_16x16x64_i8(af[ks + 1], bw[ks + 1], acc1, 0, 0, 0); }
        const i32x4_ acc = acc0 + acc1;
        if (n < 8) { const int b = r0 >> 11; const float sb_ = swab[b * 8 + n], wsc = qsbab[n];
#pragma unroll
            for (int i = 0; i < 4; ++i) { const int row = r0 + 4 * kq + i; ab[(size_t)row * 8 + n] = rq[i] * wsc * (float)acc[i] + sb_; } }
    }
}

__device__ __forceinline__ void sg_simple(Frame& F, int l, int unit) {
    const int b = unit >> 4, nblk = unit & 15; const size_t r0 = (size_t)b * SEQ + nblk * 128;
    const bf16* P = WSP(bf16, WS_P); bf16* Y = WSP(bf16, WS_Y); LAS float* vn = (LAS float*)F.lds;
    for (int pr = F.wave; pr < 512; pr += NWAVES) { const int tok = pr >> 2, h = pr & 3;
        const float v = bf2f(P[(r0 + tok) * NP + PC_VB + h * 64 + F.lane]);
        const float mu = wave_sum(v) * (1.0f / 64.0f), xc = v - mu, var = wave_sum(xc * xc) * (1.0f / 64.0f);
        vn[tok * 256 + h * 64 + F.lane] = xc * __builtin_amdgcn_rsqf(var + EPS) * GIN(I_GLNB)[l * 256 + h * 64 + F.lane]; }
    __syncthreads();
    const int c = F.tid & 255, h = __builtin_amdgcn_readfirstlane(c >> 6), half = __builtin_amdgcn_readfirstlane(F.tid >> 8);
    const float* wsg = GIN(I_WSG) + ((size_t)l * 4 + h) * 128 * 128; const float* bsg = GIN(I_BSG) + ((size_t)l * 4 + h) * 128;
    for (int t4 = 0; t4 < 16; ++t4) { const int t0 = half * 64 + t4 * 4; const int smax = half ? 128 : 64;
        float a0 = bsg[t0], a1 = bsg[t0 + 1], a2 = bsg[t0 + 2], a3 = bsg[t0 + 3];
        const float* w0 = wsg + (size_t)t0 * 128;
        for (int s = 0; s < smax; ++s) { const float v = vn[s * 256 + c]; a0 += w0[s] * v; a1 += w0[128 + s] * v; a2 += w0[256 + s] * v; a3 += w0[384 + s] * v; }
        const float av[4] = {a0, a1, a2, a3};
#pragma unroll
        for (int i = 0; i < 4; ++i) { const size_t r = r0 + t0 + i; Y[r * D + YC_B + c] = (bf16)f2bf(bf2f(P[r * NP + PC_UB + c]) * av[i]); } }
    __syncthreads();
}
__device__ __forceinline__ void pool_simple(Frame& F, int l, int unit) {
    const int b = unit >> 5, t0 = (unit & 31) * 64; const size_t r0 = (size_t)b * SEQ + t0;
    const bf16* P = WSP(bf16, WS_P); bf16* Y = WSP(bf16, WS_Y); LAS float* pl = (LAS float*)F.lds;
    const int c = F.tid & 255, g = __builtin_amdgcn_readfirstlane(c >> 6), half = __builtin_amdgcn_readfirstlane(F.tid >> 8);
    const int W = 2 << g;
    for (int tl = half * 32; tl < half * 32 + 32; ++tl) { const int t = t0 + tl; const int lo = (t + 1 - W) > 0 ? (t + 1 - W) : 0; float s = 0.f;
        for (int q = lo; q <= t; ++q) s += bf2f(P[((size_t)b * SEQ + q) * NP + PC_XC + c]);
        pl[tl * 256 + c] = s / (float)(t + 1 - lo) - bf2f(P[(r0 + tl) * NP + PC_XC + c]); }
    __syncthreads();
    const int d = c & 63; const float* wp = GIN(I_WPOOL) + ((size_t)l * 4 + g) * 64 * 64; const float sp = GIN(I_SPOOL)[l * 256 + c];
    float acc[32];
#pragma unroll
    for (int i = 0; i < 32; ++i) acc[i] = 0.f;
    for (int cc = 0; cc < 64; ++cc) { const float w = wp[cc * 64 + d];
#pragma unroll
        for (int i = 0; i < 32; ++i) acc[i] += pl[(half * 32 + i) * 256 + g * 64 + cc] * w; }
#pragma unroll
    for (int i = 0; i < 32; ++i) Y[(r0 + half * 32 + i) * D + YC_C + c] = (bf16)f2bf(acc[i] * sp);
    __syncthreads();
}
typedef short bf16x8 __attribute__((ext_vector_type(8)));
typedef short s16x4 __attribute__((ext_vector_type(4)));
typedef float f32x16 __attribute__((ext_vector_type(16)));
typedef float f32x2_t __attribute__((ext_vector_type(2))); typedef __bf16 bf16x2_t __attribute__((ext_vector_type(2)));
__device__ __forceinline__ unsigned cvtpk(float lo, float hi) { f32x2_t v = {lo, hi}; bf16x2_t b = __builtin_convertvector(v, bf16x2_t); return __builtin_bit_cast(unsigned, b); }
#define MFMA32(a, b, c) __builtin_amdgcn_mfma_f32_32x32x16_bf16((a), (b), (c), 0, 0, 0)
__device__ __forceinline__ void y_tile_store(LAS unsigned char* ys, const unsigned (&w)[2][4], unsigned char* ydst, int lane) {
    const int r = lane & 31, hf = lane >> 5;
#pragma unroll
    for (int dt = 0; dt < 2; ++dt)
#pragma unroll
        for (int g4 = 0; g4 < 4; ++g4) *(LAS unsigned*)(ys + r * 80 + 32 * dt + 8 * g4 + 4 * hf) = w[dt][g4];
    asm volatile("s_waitcnt lgkmcnt(0)" ::: "memory");
#pragma unroll
    for (int k = 0; k < 2; ++k) { const int row = (lane >> 2) + 16 * k, piece = lane & 3; const u32x4 v = *(const LAS u32x4*)(ys + row * 80 + piece * 16); *(u32x4*)(ydst + (size_t)row * 1024 + piece * 16) = v; }
    asm volatile("" ::: "memory");
}
__device__ __forceinline__ void sb_tile(Frame& F, int l, int b, int h, int qt, LAS unsigned char* wl) {
    int lane_ = F.lane; asm volatile("" : "+v"(lane_));
    const int lane = lane_, r = lane & 31, hf = lane >> 5;
    const bf16* P = WSP(bf16, WS_P); unsigned char* Y = WSP(unsigned char, WS_Y);
    const size_t rowq = (size_t)b * SEQ + qt * 32 + r;
    bf16x8 qf[4];
#pragma unroll
    for (int s = 0; s < 4; ++s) qf[s] = *(const bf16x8*)(P + rowq * NP + PC_QD + h * 64 + 16 * s + 8 * hf);
    f32x16 o0, o1;
#pragma unroll
    for (int i = 0; i < 16; ++i) { o0[i] = 0.f; o1[i] = 0.f; }
    float carry = 0.f;
#define SB_LOADK(KR, KT) do { const size_t rowk_ = (size_t)b * SEQ + (KT) * 32; \
        _Pragma("unroll") for (int i_ = 0; i_ < 4; ++i_) KR[i_] = *(const u32x4*)(P + (rowk_ + 8 * i_ + (lane >> 3)) * NP + PC_KD + h * 64 + (lane & 7) * 8); } while (0)
#define SB_PUTK(KR) do { _Pragma("unroll") for (int i_ = 0; i_ < 4; ++i_) *(LAS u32x4*)(wl + 10240 + (8 * i_ + (lane >> 3)) * 144 + (lane & 7) * 16) = KR[i_]; } while (0)
#define SB_GETK(KF) do { _Pragma("unroll") for (int s_ = 0; s_ < 4; ++s_) KF[s_] = *(const LAS bf16x8*)(wl + 10240 + r * 144 + (16 * s_ + 8 * hf) * 2); } while (0)
#define SB_LOADV(VR, KT) do { const size_t rowk_ = (size_t)b * SEQ + (KT) * 32; \
        _Pragma("unroll") for (int i_ = 0; i_ < 4; ++i_) VR[i_] = *(const u32x4*)(P + (rowk_ + 8 * i_ + (lane >> 3)) * NP + PC_VD + h * 64 + (lane & 7) * 8); } while (0)
#define SB_PUTV(VR, BUF) do { _Pragma("unroll") for (int i_ = 0; i_ < 4; ++i_) *(LAS u32x4*)(wl + (BUF) * 5120 + (8 * i_ + (lane >> 3)) * 160 + (lane & 7) * 16) = VR[i_]; } while (0)
#define SB_GETV(VF, BUF) do { const unsigned a_ = (unsigned)(size_t)(wl + (BUF) * 5120) + (unsigned)((4 * hf + ((lane & 15) >> 2)) * 160 + (16 * ((lane >> 4) & 1) + 4 * (lane & 3)) * 2); \
        s16x4 t0_, t1_, t2_, t3_, t4_, t5_, t6_, t7_; \
        asm volatile("ds_read_b64_tr_b16 %0, %8\n\tds_read_b64_tr_b16 %1, %8 offset:1280\n\tds_read_b64_tr_b16 %2, %8 offset:2560\n\tds_read_b64_tr_b16 %3, %8 offset:3840\n\t" \
                     "ds_read_b64_tr_b16 %4, %8 offset:64\n\tds_read_b64_tr_b16 %5, %8 offset:1344\n\tds_read_b64_tr_b16 %6, %8 offset:2624\n\tds_read_b64_tr_b16 %7, %8 offset:3904\n\ts_waitcnt lgkmcnt(0)" \
                     : "=&v"(t0_), "=&v"(t1_), "=&v"(t2_), "=&v"(t3_), "=&v"(t4_), "=&v"(t5_), "=&v"(t6_), "=&v"(t7_) : "v"(a_) : "memory"); \
        VF[0][0] = (bf16x8){t0_[0], t0_[1], t0_[2], t0_[3], t1_[0], t1_[1], t1_[2], t1_[3]}; VF[0][1] = (bf16x8){t2_[0], t2_[1], t2_[2], t2_[3], t3_[0], t3_[1], t3_[2], t3_[3]}; \
        VF[1][0] = (bf16x8){t4_[0], t4_[1], t4_[2], t4_[3], t5_[0], t5_[1], t5_[2], t5_[3]}; VF[1][1] = (bf16x8){t6_[0], t6_[1], t6_[2], t6_[3], t7_[0], t7_[1], t7_[2], t7_[3]}; } while (0)
    bf16x8 kf[4]; int cur = 0;
    { u32x4 vr[4], kr[4]; SB_LOADK(kr, qt); SB_LOADV(vr, qt); SB_PUTK(kr); SB_PUTV(vr, 0); asm volatile("" ::: "memory"); SB_GETK(kf); }
    for (int kt = qt; kt >= 0; --kt) {
        bf16x8 vf[2][2]; u32x4 vrn[4], krn[4];
        SB_GETV(vf, cur);
        { const int ktn = kt > 0 ? kt - 1 : 0; SB_LOADK(krn, ktn); SB_LOADV(vrn, ktn); }
        f32x16 sa;
#pragma unroll
        for (int i = 0; i < 16; ++i) sa[i] = 0.f;
#pragma unroll
        for (int s = 0; s < 4; ++s) sa = MFMA32(kf[s], qf[s], sa);
        const bool diag = (kt == qt);
        float lf[16], ls[16];
#pragma unroll
        for (int i = 0; i < 16; ++i) { const int kk = (i & 3) + 8 * (i >> 2) + 4 * hf; const float z = sa[i] * 0.125f; const float sp = softplus_f(z);
            const bool past = !diag || (kk < r); lf[i] = past ? -sp : 0.f; ls[i] = past ? (z - sp) : -1e30f; }
        float Gs[4], Gp[4];
#pragma unroll
        for (int j = 0; j < 4; ++j) { Gs[j] = (lf[4 * j] + lf[4 * j + 1]) + (lf[4 * j + 2] + lf[4 * j + 3]); Gp[j] = __shfl_xor(Gs[j], 32); }
        float a[16]; float above = 0.f;
#pragma unroll
        for (int j = 3; j >= 0; --j) {
            const float T = carry + above + (hf == 0 ? Gp[j] : 0.f);
            const float e2 = lf[4 * j + 3], e1 = e2 + lf[4 * j + 2], e0 = e1 + lf[4 * j + 1];
            a[4 * j + 3] = __expf(ls[4 * j + 3] + T); a[4 * j + 2] = __expf(ls[4 * j + 2] + T + e2); a[4 * j + 1] = __expf(ls[4 * j + 1] + T + e1); a[4 * j] = __expf(ls[4 * j] + T + e0);
            above += Gs[j] + Gp[j];
        }
        carry += above;
#pragma unroll
        for (int s2 = 0; s2 < 2; ++s2) { u32x4 pw; pw.x = cvtpk(a[8 * s2], a[8 * s2 + 1]); pw.y = cvtpk(a[8 * s2 + 2], a[8 * s2 + 3]); pw.z = cvtpk(a[8 * s2 + 4], a[8 * s2 + 5]); pw.w = cvtpk(a[8 * s2 + 6], a[8 * s2 + 7]);
            const bf16x8 pf = __builtin_bit_cast(bf16x8, pw);
            o0 = MFMA32(vf[0][s2], pf, o0); o1 = MFMA32(vf[1][s2], pf, o1); }
        if (__all(carry < -24.0f)) break;
        cur ^= 1; SB_PUTV(vrn, cur); SB_PUTK(krn); asm volatile("" ::: "memory"); SB_GETK(kf);
    }
#undef SB_PUTK
#undef SB_GETK
#undef SB_LOADK
#undef SB_LOADV
#undef SB_PUTV
#undef SB_GETV
    float ss = 0.f;
#pragma unroll
    for (int i = 0; i < 16; ++i) ss += o0[i] * o0[i] + o1[i] * o1[i];
    ss += __shfl_xor(ss, 32);
    const float rs = __builtin_amdgcn_rsqf(ss * (1.0f / 64.0f) + EPS);
    const float* go = GIN(I_GOD) + l * 256 + h * 64;
    unsigned yw[2][4];
#pragma unroll
    for (int dt = 0; dt < 2; ++dt)
#pragma unroll
        for (int g4 = 0; g4 < 4; ++g4) { const int d0 = 32 * dt + 8 * g4 + 4 * hf; const f32x4 gg = *(const f32x4*)(go + d0);
            float v0, v1, v2, v3;
            if (dt == 0) { v0 = o0[4 * g4]; v1 = o0[4 * g4 + 1]; v2 = o0[4 * g4 + 2]; v3 = o0[4 * g4 + 3]; } else { v0 = o1[4 * g4]; v1 = o1[4 * g4 + 1]; v2 = o1[4 * g4 + 2]; v3 = o1[4 * g4 + 3]; }
            yw[dt][g4] = q8x4(v0 * rs * gg[0], v1 * rs * gg[1], v2 * rs * gg[2], v3 * rs * gg[3]); }
    y_tile_store(wl + 14848, yw, Y + ((size_t)b * SEQ + qt * 32) * D + YC_D + h * 64, lane);
}
constexpr int CH_UT = 0;
constexpr int CH_WN = 8192;
constexpr int CH_KDT = 16384;
constexpr int CH_QD = 24576;
constexpr int CH_QKF = 32768;
constexpr int CH_EGL = CH_QKF + 2048;
constexpr int CH_STRIDE = 40960;
__device__ __forceinline__ size_t ch_off(int unit) { return unit < 1024 ? WS_CHA + (size_t)unit * CH_STRIDE : WS_CHB + (size_t)(unit - 1024) * CH_STRIDE; }
constexpr int DN_WLDS = 18432;
__device__ __forceinline__ int crow(int reg, int hf) { return (reg & 3) + 8 * (reg >> 2) + 4 * hf; }
__device__ __forceinline__ bf16x8 pack8(float a0, float a1, float a2, float a3, float a4, float a5, float a6, float a7) {
    u32x4 p; p.x = cvtpk(a0, a1); p.y = cvtpk(a2, a3); p.z = cvtpk(a4, a5); p.w = cvtpk(a6, a7); return __builtin_bit_cast(bf16x8, p); }
__device__ __forceinline__ bf16x8 pack_regs(const f32x16& x, int s) { return pack8(x[8 * s], x[8 * s + 1], x[8 * s + 2], x[8 * s + 3], x[8 * s + 4], x[8 * s + 5], x[8 * s + 6], x[8 * s + 7]); }
#define WAVE_LDS_SYNC() asm volatile("s_waitcnt lgkmcnt(0)" ::: "memory")

__device__ __forceinline__ void dn_prep(Frame& F, int l, int unit, LAS unsigned char* wl) {
    int lane = F.lane, r, hf;
#define RELANE() do { asm volatile("" : "+v"(lane)); r = lane & 31; hf = lane >> 5; } while (0)
    RELANE();
    const int bh = unit >> 5, c = unit & 31, b = bh >> 2, h = bh & 3, t0 = c * 64;
    const size_t r0 = (size_t)b * SEQ + t0;
    const bf16* P = WSP(bf16, WS_P); const float* cw = GIN(I_CONV) + (size_t)l * 4 * 768; const float* ab = WSP(float, WS_ABLOG);
    unsigned char* cb = F.ws + ch_off(unit);
    LAS float* Lm = (LAS float*)wl; LAS float* Gt = (LAS float*)(wl + 16896); LAS float* Bt = Gt + 64; LAS float* Rk = Bt + 64; LAS float* Rq = Rk + 64;
    float G63;
    { const float a = ab[(r0 + lane) * 8 + h], bb = ab[(r0 + lane) * 8 + 4 + h];
      float g = -__expf(GIN(I_ALOG)[l * 4 + h]) * softplus_f(a + GIN(I_DTB)[l * 4 + h]);
#pragma unroll
      for (int o = 1; o < 64; o <<= 1) { const float v = __shfl_up(g, o); if (lane >= o) g += v; }
      Gt[lane] = g; Bt[lane] = sigmoid_f(bb); G63 = rdlane(g, 63); }
#define DN_STAGE(colbase, halfoff) do { const bf16* base_ = P + r0 * NP + (colbase) + (lane & 7) * 8; u32x4 w_[8], hw_ = (u32x4){0u, 0u, 0u, 0u}; \
        _Pragma("unroll") for (int k_ = 0; k_ < 8; ++k_) w_[k_] = *(const u32x4*)(base_ + (size_t)(8 * k_ + (lane >> 3)) * NP); \
        if (t0 > 0) { if (lane < 24) hw_ = *(const u32x4*)(base_ + ((long)(lane >> 3) - 3) * NP); } \
        _Pragma("unroll") for (int k_ = 0; k_ < 8; ++k_) { LAS unsigned char* d_ = wl + (8 * k_ + (lane >> 3)) * 264 + (halfoff) + (lane & 7) * 16; *(LAS u32x2*)d_ = (u32x2){w_[k_].x, w_[k_].y}; *(LAS u32x2*)(d_ + 8) = (u32x2){w_[k_].z, w_[k_].w}; } \
        if (lane < 24) *(LAS u32x4*)(wl + 17920 + (lane >> 3) * 128 + (lane & 7) * 16) = hw_; \
        WAVE_LDS_SYNC(); asm volatile("" ::: "memory"); } while (0)
#define DN_RAWCOL(raw, halfoff) do { _Pragma("unroll") for (int i_ = 0; i_ < 3; ++i_) raw[i_] = *(const LAS bf16*)(wl + 17920 + i_ * 128 + lane * 2); \
        _Pragma("unroll") for (int i_ = 0; i_ < 64; ++i_) raw[3 + i_] = *(const LAS bf16*)(wl + i_ * 264 + (halfoff) + lane * 2); } while (0)
    unsigned vpk[32];
    {   const int chv = 512 + h * 64 + lane; const float w0 = cw[chv], w1 = cw[768 + chv], w2 = cw[1536 + chv], w3 = cw[2304 + chv];
        DN_STAGE(512 + h * 64, 0);
        unsigned raw[67]; DN_RAWCOL(raw, 0);
#pragma unroll
        for (int i = 0; i < 64; i += 2) vpk[i >> 1] = cvtpk(silu_f(w0 * bf2f(raw[i]) + w1 * bf2f(raw[i + 1]) + w2 * bf2f(raw[i + 2]) + w3 * bf2f(raw[i + 3])), silu_f(w0 * bf2f(raw[i + 1]) + w1 * bf2f(raw[i + 2]) + w2 * bf2f(raw[i + 3]) + w3 * bf2f(raw[i + 4])));
        WAVE_LDS_SYNC(); asm volatile("" ::: "memory"); }
    {   LAS bf16* T = (LAS bf16*)wl;
#pragma unroll
        for (int which = 0; which < 2; ++which) { const int chn = which * 256 + h * 64 + lane;
            const float w0 = cw[chn], w1 = cw[768 + chn], w2 = cw[1536 + chn], w3 = cw[2304 + chn];
            DN_STAGE(which * 256 + h * 64, which * 128);
            unsigned raw[67]; DN_RAWCOL(raw, which * 128); unsigned kq_[4] = {0u, 0u, 0u, 0u};
            WAVE_LDS_SYNC(); asm volatile("" ::: "memory");
#pragma unroll
            for (int i = 0; i < 64; i += 2) { const unsigned pk_ = cvtpk(silu_f(w0 * bf2f(raw[i]) + w1 * bf2f(raw[i + 1]) + w2 * bf2f(raw[i + 2]) + w3 * bf2f(raw[i + 3])), silu_f(w0 * bf2f(raw[i + 1]) + w1 * bf2f(raw[i + 2]) + w2 * bf2f(raw[i + 3]) + w3 * bf2f(raw[i + 4])));
                T[i * 132 + which * 64 + lane] = (bf16)(pk_ & 0xffffu); T[(i + 1) * 132 + which * 64 + lane] = (bf16)(pk_ >> 16); if (which == 1) { kq_[(i >> 1) & 3] = pk_; if ((i & 6) == 6) *(u32x4*)(cb + CH_WN + ((i >> 3) * 64 + lane) * 16) = (u32x4){kq_[0], kq_[1], kq_[2], kq_[3]}; }     }
            asm volatile("" ::: "memory"); }
    }
    WAVE_LDS_SYNC();
    RELANE();
    bf16x8 qf[2][4], kf[2][4]; float sq[2] = {0.f, 0.f}, sk[2] = {0.f, 0.f};
#pragma unroll
    for (int which = 0; which < 2; ++which)
#pragma unroll
        for (int it = 0; it < 2; ++it)
#pragma unroll
            for (int s = 0; s < 4; ++s) { const LAS unsigned char* tp = wl + (32 * it + r) * 264 + (which * 64 + 16 * s + 4 * hf) * 2;
                const u32x2 lo = *(const LAS u32x2*)tp, hi = *(const LAS u32x2*)(tp + 16); const u32x4 fv = (u32x4){lo.x, lo.y, hi.x, hi.y};
                const float e0 = bf2f(fv.x & 0xffffu), e1 = bf2f(fv.x >> 16), e2 = bf2f(fv.y & 0xffffu), e3 = bf2f(fv.y >> 16), e4 = bf2f(fv.z & 0xffffu), e5 = bf2f(fv.z >> 16), e6 = bf2f(fv.w & 0xffffu), e7 = bf2f(fv.w >> 16);
                const float ss = ((e0 * e0 + e1 * e1) + (e2 * e2 + e3 * e3)) + ((e4 * e4 + e5 * e5) + (e6 * e6 + e7 * e7));
                if (which == 0) { qf[it][s] = __builtin_bit_cast(bf16x8, fv); sq[it] += ss; } else { kf[it][s] = __builtin_bit_cast(bf16x8, fv); sk[it] += ss; } }
#pragma unroll
    for (int it = 0; it < 2; ++it) { sq[it] += __shfl_xor(sq[it], 32); sk[it] += __shfl_xor(sk[it], 32);
        if (hf == 0) { Rq[32 * it + r] = __builtin_amdgcn_rsqf(sq[it] + EPS); Rk[32 * it + r] = __builtin_amdgcn_rsqf(sk[it] + EPS); } }
    WAVE_LDS_SYNC();
#ifndef NO_S3
    RELANE();
#pragma unroll
    for (int tl = 0; tl < 3; ++tl) { const int jt = tl == 2 ? 1 : 0, it = tl == 0 ? 0 : 1;
        RELANE();
        f32x16 acc;
#pragma unroll
        for (int i = 0; i < 16; ++i) acc[i] = 0.f;
#pragma unroll
        for (int s = 0; s < 4; ++s) acc = MFMA32(kf[jt][s], kf[it][s], acc);
        const int i = 32 * it + r; const float ci = Bt[i] * Rk[i], gi = Gt[i];
#pragma unroll
        for (int j16 = 0; j16 < 16; ++j16) { const int j = 32 * jt + crow(j16, hf);
            Lm[j * 64 + i] = (i > j) ? acc[j16] * ci * Rk[j] * __expf(gi - Gt[j]) : 0.f; } }
#endif
#ifndef NO_S4
    RELANE();
#pragma unroll
    for (int tl = 0; tl < 3; ++tl) { const int tt = tl == 0 ? 0 : 1, jt = tl == 2 ? 1 : 0;
        RELANE();
        f32x16 acc;
#pragma unroll
        for (int i = 0; i < 16; ++i) acc[i] = 0.f;
#pragma unroll
        for (int s = 0; s < 4; ++s) acc = MFMA32(kf[jt][s], qf[tt][s], acc);
        const int i = 32 * tt + r; const float ci = Rq[i] * 0.125f, gi = Gt[i];
#pragma unroll
        for (int j16 = 0; j16 < 16; ++j16) { const int j = 32 * jt + crow(j16, hf); acc[j16] = (i >= j) ? acc[j16] * Rk[j] * ci * __expf(gi - Gt[j]) : 0.f; }
#pragma unroll
        for (int s2 = 0; s2 < 2; ++s2) *(bf16x8*)(cb + CH_QKF + (((tt * 2 + jt) * 2 + s2) * 64 + lane) * 16) = pack_regs(acc, s2); }
#pragma unroll
    for (int it = 0; it < 2; ++it) { const int i = 32 * it + r; const float sc = Rq[i] * 0.125f * __expf(Gt[i]);
#pragma unroll
        for (int s = 0; s < 4; ++s) { const u32x4 q = __builtin_bit_cast(u32x4, qf[it][s]);
            *(bf16x8*)(cb + CH_QD + ((it * 4 + s) * 64 + lane) * 16) = pack8(bf2f(q.x & 0xffffu) * sc, bf2f(q.x >> 16) * sc, bf2f(q.y & 0xffffu) * sc, bf2f(q.y >> 16) * sc, bf2f(q.z & 0xffffu) * sc, bf2f(q.z >> 16) * sc, bf2f(q.w & 0xffffu) * sc, bf2f(q.w >> 16) * sc); } }
    WAVE_LDS_SYNC();
#endif
#ifndef NO_S5
    RELANE();
#define DN_SOLVE(X2) do { _Pragma("unroll") for (int j = 0; j < 63; ++j) { const float xj_ = (j & 1) ? X2[j >> 1][1] : X2[j >> 1][0]; const f32x2_t nx_ = (f32x2_t){-xj_, -xj_}; \
        _Pragma("unroll") for (int i4 = (j + 1) / 4; i4 < 16; ++i4) { const f32x4 lv = *(const LAS f32x4*)(Lm + j * 64 + 4 * i4); \
            if (4 * i4 > j) X2[2 * i4] = __builtin_elementwise_fma((f32x2_t){lv[0], lv[1]}, nx_, X2[2 * i4]); \
            else if (4 * i4 + 1 > j) X2[2 * i4][1] = __builtin_fmaf(lv[1], -xj_, X2[2 * i4][1]); \
            if (4 * i4 + 2 > j) X2[2 * i4 + 1] = __builtin_elementwise_fma((f32x2_t){lv[2], lv[3]}, nx_, X2[2 * i4 + 1]); \
            else if (4 * i4 + 3 > j) X2[2 * i4 + 1][1] = __builtin_fmaf(lv[3], -xj_, X2[2 * i4 + 1][1]); } \
        asm volatile("" ::: "memory"); __builtin_amdgcn_sched_barrier(0); } } while (0)
#define DN_SOLVE2(XU, XW) do { _Pragma("unroll") for (int j = 0; j < 63; ++j) { const float xu_ = (j & 1) ? XU[j >> 1][1] : XU[j >> 1][0], xw_ = (j & 1) ? XW[j >> 1][1] : XW[j >> 1][0]; \
        const f32x2_t nu_ = (f32x2_t){-xu_, -xu_}, nw_ = (f32x2_t){-xw_, -xw_}; \
        _Pragma("unroll") for (int i4 = (j + 1) / 4; i4 < 16; ++i4) { const f32x4 lv = *(const LAS f32x4*)(Lm + j * 64 + 4 * i4); \
            if (4 * i4 > j) { XU[2 * i4] = __builtin_elementwise_fma((f32x2_t){lv[0], lv[1]}, nu_, XU[2 * i4]); XW[2 * i4] = __builtin_elementwise_fma((f32x2_t){lv[0], lv[1]}, nw_, XW[2 * i4]); } \
            else if (4 * i4 + 1 > j) { XU[2 * i4][1] = __builtin_fmaf(lv[1], -xu_, XU[2 * i4][1]); XW[2 * i4][1] = __builtin_fmaf(lv[1], -xw_, XW[2 * i4][1]); } \
            if (4 * i4 + 2 > j) { XU[2 * i4 + 1] = __builtin_elementwise_fma((f32x2_t){lv[2], lv[3]}, nu_, XU[2 * i4 + 1]); XW[2 * i4 + 1] = __builtin_elementwise_fma((f32x2_t){lv[2], lv[3]}, nw_, XW[2 * i4 + 1]); } \
            else if (4 * i4 + 3 > j) { XU[2 * i4 + 1][1] = __builtin_fmaf(lv[3], -xu_, XU[2 * i4 + 1][1]); XW[2 * i4 + 1][1] = __builtin_fmaf(lv[3], -xw_, XW[2 * i4 + 1][1]); } } \
        asm volatile("" ::: "memory"); __builtin_amdgcn_sched_barrier(0); } } while (0)
    {
#pragma clang fp contract(off)
        f32x2_t XU[32], XW[32];
        {
#pragma unroll
          for (int i = 0; i < 64; ++i) { XU[i >> 1][i & 1] = ((i & 1) ? bf2f(vpk[i >> 1] >> 16) : bf2f(vpk[i >> 1] & 0xffffu)) * Bt[i];
              if ((i & 7) == 7) { asm volatile("" ::: "memory"); __builtin_amdgcn_sched_barrier(0); } } }
        { u32x4 kpk[8];
#pragma unroll
          for (int i8 = 0; i8 < 8; ++i8) kpk[i8] = *(const u32x4*)(cb + CH_WN + (i8 * 64 + lane) * 16);
          float kd[8];
#pragma unroll
          for (int i = 0; i < 64; ++i) { const unsigned kw_ = kpk[i >> 3][(i >> 1) & 3]; const float kc = ((i & 1) ? bf2f(kw_ >> 16) : bf2f(kw_ & 0xffffu)) * Rk[i], gi = Gt[i];
              XW[i >> 1][i & 1] = kc * Bt[i] * __expf(gi); kd[i & 7] = kc * __expf(G63 - gi);
              if ((i & 7) == 7) { *(bf16x8*)(cb + CH_KDT + ((i >> 3) * 64 + lane) * 16) = pack8(kd[0], kd[1], kd[2], kd[3], kd[4], kd[5], kd[6], kd[7]); asm volatile("" ::: "memory"); __builtin_amdgcn_sched_barrier(0); } } }
        __builtin_amdgcn_sched_barrier(0);
        DN_SOLVE2(XU, XW);
#pragma unroll
        for (int i8 = 0; i8 < 8; ++i8) *(bf16x8*)(cb + CH_UT + (i8 * 64 + lane) * 16) = pack8(XU[4 * i8][0], XU[4 * i8][1], XU[4 * i8 + 1][0], XU[4 * i8 + 1][1], XU[4 * i8 + 2][0], XU[4 * i8 + 2][1], XU[4 * i8 + 3][0], XU[4 * i8 + 3][1]);
        WAVE_LDS_SYNC(); asm volatile("" ::: "memory");
#pragma unroll
        for (int i = 0; i < 64; ++i) *(LAS bf16*)(wl + i * 264 + lane * 2) = (bf16)f2bf(-XW[i >> 1][i & 1]);
        WAVE_LDS_SYNC(); asm volatile("" ::: "memory");
#pragma unroll
        for (int k = 0; k < 8; ++k) { const LAS unsigned char* sp = wl + (8 * k + (lane >> 3)) * 264 + (lane & 7) * 16; const u32x2 lo = *(const LAS u32x2*)sp, hi = *(const LAS u32x2*)(sp + 8);
            *(u32x4*)(cb + CH_WN + (8 * k + (lane >> 3)) * 128 + (lane & 7) * 16) = (u32x4){lo.x, lo.y, hi.x, hi.y}; }
    }
#undef DN_SOLVE2
#undef DN_SOLVE
#undef DN_STAGE
#undef DN_RAWCOL
#endif
#undef RELANE
    if (lane == 0) *(float*)(cb + CH_EGL) = __expf(G63);
    WAVE_LDS_SYNC();
}

constexpr int SCAN_LDS0 = 8192, SCAN_BUF = 49152, SC_GATE = 40960, SCAN_NDMA = 47;
__device__ __forceinline__ void dn_scan_fetch(const unsigned char* cb, const bf16* gate0, LAS unsigned char* buf, int lane) {
    asm volatile("" : "+v"(lane));
    const unsigned rW = lane >> 3, pW = lane & 7;
#pragma unroll
    for (int n = 0; n < 8; ++n) { const unsigned row = 8 * n + rW; const unsigned so = (row * 8 + (pW ^ (row & 7))) * 16;
        __builtin_amdgcn_global_load_lds((const unsigned*)(cb + CH_UT + so), (LAS unsigned*)(buf + CH_UT + n * 1024), 16, 0, 0);
        __builtin_amdgcn_global_load_lds((const unsigned*)(cb + CH_WN + so), (LAS unsigned*)(buf + CH_WN + n * 1024), 16, 0, 0);
        __builtin_amdgcn_global_load_lds((const unsigned*)(cb + CH_KDT + so), (LAS unsigned*)(buf + CH_KDT + n * 1024), 16, 0, 0);
        __builtin_amdgcn_global_load_lds((const unsigned*)(cb + CH_QD + n * 1024 + lane * 16), (LAS unsigned*)(buf + CH_QD + n * 1024), 16, 0, 0);
        if (n != 3) __builtin_amdgcn_global_load_lds((const unsigned*)(cb + CH_QKF + n * 1024 + lane * 16), (LAS unsigned*)(buf + CH_QKF + n * 1024), 16, 0, 0);
        __builtin_amdgcn_global_load_lds((const unsigned*)(gate0 + (size_t)row * NP + 8 * (pW ^ (row & 7))), (LAS unsigned*)(buf + SC_GATE + n * 1024), 16, 0, 0); }
}
__device__ __forceinline__ void dn_scan(Frame& F, int l, int bh) {
    const int lane = F.lane, r = lane & 31, hf = lane >> 5, b = bh >> 2, h = bh & 3;
    const bf16* P = WSP(bf16, WS_P); unsigned char* Y = WSP(unsigned char, WS_Y);
    const unsigned char* cb0 = F.ws + ch_off(bh * 32);
    const bf16* gate00 = P + (size_t)b * SEQ * NP + PC_GATE + h * 64;
    f32x16 S[2][2];
#pragma unroll
    for (int dt = 0; dt < 2; ++dt)
#pragma unroll
        for (int jt = 0; jt < 2; ++jt)
#pragma unroll
            for (int i = 0; i < 16; ++i) S[dt][jt][i] = 0.f;
    dn_scan_fetch(cb0, gate00, F.lds + SCAN_LDS0, lane);
    dn_scan_fetch(cb0 + CH_STRIDE, gate00 + (size_t)64 * NP, F.lds + SCAN_LDS0 + SCAN_BUF, lane);
    asm volatile("s_waitcnt vmcnt(47)" ::: "memory");
    int bi = 0;
    for (int c = 0; c < 32; ++c) {
        asm volatile("s_waitcnt lgkmcnt(0)" ::: "memory");
        { const int cf = (c + 2 < 32) ? c + 2 : 31; const int bf_ = bi == 0 ? 2 : bi - 1;
          dn_scan_fetch(cb0 + (size_t)cf * CH_STRIDE, gate00 + (size_t)cf * 64 * NP, F.lds + SCAN_LDS0 + bf_ * SCAN_BUF, lane); }
        const LAS unsigned char* lb = F.lds + SCAN_LDS0 + bi * SCAN_BUF;
        bi = bi == 2 ? 0 : bi + 1;
        const size_t r0 = (size_t)b * SEQ + c * 64;
        const float egl = *(const LAS float*)(lb + CH_EGL);
        bf16x8 Sp[2][2][2];
#pragma unroll
        for (int dt = 0; dt < 2; ++dt)
#pragma unroll
            for (int jt = 0; jt < 2; ++jt) { Sp[dt][jt][0] = pack_regs(S[dt][jt], 0); Sp[dt][jt][1] = pack_regs(S[dt][jt], 1); }
        f32x16 vn[2][2];
#pragma unroll
        for (int it = 0; it < 2; ++it)
#pragma unroll
            for (int jt = 0; jt < 2; ++jt)
#pragma unroll
                for (int g4 = 0; g4 < 4; ++g4) { const unsigned row = 32 * jt + r; const u32x2 u = *(const LAS u32x2*)(lb + CH_UT + row * 128 + (((4 * it + g4) ^ (row & 7)) * 16) + 8 * hf);
                    vn[it][jt][4 * g4] = bf2f(u.x & 0xffffu); vn[it][jt][4 * g4 + 1] = bf2f(u.x >> 16); vn[it][jt][4 * g4 + 2] = bf2f(u.y & 0xffffu); vn[it][jt][4 * g4 + 3] = bf2f(u.y >> 16); }
#pragma unroll
        for (int it = 0; it < 2; ++it) { bf16x8 wf[4];
#pragma unroll
            for (int s = 0; s < 4; ++s) { const unsigned row = 32 * it + r; const LAS unsigned char* wp = lb + CH_WN + row * 128 + 8 * hf; const unsigned sw = row & 7;
                const u32x2 lo = *(const LAS u32x2*)(wp + (((2 * s) ^ sw) * 16)), hi = *(const LAS u32x2*)(wp + (((2 * s + 1) ^ sw) * 16)); wf[s] = __builtin_bit_cast(bf16x8, (u32x4){lo.x, lo.y, hi.x, hi.y}); }
            asm volatile("" ::: "memory");
#pragma unroll
            for (int s = 0; s < 4; ++s) { vn[it][0] = MFMA32(wf[s], Sp[s >> 1][0][s & 1], vn[it][0]); vn[it][1] = MFMA32(wf[s], Sp[s >> 1][1][s & 1], vn[it][1]); } }
        bf16x8 Vp[2][2][2];
#pragma unroll
        for (int it = 0; it < 2; ++it)
#pragma unroll
            for (int jt = 0; jt < 2; ++jt) { Vp[it][jt][0] = pack_regs(vn[it][jt], 0); Vp[it][jt][1] = pack_regs(vn[it][jt], 1); }
#pragma unroll
        for (int dt = 0; dt < 2; ++dt)
#pragma unroll
            for (int jt = 0; jt < 2; ++jt)
#pragma unroll
                for (int i = 0; i < 16; ++i) S[dt][jt][i] *= egl;
#pragma unroll
        for (int dt = 0; dt < 2; ++dt) { bf16x8 kfr[4];
#pragma unroll
            for (int q = 0; q < 4; ++q) { const unsigned row = 32 * dt + r; const LAS unsigned char* kp = lb + CH_KDT + row * 128 + 8 * hf; const unsigned sw = row & 7, c0 = 2 * q;
                const u32x2 lo = *(const LAS u32x2*)(kp + ((c0 ^ sw) * 16)), hi = *(const LAS u32x2*)(kp + (((c0 + 1) ^ sw) * 16)); kfr[q] = __builtin_bit_cast(bf16x8, (u32x4){lo.x, lo.y, hi.x, hi.y}); }
            asm volatile("" ::: "memory");
#pragma unroll
            for (int q = 0; q < 4; ++q) { S[dt][0] = MFMA32(kfr[q], Vp[q >> 1][0][q & 1], S[dt][0]); S[dt][1] = MFMA32(kfr[q], Vp[q >> 1][1][q & 1], S[dt][1]); } }
#pragma unroll
        for (int tt = 0; tt < 2; ++tt) {
            f32x16 o[2];
#pragma unroll
            for (int jt = 0; jt < 2; ++jt)
#pragma unroll
                for (int i = 0; i < 16; ++i) o[jt][i] = 0.f;
            bf16x8 qd[4], qk[4];
#pragma unroll
            for (int s = 0; s < 4; ++s) qd[s] = *(const LAS bf16x8*)(lb + CH_QD + ((tt * 4 + s) * 64 + lane) * 16);
#pragma unroll
            for (int q = 0; q < 2 * (tt + 1); ++q) qk[q] = *(const LAS bf16x8*)(lb + CH_QKF + ((tt * 4 + q) * 64 + lane) * 16);
            asm volatile("" ::: "memory");
#pragma unroll
            for (int s = 0; s < 4; ++s) { o[0] = MFMA32(Sp[s >> 1][0][s & 1], qd[s], o[0]); o[1] = MFMA32(Sp[s >> 1][1][s & 1], qd[s], o[1]); }
#pragma unroll
            for (int q = 0; q < 2 * (tt + 1); ++q) { o[0] = MFMA32(Vp[q >> 1][0][q & 1], qk[q], o[0]); o[1] = MFMA32(Vp[q >> 1][1][q & 1], qk[q], o[1]); }
            float ss = 0.f;
#pragma unroll
            for (int i = 0; i < 16; ++i) ss += o[0][i] * o[0][i] + o[1][i] * o[1][i];
            ss += __shfl_xor(ss, 32);
            const float rs = __builtin_amdgcn_rsqf(ss * (1.0f / 64.0f) + EPS);
            const size_t row = r0 + 32 * tt + r;
            if (tt == 0) asm volatile("s_waitcnt vmcnt(47)" ::: "memory");
#pragma unroll
            for (int jt = 0; jt < 2; ++jt)
#pragma unroll
                for (int g4 = 0; g4 < 4; ++g4) { const int d0 = 32 * jt + 8 * g4 + 4 * hf;
                    const unsigned trow = 32 * tt + r; const u32x2 gv = *(const LAS u32x2*)(lb + SC_GATE + trow * 128 + (((4 * jt + g4) ^ (trow & 7)) * 16) + 8 * hf);
                    const float y0 = o[jt][4 * g4] * rs * bf2f(gv.x & 0xffffu), y1 = o[jt][4 * g4 + 1] * rs * bf2f(gv.x >> 16);
                    const float y2 = o[jt][4 * g4 + 2] * rs * bf2f(gv.y & 0xffffu), y3 = o[jt][4 * g4 + 3] * rs * bf2f(gv.y >> 16);
                    *(unsigned*)(Y + row * D + YC_A + h * 64 + d0) = q8x4(y0, y1, y2, y3); }
        }
    }
    asm volatile("s_waitcnt vmcnt(0) lgkmcnt(0)" ::: "memory");
}
constexpr int SL_RING = 8192, SL_BUF = 24576, SL_HO = 81920, SL_HOSLOT = 16384, SL_GATE = 131072, SL_FLAGS = 162048;
__device__ __forceinline__ void dn_lead_fetch(const unsigned char* cb, LAS unsigned char* buf, int lane) {
    asm volatile("" : "+v"(lane));
    const unsigned rW = lane >> 3, pW = lane & 7;
#pragma unroll
    for (int n = 0; n < 8; ++n) { const unsigned row = 8 * n + rW; const unsigned so = (row * 8 + (pW ^ (row & 7))) * 16, sp = ((pW ^ (row & 7)) * 64 + row) * 16;
        __builtin_amdgcn_global_load_lds((const unsigned*)(cb + CH_UT + sp), (LAS unsigned*)(buf + n * 1024), 16, 0, 0);
        __builtin_amdgcn_global_load_lds((const unsigned*)(cb + CH_WN + so), (LAS unsigned*)(buf + 8192 + n * 1024), 16, 0, 0);
        __builtin_amdgcn_global_load_lds((const unsigned*)(cb + CH_KDT + sp), (LAS unsigned*)(buf + 16384 + n * 1024), 16, 0, 0); }
}
__device__ __forceinline__ void dn_scan_lead(Frame& F, int l, int bh) {
    int lane = F.lane; asm volatile("" : "+v"(lane)); const int r = lane & 31, hf = lane >> 5;
    const unsigned char* cb0 = F.ws + ch_off(bh * 32);
    volatile LAS unsigned* fl = (volatile LAS unsigned*)(F.lds + SL_FLAGS); volatile LAS unsigned* hand = fl + 1; volatile LAS unsigned* done = fl + 33;
    const unsigned tag = (unsigned)(l + 1);
    const float eglv = *(const float*)(cb0 + (size_t)(lane & 31) * CH_STRIDE + CH_EGL);
    f32x16 S[2][2];
#pragma unroll
    for (int dt = 0; dt < 2; ++dt)
#pragma unroll
        for (int jt = 0; jt < 2; ++jt)
#pragma unroll
            for (int i = 0; i < 16; ++i) S[dt][jt][i] = 0.f;
    asm volatile("s_waitcnt vmcnt(0)" ::: "memory");
    dn_lead_fetch(cb0, F.lds + SL_RING, lane);
    dn_lead_fetch(cb0 + CH_STRIDE, F.lds + SL_RING + SL_BUF, lane);
    asm volatile("s_waitcnt vmcnt(24)" ::: "memory");
    int bi = 0;
    for (int c = 0; c < 32; ++c) {
        asm volatile("s_waitcnt lgkmcnt(0)" ::: "memory");
        { const int cf = (c + 2 < 32) ? c + 2 : 31; const int bf_ = bi == 0 ? 2 : bi - 1;
          dn_lead_fetch(cb0 + (size_t)cf * CH_STRIDE, F.lds + SL_RING + bf_ * SL_BUF, lane); }
        const LAS unsigned char* lb = F.lds + SL_RING + bi * SL_BUF;
        LAS unsigned char* ho = F.lds + SL_HO + bi * SL_HOSLOT;
        bi = bi == 2 ? 0 : bi + 1;
        const float egl = rdlane(eglv, c);
        bf16x8 Sp[2][2][2];
#pragma unroll
        for (int dt = 0; dt < 2; ++dt)
#pragma unroll
            for (int jt = 0; jt < 2; ++jt) { Sp[dt][jt][0] = pack_regs(S[dt][jt], 0); Sp[dt][jt][1] = pack_regs(S[dt][jt], 1); }
        f32x16 vn[2][2];
#pragma unroll
        for (int it = 0; it < 2; ++it)
#pragma unroll
            for (int jt = 0; jt < 2; ++jt)
#pragma unroll
                for (int g4 = 0; g4 < 4; ++g4) { const unsigned row = 32 * jt + r; const u32x2 u = *(const LAS u32x2*)(lb + row * 128 + (((4 * it + g4) ^ (row & 7)) * 16) + 8 * hf);
                    vn[it][jt][4 * g4] = bf2f(u.x & 0xffffu); vn[it][jt][4 * g4 + 1] = bf2f(u.x >> 16); vn[it][jt][4 * g4 + 2] = bf2f(u.y & 0xffffu); vn[it][jt][4 * g4 + 3] = bf2f(u.y >> 16); }
#pragma unroll
        for (int it = 0; it < 2; ++it) { bf16x8 wf[4];
#pragma unroll
            for (int s = 0; s < 4; ++s) { const unsigned row = 32 * it + r; const LAS unsigned char* wp = lb + 8192 + row * 128 + 8 * hf; const unsigned sw = row & 7;
                const u32x2 lo = *(const LAS u32x2*)(wp + (((2 * s) ^ sw) * 16)), hi = *(const LAS u32x2*)(wp + (((2 * s + 1) ^ sw) * 16)); wf[s] = __builtin_bit_cast(bf16x8, (u32x4){lo.x, lo.y, hi.x, hi.y}); }
            asm volatile("" ::: "memory");
#pragma unroll
            for (int s = 0; s < 4; ++s) { vn[it][0] = MFMA32(wf[s], Sp[s >> 1][0][s & 1], vn[it][0]); vn[it][1] = MFMA32(wf[s], Sp[s >> 1][1][s & 1], vn[it][1]); } }
        bf16x8 Vp[2][2][2];
#pragma unroll
        for (int it = 0; it < 2; ++it)
#pragma unroll
            for (int jt = 0; jt < 2; ++jt) { Vp[it][jt][0] = pack_regs(vn[it][jt], 0); Vp[it][jt][1] = pack_regs(vn[it][jt], 1); }
        if (c >= 3) { unsigned spins = 0; while ((unsigned)__builtin_amdgcn_readfirstlane(done[c - 3]) < tag) { if (++spins > (1u << 22)) break; } }
        asm volatile("" ::: "memory");
#pragma unroll
        for (int a = 0; a < 2; ++a)
#pragma unroll
            for (int jt = 0; jt < 2; ++jt)
#pragma unroll
                for (int s2 = 0; s2 < 2; ++s2) { *(LAS bf16x8*)(ho + (((a * 2 + jt) * 2 + s2) * 64 + lane) * 16) = Sp[a][jt][s2]; *(LAS bf16x8*)(ho + 8192 + (((a * 2 + jt) * 2 + s2) * 64 + lane) * 16) = Vp[a][jt][s2]; }
        asm volatile("s_waitcnt lgkmcnt(0)" ::: "memory");
        if (lane == 0) hand[c] = tag;
#pragma unroll
        for (int dt = 0; dt < 2; ++dt)
#pragma unroll
            for (int jt = 0; jt < 2; ++jt)
#pragma unroll
                for (int i = 0; i < 16; ++i) S[dt][jt][i] *= egl;
#pragma unroll
        for (int dt = 0; dt < 2; ++dt) { bf16x8 kfr[4];
#pragma unroll
            for (int q = 0; q < 4; ++q) { const unsigned row = 32 * dt + r; const LAS unsigned char* kp = lb + 16384 + row * 128 + 8 * hf; const unsigned sw = row & 7, c0 = 2 * q;
                const u32x2 lo = *(const LAS u32x2*)(kp + ((c0 ^ sw) * 16)), hi = *(const LAS u32x2*)(kp + (((c0 + 1) ^ sw) * 16)); kfr[q] = __builtin_bit_cast(bf16x8, (u32x4){lo.x, lo.y, hi.x, hi.y}); }
            asm volatile("" ::: "memory");
#pragma unroll
            for (int q = 0; q < 4; ++q) { S[dt][0] = MFMA32(kfr[q], Vp[q >> 1][0][q & 1], S[dt][0]); S[dt][1] = MFMA32(kfr[q], Vp[q >> 1][1][q & 1], S[dt][1]); } }
        asm volatile("s_waitcnt vmcnt(24)" ::: "memory");
    }
    asm volatile("s_waitcnt vmcnt(0) lgkmcnt(0)" ::: "memory");
}
template <int JT> __device__ __forceinline__ void dn_lead2_fetch(const unsigned char* cb, LAS unsigned char* buf, int lane) {
    asm volatile("" : "+v"(lane));
    const unsigned rW = lane >> 3, pW = lane & 7;
#pragma unroll
    for (int n = 0; n < 8; ++n) { const unsigned row = 8 * n + rW; const unsigned so = (row * 8 + (pW ^ (row & 7))) * 16, sp = ((pW ^ (row & 7)) * 64 + row) * 16;
        if ((n >> 2) == JT) __builtin_amdgcn_global_load_lds((const unsigned*)(cb + CH_UT + sp), (LAS unsigned*)(buf + n * 1024), 16, 0, 0);
        if (JT == 0) { __builtin_amdgcn_global_load_lds((const unsigned*)(cb + CH_WN + so), (LAS unsigned*)(buf + 8192 + n * 1024), 16, 0, 0);
                       __builtin_amdgcn_global_load_lds((const unsigned*)(cb + CH_KDT + sp), (LAS unsigned*)(buf + 16384 + n * 1024), 16, 0, 0); } }
}
template <int JT> __device__ __forceinline__ void dn_scan_lead2(Frame& F, int l, int bh) {
    int lane = F.lane; asm volatile("" : "+v"(lane)); const int r = lane & 31, hf = lane >> 5;
    const unsigned char* cb0 = F.ws + ch_off(bh * 32);
    volatile LAS unsigned* fl = (volatile LAS unsigned*)(F.lds + SL_FLAGS); volatile LAS unsigned* hand = fl + 1 + 64 * JT; volatile LAS unsigned* done = fl + 33; volatile LAS unsigned* landed = fl + 97; volatile LAS unsigned* prog1 = fl + 129;
    const unsigned tag = (unsigned)(l + 1), pbase = 64u * (unsigned)l;
    if (JT == 1) { unsigned spins = 0; while ((unsigned)__builtin_amdgcn_readfirstlane(fl[0]) < tag) { __builtin_amdgcn_s_sleep(2); if (++spins > (1u << 22)) break; } }
    const float eglv = *(const float*)(cb0 + (size_t)(lane & 31) * CH_STRIDE + CH_EGL);
    f32x16 S[2];
#pragma unroll
    for (int dt = 0; dt < 2; ++dt)
#pragma unroll
        for (int i = 0; i < 16; ++i) S[dt][i] = 0.f;
    asm volatile("s_waitcnt vmcnt(0)" ::: "memory");
    dn_lead2_fetch<JT>(cb0, F.lds + SL_RING, lane);
    dn_lead2_fetch<JT>(cb0 + CH_STRIDE, F.lds + SL_RING + SL_BUF, lane);
    if (JT == 0) { asm volatile("s_waitcnt vmcnt(20)" ::: "memory"); if (lane == 0) landed[0] = tag; } else asm volatile("s_waitcnt vmcnt(4)" ::: "memory");
    int bi = 0;
    for (int c = 0; c < 32; ++c) {
        asm volatile("s_waitcnt lgkmcnt(0)" ::: "memory");
        if (JT == 1) { if (lane == 0) prog1[0] = pbase + (unsigned)c; }
        else { unsigned spins = 0; while ((unsigned)__builtin_amdgcn_readfirstlane(prog1[0]) < pbase + (unsigned)c) { if (++spins > (1u << 22)) break; } }
        asm volatile("" ::: "memory");
        { const int cf = (c + 2 < 32) ? c + 2 : 31; const int bf_ = bi == 0 ? 2 : bi - 1;
          dn_lead2_fetch<JT>(cb0 + (size_t)cf * CH_STRIDE, F.lds + SL_RING + bf_ * SL_BUF, lane); }
        if (JT == 1) { unsigned spins = 0; while ((unsigned)__builtin_amdgcn_readfirstlane(landed[c]) < tag) { if (++spins > (1u << 22)) break; } }
        asm volatile("" ::: "memory");
        const LAS unsigned char* lb = F.lds + SL_RING + bi * SL_BUF;
        LAS unsigned char* ho = F.lds + SL_HO + bi * SL_HOSLOT;
        bi = bi == 2 ? 0 : bi + 1;
        const float egl = rdlane(eglv, c);
        bf16x8 Sp[2][2];
#pragma unroll
        for (int dt = 0; dt < 2; ++dt) { Sp[dt][0] = pack_regs(S[dt], 0); Sp[dt][1] = pack_regs(S[dt], 1); }
        f32x16 vn[2];
#pragma unroll
        for (int it = 0; it < 2; ++it)
#pragma unroll
            for (int g4 = 0; g4 < 4; ++g4) { const unsigned row = 32 * JT + r; const u32x2 u = *(const LAS u32x2*)(lb + row * 128 + (((4 * it + g4) ^ (row & 7)) * 16) + 8 * hf);
                vn[it][4 * g4] = bf2f(u.x & 0xffffu); vn[it][4 * g4 + 1] = bf2f(u.x >> 16); vn[it][4 * g4 + 2] = bf2f(u.y & 0xffffu); vn[it][4 * g4 + 3] = bf2f(u.y >> 16); }
#pragma unroll
        for (int it = 0; it < 2; ++it) { bf16x8 wf[4];
#pragma unroll
            for (int s = 0; s < 4; ++s) { const unsigned row = 32 * it + r; const LAS unsigned char* wp = lb + 8192 + row * 128 + 8 * hf; const unsigned sw = row & 7;
                const u32x2 lo = *(const LAS u32x2*)(wp + (((2 * s) ^ sw) * 16)), hi = *(const LAS u32x2*)(wp + (((2 * s + 1) ^ sw) * 16)); wf[s] = __builtin_bit_cast(bf16x8, (u32x4){lo.x, lo.y, hi.x, hi.y}); }
            asm volatile("" ::: "memory");
#pragma unroll
            for (int s = 0; s < 4; ++s) vn[it] = MFMA32(wf[s], Sp[s >> 1][s & 1], vn[it]); }
        bf16x8 Vp[2][2];
#pragma unroll
        for (int it = 0; it < 2; ++it) { Vp[it][0] = pack_regs(vn[it], 0); Vp[it][1] = pack_regs(vn[it], 1); }
        if (c >= 3) { unsigned spins = 0; while ((unsigned)__builtin_amdgcn_readfirstlane(done[c - 3]) < tag) { if (++spins > (1u << 22)) break; } }
        asm volatile("" ::: "memory");
#pragma unroll
        for (int a = 0; a < 2; ++a)
#pragma unroll
            for (int s2 = 0; s2 < 2; ++s2) { *(LAS bf16x8*)(ho + (((a * 2 + JT) * 2 + s2) * 64 + lane) * 16) = Sp[a][s2]; *(LAS bf16x8*)(ho + 8192 + (((a * 2 + JT) * 2 + s2) * 64 + lane) * 16) = Vp[a][s2]; }
        asm volatile("s_waitcnt lgkmcnt(0)" ::: "memory");
        if (lane == 0) hand[c] = tag;
#pragma unroll
        for (int dt = 0; dt < 2; ++dt)
#pragma unroll
            for (int i = 0; i < 16; ++i) S[dt][i] *= egl;
#pragma unroll
        for (int dt = 0; dt < 2; ++dt) { bf16x8 kfr[4];
#pragma unroll
            for (int q = 0; q < 4; ++q) { const unsigned row = 32 * dt + r; const LAS unsigned char* kp = lb + 16384 + row * 128 + 8 * hf; const unsigned sw = row & 7, c0 = 2 * q;
                const u32x2 lo = *(const LAS u32x2*)(kp + ((c0 ^ sw) * 16)), hi = *(const LAS u32x2*)(kp + (((c0 + 1) ^ sw) * 16)); kfr[q] = __builtin_bit_cast(bf16x8, (u32x4){lo.x, lo.y, hi.x, hi.y}); }
            asm volatile("" ::: "memory");
#pragma unroll
            for (int q = 0; q < 4; ++q) S[dt] = MFMA32(kfr[q], Vp[q >> 1][q & 1], S[dt]); }
        if (JT == 0) { asm volatile("s_waitcnt vmcnt(20)" ::: "memory"); if (lane == 0 && c + 1 < 32) landed[c + 1] = tag; }
        else asm volatile("s_waitcnt vmcnt(4)" ::: "memory");
    }
    asm volatile("s_waitcnt vmcnt(0) lgkmcnt(0)" ::: "memory");
}
__device__ __forceinline__ void dn_scan_help(Frame& F, int l, int bh, int hidx) {
    int lane = F.lane; asm volatile("" : "+v"(lane)); const int r = lane & 31, hf = lane >> 5, b = bh >> 2, h = bh & 3;
    const bf16* P = WSP(bf16, WS_P); unsigned char* Y = WSP(unsigned char, WS_Y);
    const unsigned char* cb0 = F.ws + ch_off(bh * 32);
    const bf16* gate00 = P + (size_t)b * SEQ * NP + PC_GATE + h * 64;
    volatile LAS unsigned* fl = (volatile LAS unsigned*)(F.lds + SL_FLAGS); volatile LAS unsigned* hand = fl + 1; volatile LAS unsigned* done = fl + 33;
    const unsigned tag = (unsigned)(l + 1);
    LAS unsigned char* gb = F.lds + SL_GATE + hidx * 8192;
    { unsigned spins = 0; while ((unsigned)__builtin_amdgcn_readfirstlane(fl[0]) < tag) { __builtin_amdgcn_s_sleep(2); if (++spins > (1u << 22)) break; } }
    const unsigned rW = lane >> 3, pW = lane & 7;
    for (int c = hidx; c < 32; c += 2) {
        const unsigned char* cb = cb0 + (size_t)c * CH_STRIDE; const size_t r0 = (size_t)b * SEQ + c * 64; const bf16* gate0 = gate00 + (size_t)c * 64 * NP;
        asm volatile("s_waitcnt lgkmcnt(0)" ::: "memory");
#pragma unroll
        for (int n = 0; n < 8; ++n) { const unsigned row = 8 * n + rW;
            __builtin_amdgcn_global_load_lds((const unsigned*)(gate0 + (size_t)row * NP + 8 * (pW ^ (row & 7))), (LAS unsigned*)(gb + n * 1024), 16, 0, 0); }
        bf16x8 qd[8], qk[6];
#pragma unroll
        for (int i = 0; i < 8; ++i) qd[i] = *(const bf16x8*)(cb + CH_QD + (i * 64 + lane) * 16);
#pragma unroll
        for (int i = 0; i < 6; ++i) qk[i] = *(const bf16x8*)(cb + CH_QKF + (((i < 2 ? i : i + 2)) * 64 + lane) * 16);
        { unsigned spins = 0; while ((unsigned)__builtin_amdgcn_readfirstlane(hand[c]) < tag || (unsigned)__builtin_amdgcn_readfirstlane(hand[64 + c]) < tag) { if (++spins > (1u << 22)) break; } }
        asm volatile("" ::: "memory");
        const LAS unsigned char* ho = F.lds + SL_HO + (c % 3) * SL_HOSLOT;
        bf16x8 Sp[2][2][2], Vp[2][2][2];
#pragma unroll
        for (int a = 0; a < 2; ++a)
#pragma unroll
            for (int jt = 0; jt < 2; ++jt)
#pragma unroll
                for (int s2 = 0; s2 < 2; ++s2) { Sp[a][jt][s2] = *(const LAS bf16x8*)(ho + (((a * 2 + jt) * 2 + s2) * 64 + lane) * 16); Vp[a][jt][s2] = *(const LAS bf16x8*)(ho + 8192 + (((a * 2 + jt) * 2 + s2) * 64 + lane) * 16); }
        asm volatile("s_waitcnt lgkmcnt(0)" ::: "memory");
        if (lane == 0) done[c] = tag;
        asm volatile("s_waitcnt vmcnt(0)" ::: "memory");
#pragma unroll
        for (int tt = 0; tt < 2; ++tt) {
            f32x16 o[2];
#pragma unroll
            for (int jt = 0; jt < 2; ++jt)
#pragma unroll
                for (int i = 0; i < 16; ++i) o[jt][i] = 0.f;
#pragma unroll
            for (int s = 0; s < 4; ++s) { o[0] = MFMA32(Sp[s >> 1][0][s & 1], qd[tt * 4 + s], o[0]); o[1] = MFMA32(Sp[s >> 1][1][s & 1], qd[tt * 4 + s], o[1]); }
#pragma unroll
            for (int q = 0; q < 2 * (tt + 1); ++q) { o[0] = MFMA32(Vp[q >> 1][0][q & 1], qk[2 * tt + q], o[0]); o[1] = MFMA32(Vp[q >> 1][1][q & 1], qk[2 * tt + q], o[1]); }
            float ss = 0.f;
#pragma unroll
            for (int i = 0; i < 16; ++i) ss += o[0][i] * o[0][i] + o[1][i] * o[1][i];
            ss += __shfl_xor(ss, 32);
            const float rs = __builtin_amdgcn_rsqf(ss * (1.0f / 64.0f) + EPS);
            const size_t row = r0 + 32 * tt + r;
            unsigned yw[2][4];
#pragma unroll
            for (int jt = 0; jt < 2; ++jt)
#pragma unroll
                for (int g4 = 0; g4 < 4; ++g4) {
                    const unsigned trow = 32 * tt + r; const u32x2 gv = *(const LAS u32x2*)(gb + trow * 128 + (((4 * jt + g4) ^ (trow & 7)) * 16) + 8 * hf);
                    const float y0 = o[jt][4 * g4] * rs * bf2f(gv.x & 0xffffu), y1 = o[jt][4 * g4 + 1] * rs * bf2f(gv.x >> 16);
                    const float y2 = o[jt][4 * g4 + 2] * rs * bf2f(gv.y & 0xffffu), y3 = o[jt][4 * g4 + 3] * rs * bf2f(gv.y >> 16);
                    yw[jt][g4] = q8x4(y0, y1, y2, y3); }
            y_tile_store(F.lds + 147456 + hidx * 2560, yw, Y + (r0 + 32 * tt) * D + YC_A + h * 64, lane);
        }
    }
    asm volatile("s_waitcnt vmcnt(0) lgkmcnt(0)" ::: "memory");
}
__device__ __forceinline__ void sg_tile(Frame& F, int l, int unit, LAS unsigned char* wl) {
    int lane = F.lane; asm volatile("" : "+v"(lane)); const int r = lane & 31, hf = lane >> 5;
    const int h = unit & 3, bn = unit >> 2; const size_t r0 = (size_t)(bn >> 4) * SEQ + (bn & 15) * 128;
    const bf16* P = WSP(bf16, WS_P); unsigned char* Y = WSP(unsigned char, WS_Y); const bf16* wsg = WSP(bf16, WS_WSG) + (size_t)(l * 4 + h) * 128 * 128;
    LAS float* MU = (LAS float*)wl; LAS float* RS = MU + 128;
    LAS unsigned char* vt = wl + 1024;
    { u32x4 w_[16];
#pragma unroll
      for (int i = 0; i < 16; ++i) w_[i] = *(const u32x4*)(P + (r0 + 8 * i + (lane >> 3)) * NP + PC_VB + h * 64 + (lane & 7) * 8);
#pragma unroll
      for (int i = 0; i < 16; ++i) { LAS unsigned char* d_ = vt + (8 * i + (lane >> 3)) * 136 + (lane & 7) * 16; *(LAS u32x2*)d_ = (u32x2){w_[i].x, w_[i].y}; *(LAS u32x2*)(d_ + 8) = (u32x2){w_[i].z, w_[i].w}; } }
    WAVE_LDS_SYNC(); asm volatile("" ::: "memory");
#pragma unroll
    for (int tk = 0; tk < 2; ++tk) { const int s = lane + 64 * tk; const LAS u32x2* vp = (const LAS u32x2*)(vt + s * 136);
        float x[64];
#pragma unroll
        for (int c4 = 0; c4 < 16; ++c4) { const u32x2 v = vp[c4]; x[4 * c4] = bf2f(v.x & 0xffffu); x[4 * c4 + 1] = bf2f(v.x >> 16); x[4 * c4 + 2] = bf2f(v.y & 0xffffu); x[4 * c4 + 3] = bf2f(v.y >> 16); }
        float sm = 0.f;
#pragma unroll
        for (int i = 0; i < 64; ++i) sm += x[i];
        const float mu = sm * (1.0f / 64.0f); float vr = 0.f;
#pragma unroll
        for (int i = 0; i < 64; ++i) { const float dx = x[i] - mu; vr += dx * dx; }
        MU[s] = mu; RS[s] = __builtin_amdgcn_rsqf(vr * (1.0f / 64.0f) + EPS); }
    WAVE_LDS_SYNC();
    bf16x8 af[2][8];
    { const float g0 = GIN(I_GLNB)[l * 256 + h * 64 + r], g1 = GIN(I_GLNB)[l * 256 + h * 64 + 32 + r];
      const LAS bf16* vcol = (const LAS bf16*)(vt + r * 2);
#pragma unroll
      for (int ks = 0; ks < 8; ++ks) { float a0[8], a1[8];
#pragma unroll
          for (int j = 0; j < 8; ++j) { const int s = 16 * ks + 8 * hf + j; const float mu = MU[s], rs = RS[s];
              a0[j] = (bf2f(vcol[s * 68]) - mu) * rs * g0; a1[j] = (bf2f(vcol[s * 68 + 32]) - mu) * rs * g1; }
          af[0][ks] = pack8(a0[0], a0[1], a0[2], a0[3], a0[4], a0[5], a0[6], a0[7]); af[1][ks] = pack8(a1[0], a1[1], a1[2], a1[3], a1[4], a1[5], a1[6], a1[7]);
          if (ks & 1) asm volatile("" ::: "memory"); } }
    { u32x4 w_[16];
#pragma unroll
      for (int i = 0; i < 16; ++i) w_[i] = *(const u32x4*)(P + (r0 + 8 * i + (lane >> 3)) * NP + PC_UB + h * 64 + (lane & 7) * 8);
      asm volatile("s_waitcnt lgkmcnt(0)" ::: "memory");
#pragma unroll
      for (int i = 0; i < 16; ++i) { LAS unsigned char* d_ = vt + (8 * i + (lane >> 3)) * 136 + (lane & 7) * 16; *(LAS u32x2*)d_ = (u32x2){w_[i].x, w_[i].y}; *(LAS u32x2*)(d_ + 8) = (u32x2){w_[i].z, w_[i].w}; }
      asm volatile("s_waitcnt lgkmcnt(0)" ::: "memory"); }
#pragma unroll
    for (int tt = 0; tt < 4; ++tt) {
        f32x16 acc[2];
#pragma unroll
        for (int i = 0; i < 16; ++i) { acc[0][i] = 0.f; acc[1][i] = 0.f; }
        const bf16* wrow = wsg + (size_t)(tt * 8 * 64 + lane) * 8;
        bf16x8 bw[8];
#pragma unroll
        for (int ks = 0; ks < (tt < 2 ? 4 : 8); ++ks) bw[ks] = *(const bf16x8*)(wrow + ks * 512);
        asm volatile("" ::: "memory");
#pragma unroll
        for (int ks = 0; ks < (tt < 2 ? 4 : 8); ++ks) { acc[0] = MFMA32(af[0][ks], bw[ks], acc[0]); acc[1] = MFMA32(af[1][ks], bw[ks], acc[1]); }
        const int t = 32 * tt + r; const float bias = GIN(I_BSG)[(l * 4 + h) * 128 + t]; const size_t row = r0 + t; unsigned yw[2][4];
#pragma unroll
        for (int dt = 0; dt < 2; ++dt)
#pragma unroll
            for (int g4 = 0; g4 < 4; ++g4) { const int d0 = 32 * dt + 8 * g4 + 4 * hf; const u32x2 uv = *(const LAS u32x2*)(vt + (32 * tt + r) * 136 + d0 * 2);
                yw[dt][g4] = q8x4(bf2f(uv.x & 0xffffu) * (acc[dt][4 * g4] + bias), bf2f(uv.x >> 16) * (acc[dt][4 * g4 + 1] + bias), bf2f(uv.y & 0xffffu) * (acc[dt][4 * g4 + 2] + bias), bf2f(uv.y >> 16) * (acc[dt][4 * g4 + 3] + bias)); }
        y_tile_store(vt + 32 * tt * 136, yw, Y + (r0 + 32 * tt) * D + YC_B + h * 64, lane);
    }
    WAVE_LDS_SYNC();
}
template <int W> __device__ __forceinline__ void pool_tile_w(Frame& F, int l, int g, int tile, LAS unsigned char* wl) {
    int lane = F.lane; asm volatile("" : "+v"(lane)); const int r = lane & 31, hf = lane >> 5;
    const size_t row0 = (size_t)tile * 32, row = row0 + r; const int t = (int)(row & (SEQ - 1));
    const bf16* P = WSP(bf16, WS_P); unsigned char* Y = WSP(unsigned char, WS_Y); const bf16* wpt = WSP(bf16, WS_WPT) + (size_t)(l * 4 + g) * 64 * 64;
    const int cnt = (t + 1 < W) ? (t + 1) : W; const float icnt = 1.0f / (float)cnt;
    constexpr int NR = 32 + W - 1, NL = (NR + 7) / 8;
    { const long first = (long)row0 - (W - 1), seq0 = (long)(row0 & ~(size_t)(SEQ - 1));
      u32x4 wv[NL];
#pragma unroll
      for (int k = 0; k < NL; ++k) { const int rr = 8 * k + (lane >> 3); long gr = first + (rr < NR ? rr : NR - 1); gr = gr < seq0 ? seq0 : gr;
          wv[k] = *(const u32x4*)(P + (size_t)gr * NP + PC_XC + g * 64 + (lane & 7) * 8); }
      asm volatile("s_waitcnt lgkmcnt(0)" ::: "memory");
#pragma unroll
      for (int k = 0; k < NL; ++k) { const int rr = 8 * k + (lane >> 3); if (rr < NR) *(LAS u32x4*)(wl + rr * 144 + (lane & 7) * 16) = wv[k]; }
      asm volatile("s_waitcnt lgkmcnt(0)" ::: "memory"); }
    f32x16 acc[2];
#pragma unroll
    for (int i = 0; i < 16; ++i) { acc[0][i] = 0.f; acc[1][i] = 0.f; }
#pragma unroll
    for (int ks = 0; ks < 4; ++ks) { const LAS unsigned char* xp = wl + (W - 1 + r) * 144 + (16 * ks + 8 * hf) * 2;
        u32x4 v[W];
#pragma unroll
        for (int q = 0; q < W; ++q) v[q] = *(const LAS u32x4*)(xp - q * 144);
        float sm[8];
#pragma unroll
        for (int j = 0; j < 8; ++j) sm[j] = 0.f;
#pragma unroll
        for (int q = 0; q < W; ++q) { const float m = (q < cnt) ? 1.0f : 0.0f;
            sm[0] += m * bf2f(v[q].x & 0xffffu); sm[1] += m * bf2f(v[q].x >> 16); sm[2] += m * bf2f(v[q].y & 0xffffu); sm[3] += m * bf2f(v[q].y >> 16);
            sm[4] += m * bf2f(v[q].z & 0xffffu); sm[5] += m * bf2f(v[q].z >> 16); sm[6] += m * bf2f(v[q].w & 0xffffu); sm[7] += m * bf2f(v[q].w >> 16); }
        const bf16x8 bfr = pack8(sm[0] * icnt - bf2f(v[0].x & 0xffffu), sm[1] * icnt - bf2f(v[0].x >> 16), sm[2] * icnt - bf2f(v[0].y & 0xffffu), sm[3] * icnt - bf2f(v[0].y >> 16),
                                 sm[4] * icnt - bf2f(v[0].z & 0xffffu), sm[5] * icnt - bf2f(v[0].z >> 16), sm[6] * icnt - bf2f(v[0].w & 0xffffu), sm[7] * icnt - bf2f(v[0].w >> 16));
        const bf16x8 a0 = *(const bf16x8*)(wpt + (size_t)(ks * 64 + lane) * 8), a1 = *(const bf16x8*)(wpt + (size_t)((4 + ks) * 64 + lane) * 8);
        acc[0] = MFMA32(a0, bfr, acc[0]); acc[1] = MFMA32(a1, bfr, acc[1]);
        if (W == 16) asm volatile("" ::: "memory"); }
    const float* sp = GIN(I_SPOOL) + l * 256 + g * 64;
    unsigned yw[2][4];
#pragma unroll
    for (int dt = 0; dt < 2; ++dt)
#pragma unroll
        for (int g4 = 0; g4 < 4; ++g4) { const int d0 = 32 * dt + 8 * g4 + 4 * hf; const f32x4 sv = *(const f32x4*)(sp + d0);
            yw[dt][g4] = q8x4(acc[dt][4 * g4] * sv[0], acc[dt][4 * g4 + 1] * sv[1], acc[dt][4 * g4 + 2] * sv[2], acc[dt][4 * g4 + 3] * sv[3]); }
    y_tile_store(wl + 8192, yw, Y + row0 * D + YC_C + g * 64, lane);
}
__device__ __forceinline__ void pool_tile(Frame& F, int l, int unit, LAS unsigned char* wl) {
    const int g = 3 - (unit >> 10), tile = unit & 1023;
    if (g == 3) pool_tile_w<16>(F, l, 3, tile, wl); else if (g == 2) pool_tile_w<8>(F, l, 2, tile, wl); else if (g == 1) pool_tile_w<4>(F, l, 1, tile, wl); else pool_tile_w<2>(F, l, 0, tile, wl);
}
__device__ __forceinline__ void mix(Frame& F, int l) {
    constexpr int NSC = 64;
    const int gw = F.bid * NWAVES + F.wave, NGW = F.G * NWAVES;
    unsigned* cnt = (unsigned*)(F.ws + WS_CTL) + CW_DNCNT;
    LAS unsigned char* wl = F.lds + F.wave * DN_WLDS;
    for (int u0 = F.bid * NWAVES; u0 < 2048; u0 += NGW) {
        if (u0 + F.wave < 2048) dn_prep(F, l, u0 + F.wave, wl);
        asm volatile("s_waitcnt vmcnt(0)" ::: "memory");
        __syncthreads();
        if (F.tid == 0) { __builtin_amdgcn_fence(__ATOMIC_RELEASE, "agent");
            asm volatile("s_waitcnt vmcnt(0)" ::: "memory");
            const int nch = 2048 - u0 < NWAVES ? 2048 - u0 : NWAVES;
            __hip_atomic_fetch_add(cnt + 64 * (u0 >> 5), (unsigned)nch, __ATOMIC_RELAXED, __HIP_MEMORY_SCOPE_AGENT); }
    }
    if (F.bid < NSC) {
        if (F.wave == 0) {
            const unsigned want = 32u * (unsigned)(l + 1); unsigned spins = 0;
            while ((unsigned)__builtin_amdgcn_readfirstlane(__hip_atomic_load(cnt + 64 * F.bid, __ATOMIC_RELAXED, __HIP_MEMORY_SCOPE_AGENT)) < want) {
                __builtin_amdgcn_s_sleep(2); if (++spins > (1u << 22)) break; }
            __builtin_amdgcn_fence(__ATOMIC_ACQUIRE, "agent");
            asm volatile("s_waitcnt vmcnt(0)" ::: "memory");
            if (F.lane == 0) ((volatile LAS unsigned*)(F.lds + SL_FLAGS))[0] = (unsigned)(l + 1);
            dn_scan_lead2<0>(F, l, F.bid);
            return; }
        if (F.wave == 1) { dn_scan_lead2<1>(F, l, F.bid); return; }
        if (F.wave <= 3) dn_scan_help(F, l, F.bid, F.wave - 2);
        return; }
    const int wi = (F.bid - NSC) * NWAVES + F.wave, NWI = (F.G - NSC) * NWAVES;
    for (int idx = wi; idx < 9216; idx += NWI) {
        if (idx < 1024) sg_tile(F, l, idx, wl);
        else if (idx < 2048) pool_tile(F, l, idx - 1024, wl);
        else if (idx >= 6144) pool_tile(F, l, idx - 6144 + 1024, wl);
        else { const int j = idx - 2048; const int qt = 63 - (j >> 6), bh = j & 63; sb_tile(F, l, bh >> 2, bh & 3, qt, wl); }
    }
}

__device__ __forceinline__ void fin(Frame& F) {
    const int gw = F.bid * NWAVES + F.wave, NGW = F.G * NWAVES; const float* ssq = WSP(float, WS_SSQ1); const float* gf = GIN(I_GFIN); const bf16* xb = WSP(bf16, WS_XB);
    for (int r = gw; r < M; r += 2 * NGW) { const int r2 = r + NGW < M ? r + NGW : r;
        const float rsa = pg8::row_rstd(ssq, r), rsb = pg8::row_rstd(ssq, r2);
        u32x4 va[2], vb[2];
#pragma unroll
        for (int j = 0; j < 2; ++j) { va[j] = *(const u32x4*)(xb + (size_t)r * D + 512 * j + 8 * F.lane); vb[j] = *(const u32x4*)(xb + (size_t)r2 * D + 512 * j + 8 * F.lane); }
#pragma unroll
        for (int j = 0; j < 2; ++j) { const int cc = 512 * j + 8 * F.lane; const f32x4 g0 = *(const f32x4*)(gf + cc), g1 = *(const f32x4*)(gf + cc + 4);
            const f32x4 a0 = (f32x4){bf2f(va[j].x & 0xffffu), bf2f(va[j].x >> 16), bf2f(va[j].y & 0xffffu), bf2f(va[j].y >> 16)}, a1 = (f32x4){bf2f(va[j].z & 0xffffu), bf2f(va[j].z >> 16), bf2f(va[j].w & 0xffffu), bf2f(va[j].w >> 16)};
            const f32x4 b0 = (f32x4){bf2f(vb[j].x & 0xffffu), bf2f(vb[j].x >> 16), bf2f(vb[j].y & 0xffffu), bf2f(vb[j].y >> 16)}, b1 = (f32x4){bf2f(vb[j].z & 0xffffu), bf2f(vb[j].z >> 16), bf2f(vb[j].w & 0xffffu), bf2f(vb[j].w >> 16)};
            *(f32x4*)(as_global(F.out) + (size_t)r * D + cc) = a0 * rsa * g0; *(f32x4*)(as_global(F.out) + (size_t)r * D + cc + 4) = a1 * rsa * g1;
            if (r2 != r) { *(f32x4*)(as_global(F.out) + (size_t)r2 * D + cc) = b0 * rsb * g0; *(f32x4*)(as_global(F.out) + (size_t)r2 * D + cc + 4) = b1 * rsb * g1; } } }
}
#ifndef MK_PER_PHASE
#define MK_PER_PHASE 0
#endif
constexpr int N_PHASES = 2 + 6 * DEPTH + 1;
struct Args { const float* in[N_IN]; float* out; unsigned char* ws; int ph_lo, ph_hi; };
__global__ void __launch_bounds__(NTHR, 2) fwd(Args args) {
    extern __shared__ __attribute__((aligned(16))) unsigned char lds_raw[];
    Frame F;
    F.lds = (LAS unsigned char*)lds_raw;
    F.tid = threadIdx.x; F.lane = F.tid & 63; F.wave = __builtin_amdgcn_readfirstlane(F.tid >> 6);
    F.G = gridDim.x; F.bid = blockIdx.x; F.ws = args.ws; F.out = args.out;
    F.in = args.in;
    volatile LAS unsigned* MISC = (volatile LAS unsigned*)(F.lds + MISC_OFF);
    if (F.tid < 32) MISC[F.tid] = 0u;
    if (F.tid < 384) ((volatile LAS unsigned*)(F.lds + 162048))[F.tid] = 0u;
    __syncthreads();
    XcdBarrier bar; bar.bar = (unsigned*)(F.ws + WS_CTL) + CW_BAR; bar.x = 0; bar.st = nullptr;
    if (F.tid == 0) { const unsigned xcc = xb_xcc_id(); MISC[12] = xcc; MISC[13] = __hip_atomic_fetch_add((unsigned*)(F.ws + WS_CTL) + CW_XRANK + 64 * (xcc & 15), 1u, __ATOMIC_RELAXED, __HIP_MEMORY_SCOPE_AGENT); }
    int vc = F.bid;
    if (!MK_PER_PHASE) bar = xcd_barrier_post((unsigned*)(F.ws + WS_CTL) + CW_BAR, MISC + 8);
    const int lo = args.ph_lo, hi = args.ph_hi;
#define IN(k) (lo <= (k) && (k) < hi)
#define SEAMX() do { XcdBarrier b2_ = bar; unsigned* p_ = b2_.bar; unsigned x_ = b2_.x; asm volatile("" : "+s"(p_), "+s"(x_)); b2_.bar = p_; b2_.x = x_; xcd_barrier(b2_); } while (0)
#define FILL_TABLES(ssqp, swp, swld, goap, qsap, qsbp) do { const float* q_ = (ssqp); const float* s_ = (swp); const float* g_ = (goap); const float* qa_ = (qsap); const float* qb_ = (qsbp); \
    LAS float* tr_ = (LAS float*)(F.lds + RING_BYTES); LAS float* ts_ = tr_ + 2048; LAS float* tg_ = ts_ + 2048; LAS int* ul_ = (LAS int*)(tg_ + 256); LAS float* tq_ = tg_ + 512; \
      \
    if (F.tid == 0) { for (int i_ = 0; i_ < 8; ++i_) { pg8::Unit u_; const bool k_ = S.next(i_, u_); ul_[2 * i_] = k_ ? u_.pm : -1; ul_[2 * i_ + 1] = k_ ? u_.pn : 0; } } \
    asm volatile("s_waitcnt lgkmcnt(0)" ::: "memory"); __builtin_amdgcn_s_barrier(); \
    if (F.tid < 256) { float t_[8], a_s[8]; \
        _Pragma("unroll") for (int i_ = 0; i_ < 8; ++i_) { const int pm_ = ul_[2 * i_]; t_[i_] = 0.f; a_s[i_] = 1.f; if (pm_ >= 0) { const pg8::f32x4* p_ = (const pg8::f32x4*)(q_ + (size_t)(pm_ * 256 + F.tid) * 16); const pg8::f32x4 a_ = p_[0], b_ = p_[1], c_ = p_[2], d_ = p_[3]; \
            t_[i_] = ((a_[0] + a_[1]) + (a_[2] + a_[3])) + ((b_[0] + b_[1]) + (b_[2] + b_[3])) + ((c_[0] + c_[1]) + (c_[2] + c_[3])) + ((d_[0] + d_[1]) + (d_[2] + d_[3])); if (qa_) a_s[i_] = qa_[pm_ * 256 + F.tid]; } } \
        _Pragma("unroll") for (int i_ = 0; i_ < 8; ++i_) tr_[i_ * 256 + F.tid] = __builtin_amdgcn_rsqf(t_[i_] * (1.0f / 1024.0f) + 1e-6f) * a_s[i_]; \
        if (g_) tg_[F.tid] = g_[F.tid]; } \
    else { float v_[8], w_[8]; \
        _Pragma("unroll") for (int i_ = 0; i_ < 8; ++i_) { const int pm_ = ul_[2 * i_], pn_ = ul_[2 * i_ + 1]; v_[i_] = pm_ >= 0 ? s_[(size_t)(pm_ >> 3) * (swld) + pn_ * 256 + F.tid - 256] : 0.f; w_[i_] = (pm_ >= 0 && qb_) ? qb_[pn_ * 256 + F.tid - 256] : 1.f; } \
        _Pragma("unroll") for (int i_ = 0; i_ < 8; ++i_) { ts_[i_ * 256 + F.tid - 256] = v_[i_]; tq_[i_ * 256 + F.tid - 256] = w_[i_]; } } \
    asm volatile("s_waitcnt lgkmcnt(0)" ::: "memory"); __builtin_amdgcn_s_barrier(); } while (0)
#define FILL_RTAB(gatep, gnp, scp, qrefp, qsap, hsp, hcp) do { const float* ga_ = (gatep); const float* gn_ = (gnp); const float* sc_ = (scp); const float* qr_ = (qrefp); float* qa_ = (qsap); const float* hs_ = (hsp); const int* hc_ = (hcp); \
    LAS float* tis_ = (LAS float*)(F.lds + RING_BYTES); LAS float* tgs_ = tis_ + 1024; LAS float* tG_ = tgs_ + 1024; LAS int* thc_ = (LAS int*)(tG_ + 1024); LAS int* ul_ = thc_ + 1024; \
    if (F.tid == 0) { for (int i_ = 0; i_ < 4; ++i_) { pg8::Unit u_; const bool k_ = S.next(i_, u_); ul_[2 * i_] = k_ ? u_.pm : -1; ul_[2 * i_ + 1] = k_ ? u_.pn : 0; } } \
    asm volatile("s_waitcnt lgkmcnt(0)" ::: "memory"); __builtin_amdgcn_s_barrier(); \
    if (F.tid < 256) { float t_[4]; \
        _Pragma("unroll") for (int i_ = 0; i_ < 4; ++i_) { const int pm_ = ul_[2 * i_]; t_[i_] = 0.f; if (pm_ >= 0 && qr_) { const pg8::f32x4* p_ = (const pg8::f32x4*)(qr_ + (size_t)(pm_ * 256 + F.tid) * 16); const pg8::f32x4 a_ = p_[0], b_ = p_[1], c_ = p_[2], d_ = p_[3]; \
            t_[i_] = ((a_[0] + a_[1]) + (a_[2] + a_[3])) + ((b_[0] + b_[1]) + (b_[2] + b_[3])) + ((c_[0] + c_[1]) + (c_[2] + c_[3])) + ((d_[0] + d_[1]) + (d_[2] + d_[3])); } } \
        _Pragma("unroll") for (int i_ = 0; i_ < 4; ++i_) { const int pm_ = ul_[2 * i_], pn_ = ul_[2 * i_ + 1]; float v_ = 0.f; if (pm_ >= 0 && qr_) { const float rr_ = __builtin_amdgcn_rsqf(t_[i_] * (1.0f / 1024.0f) + 1e-6f); v_ = 127.0f * rr_ * (1.0f / pg8::QCLIP8); if (pn_ == 0) qa_[pm_ * 256 + F.tid] = pg8::QCLIP8 / (127.0f * rr_); } \
            tis_[i_ * 256 + F.tid] = v_; } } \
    else { const int c_ = F.tid - 256; float g_[4], G_[4]; int h_[4]; \
        _Pragma("unroll") for (int i_ = 0; i_ < 4; ++i_) { const int pm_ = ul_[2 * i_], col_ = ul_[2 * i_ + 1] * 256 + c_; g_[i_] = 0.f; G_[i_] = 0.f; h_[i_] = 0; \
            if (pm_ >= 0) { g_[i_] = ga_[(size_t)(pm_ >> 3) * 6144 + col_]; if (hs_) { g_[i_] *= hs_[col_]; if (hc_) h_[i_] = __builtin_bit_cast(int, g_[i_] * (float)(hc_[col_] * 128)); } if (gn_) G_[i_] = gn_[col_] * (sc_[(size_t)(pm_ >> 3) * 6144 + col_] + 1.0f); } } \
        _Pragma("unroll") for (int i_ = 0; i_ < 4; ++i_) { tgs_[i_ * 256 + c_] = g_[i_]; tG_[i_ * 256 + c_] = G_[i_]; thc_[i_ * 256 + c_] = h_[i_]; } } \
    asm volatile("s_waitcnt lgkmcnt(0)" ::: "memory"); __builtin_amdgcn_s_barrier(); } while (0)
#define RTABS (const LAS float*)(F.lds + RING_BYTES), (const LAS float*)(F.lds + RING_BYTES + 4096), (const LAS float*)(F.lds + RING_BYTES + 8192), (const LAS int*)(F.lds + RING_BYTES + 12288)
#define FRESH() do { int t_ = threadIdx.x; asm volatile("" : "+v"(t_)); F.tid = t_; F.lane = t_ & 63; F.wave = __builtin_amdgcn_readfirstlane(t_ >> 6); unsigned long long z_ = 0ull; asm volatile("" : "+s"(z_)); F.ws = args.ws + z_; } while (0)
#define SEAM(k) do { if (!MK_PER_PHASE && IN(k) && IN((k) + 1)) { XcdBarrier b2_ = bar; unsigned* p_ = b2_.bar; unsigned x_ = b2_.x; asm volatile("" : "+s"(p_), "+s"(x_)); b2_.bar = p_; b2_.x = x_; xcd_barrier(b2_); } } while (0)

    #ifndef SKIP_P0
    if (IN(0)) { FRESH(); p0a(F); }
#endif
    SEAM(0);
    if (!MK_PER_PHASE) { bool even = (F.G % 8 == 0); for (int j = 0; j < 16; ++j) { const unsigned n_ = __hip_atomic_load((unsigned*)(F.ws + WS_CTL) + CW_XRANK + 64 * j, __ATOMIC_RELAXED, __HIP_MEMORY_SCOPE_AGENT); even = even && ((unsigned)__builtin_amdgcn_readfirstlane((int)n_) == (j < 8 ? (unsigned)F.G / 8u : 0u)); }
        if (even) vc = __builtin_amdgcn_readfirstlane((int)(MISC[13] * 8u + MISC[12])); }
    #ifndef SKIP_P0
    if (IN(1)) { FRESH(); p0b(F); }
#if defined(PROBE_REP) && PROBE_REP == 9
    SEAMX(); if (IN(0)) { FRESH(); p0a(F); } SEAMX(); if (IN(1)) { FRESH(); p0b(F); }
#endif
#endif
    SEAM(1);
    for (int l = 0; l < DEPTH; ++l) {
        const int pb = 2 + 6 * l;
#define modl (WSP(float, WS_MOD) + (size_t)l * 16 * NMOD)
#ifndef SKIP_G1
        if (IN(pb)) {
            FRESH();
            pg8::Gemm g{WSP(bf16, WS_XG), WSP(bf16, WS_WIN) + (size_t)l * NP * D, M, NP, D / 2, D / 2, D};     pg8::StaticOrder S; S.init(M, NP, F.G, vc);
            pg8::EpiNormed<0, true> E{WSP(bf16, WS_P), NP, (const LAS float*)(F.lds + RING_BYTES), (const LAS float*)(F.lds + RING_BYTES + 8192), (const LAS float*)(F.lds + RING_BYTES + 16384), (const LAS float*)(F.lds + RING_BYTES + 16384 + 2048)};
            { auto pre = [&]() { FILL_TABLES(WSP(float, WS_SSQ1), WSP(float, WS_SW1) + (size_t)l * 16 * NP, NP, GIN(I_GOA) + l * 256, WSP(float, WS_QSA1), WSP(float, WS_QSB1) + (size_t)l * NP); }; pg8::gemm_phase<pg8::EpiNormed<0, true>, pg8::StaticOrder, true, true>(F.lds, g, S, E, pre); }
#if defined(PROBE_REP) && PROBE_REP == 6
            SEAMX(); FRESH(); pg8::gemm_phase<pg8::EpiNormed<0, true>, pg8::StaticOrder, true, true>(F.lds, g, S, E);
#endif
#ifndef SKIP_AB
            FRESH(); ab_logits(F, l);
#if defined(PROBE_REP) && PROBE_REP == 11
            SEAMX(); FRESH(); ab_logits(F, l);
#endif
#endif
        }
#endif
        SEAM(pb);
        if (IN(pb + 1)) { FRESH(); mix(F, l); }
        SEAM(pb + 2);
#ifndef SKIP_G2
        if (IN(pb + 3)) {
            FRESH();
            pg8::Gemm g{WSP(bf16, WS_Y), WSP(bf16, WS_WOUT) + (size_t)l * D * D, M, D, D / 2, D / 2, D};     pg8::StaticOrder S; S.init(M, D, F.G, vc);
            { pg8::EpiResid<false, false, true, true> E{WSP(bf16, WS_XB), WSP(bf16, WS_XB), WSP(bf16, WS_XQ), WSP(float, WS_SSQ2), RTABS};
                auto pre = [&]() { FILL_RTAB(modl + 2 * D, GIN(I_GN2) + (size_t)l * D, modl + 4 * D, WSP(float, WS_SSQ1), WSP(float, WS_QSA), WSP(float, WS_QSBO) + l * D, (const int*)nullptr); }; pg8::gemm_phase<pg8::EpiResid<false, false, true, true>, pg8::StaticOrder, true, true>(F.lds, g, S, E, pre); }
        }
#endif
        SEAM(pb + 3);
#ifndef SKIP_G3
        if (IN(pb + 4)) {
            FRESH();
            pg8::Gemm g{WSP(bf16, WS_XQ), WSP(bf16, WS_WFF1) + (size_t)l * FF * D, M, FF, D / 2, D / 2, D};     pg8::StaticOrder S; S.init(M, FF, F.G, vc);
            pg8::EpiNormed<1, true, true> E{WSP(bf16, WS_HID), FF, (const LAS float*)(F.lds + RING_BYTES), (const LAS float*)(F.lds + RING_BYTES + 8192), (const LAS float*)nullptr, (const LAS float*)(F.lds + RING_BYTES + 16384 + 2048)};
            { auto pre = [&]() { FILL_TABLES(WSP(float, WS_SSQ2), WSP(float, WS_SW2) + (size_t)l * 16 * FF, FF, (const float*)nullptr, WSP(float, WS_QSA), WSP(float, WS_QSB) + (size_t)l * FF); }; pg8::gemm_phase<pg8::EpiNormed<1, true, true>, pg8::StaticOrder, true, true>(F.lds, g, S, E, pre); }
#if defined(PROBE_REP) && PROBE_REP == 8
            { SEAMX(); FRESH(); pg8::EpiNull EN{WSP(float, WS_BETA)}; pg8::gemm_phase<pg8::EpiNull, pg8::StaticOrder, true, true>(F.lds, g, S, EN); }
#endif
#if defined(PROBE_REP) && PROBE_REP == 12
            { SEAMX(); FRESH(); pg8::EpiNormed<1, true, true> E2 = E; E2.nost = (args.ph_hi != 12345); pg8::gemm_phase<pg8::EpiNormed<1, true, true>, pg8::StaticOrder, true, true>(F.lds, g, S, E2); }
#endif
#if defined(PROBE_REP) && PROBE_REP == 7
            SEAMX(); FRESH(); pg8::gemm_phase<pg8::EpiNormed<1, true, true>, pg8::StaticOrder, true, true>(F.lds, g, S, E);
#endif
        }
#endif
        SEAM(pb + 4);
#ifndef SKIP_G4
        if (IN(pb + 5)) {
            FRESH();
            pg8::Gemm g{WSP(bf16, WS_HID), WSP(bf16, WS_WFF2) + (size_t)l * D * FF, M, D, FF / 2, FF / 2, FF};     pg8::StaticOrder S; S.init(M, D, F.G, vc);
            const bool more = l + 1 < DEPTH;
            if (more) {
                pg8::EpiResid<false, false, true, true> E{WSP(bf16, WS_XB), WSP(bf16, WS_XB), WSP(bf16, WS_XG), WSP(float, WS_SSQ1), RTABS};
                auto pre = [&]() { FILL_RTAB(modl + 5 * D, GIN(I_GN1) + (size_t)(l + 1) * D, modl + 16 * NMOD + D, WSP(float, WS_SSQ2), WSP(float, WS_QSA1), WSP(float, WS_QSB2) + l * D, WSP(int, WS_QCS2) + l * D); }; pg8::gemm_phase<pg8::EpiResid<false, false, true, true>, pg8::StaticOrder, true, true>(F.lds, g, S, E, pre); }
            else {
                pg8::EpiResid<false, false, false, true> E{WSP(bf16, WS_XB), WSP(bf16, WS_XB), (bf16*)nullptr, WSP(float, WS_SSQ1), RTABS};
                auto pre = [&]() { FILL_RTAB(modl + 5 * D, (const float*)nullptr, (const float*)nullptr, (const float*)nullptr, (float*)nullptr, WSP(float, WS_QSB2) + l * D, WSP(int, WS_QCS2) + l * D); }; pg8::gemm_phase<pg8::EpiResid<false, false, false, true>, pg8::StaticOrder, true, true>(F.lds, g, S, E, pre); }
        }
#endif
        SEAM(pb + 5);
    }
#ifndef SKIP_FIN
    if (IN(N_PHASES - 1)) { FRESH(); fin(F); }
#endif
#undef modl
#undef IN
#undef SEAM
}

extern "C" void kernel_launch(void* const* d_in, const int* in_sizes, int n_in, void* d_out, int out_size, void* d_ws, size_t ws_size, hipStream_t stream) {
    static int grid = 0;
    if (grid == 0) {
        if (n_in != N_IN || in_sizes[0] != M * D || out_size != M * D || ws_size < WS_END) { fprintf(stderr, "kernel_launch: unexpected shapes (n_in %d, in0 %d, out %d, ws %zu); nothing launched\n", n_in, n_in > 0 ? in_sizes[0] : -1, out_size, ws_size); grid = -1; return; }
        int dev = 0, cus = 0, per_cu = 0;
        if (hipGetDevice(&dev) != hipSuccess || hipDeviceGetAttribute(&cus, hipDeviceAttributeMultiprocessorCount, dev) != hipSuccess) { fprintf(stderr, "kernel_launch: device query failed\n"); grid = -1; return; }
        if (hipFuncSetAttribute((const void*)fwd, hipFuncAttributeMaxDynamicSharedMemorySize, LDS_BYTES) != hipSuccess) { fprintf(stderr, "kernel_launch: hipFuncSetAttribute failed\n"); grid = -1; return; }
        if (hipOccupancyMaxActiveBlocksPerMultiprocessor(&per_cu, (const void*)fwd, NTHR, LDS_BYTES) != hipSuccess || per_cu < 1) fprintf(stderr, "kernel_launch: note: occupancy query reports %d workgroups per CU\n", per_cu);
        (void)hipGetLastError();
        grid = cus;
    }
    if (grid < 0) return;
    if (hipMemsetAsync((char*)d_ws + WS_CTL, 0, CTL_ZERO_BYTES, stream) != hipSuccess) { fprintf(stderr, "kernel_launch: memset failed\n"); return; }
    Args a{};
    for (int i = 0; i < N_IN; ++i) a.in[i] = (const float*)d_in[i];
    a.out = (float*)d_out; a.ws = (unsigned char*)d_ws;
#if MK_PER_PHASE
    for (int ph = 0; ph < N_PHASES; ++ph) { a.ph_lo = ph; a.ph_hi = ph + 1; hipLaunchKernelGGL(fwd, dim3(grid), dim3(NTHR), LDS_BYTES, stream, a); }
#else
    a.ph_lo = 0; a.ph_hi = N_PHASES; hipLaunchKernelGGL(fwd, dim3(grid), dim3(NTHR), LDS_BYTES, stream, a);
#endif
    const hipError_t le = hipPeekAtLastError();
    if (le != hipSuccess) fprintf(stderr, "kernel_launch: launch failed: %s\n", hipGetErrorName(le));
}
```
